# Optimizing an MI355X kernel written in HIP

```python
import jax
import jax.numpy as jnp
from jax import lax
import numpy as np

D_MODEL = 1024
BATCH = 4
SEQ = 4096
DEPTH = 2
DEC_BATCH = 32
DEC_SEQ = 1
PAST_LEN = 16384
PAGE_SIZE = 128

W_A = D_MODEL // 2
A_GROUP_DIM = 128
G_A = W_A // A_GROUP_DIM
CHUNK = 128
W_B = D_MODEL - W_A
HD_B = 64
H_B = W_B // HD_B
DIL_PATTERNS = ((128, 1), (512, 4), (2048, 16))
WIN_MAX = max(w for w, _ in DIL_PATTERNS)
ATT_BLOCK = 128
N_IN_EVEN = 2 * W_A + 3 * W_B
D_RNN = D_MODEL
RG_BLOCK = 128
RG_HEADS = D_RNN // RG_BLOCK
RG_CONV = 4
RG_C = 8.0
D_FF = 2816
FFN_CONV = 3
N_EVEN = (DEPTH + 1) // 2
N_ODD = DEPTH // 2
EPS = 1e-6
NEG_INF = -1e30

kernel_name = 'hybrid_sgu_dilattn_rglru_convffn_step'


def _rmsnorm(x):
    xf = x.astype(jnp.float32)
    return (xf * lax.rsqrt(jnp.mean(xf * xf, -1, keepdims=True) + EPS)).astype(x.dtype)


def _layernorm(x, g, b):
    xf = x.astype(jnp.float32)
    mu = jnp.mean(xf, -1, keepdims=True)
    var = jnp.mean(jnp.square(xf - mu), -1, keepdims=True)
    return ((xf - mu) * lax.rsqrt(var + EPS)).astype(x.dtype) * g + b


def _causal_dwconv(x, buf, w, b):
    K = w.shape[0]
    T = x.shape[1]
    xp = jnp.concatenate([buf.astype(x.dtype), x], axis=1)
    y = b + w[0] * xp[:, :T]
    for k in range(1, K):
        y = y + w[k] * xp[:, k:k + T]
    return y, xp[:, xp.shape[1] - (K - 1):]


def _chunk_sgu(u, v, w_s, b_s):
    N, T = u.shape[:2]
    nc = -(-T // CHUNK)
    pad = nc * CHUNK - T
    vp = jnp.pad(v, ((0, 0), (0, pad), (0, 0), (0, 0))).reshape(N, nc, CHUNK, G_A, A_GROUP_DIM)
    w_causal = jnp.tril(w_s)
    mix = jnp.einsum('gts,ncsgd->nctgd', w_causal, vp) + b_s.T[None, None, :, :, None]
    mix = mix.reshape(N, nc * CHUNK, G_A, A_GROUP_DIM)[:, :T]
    return u * mix


def _band_attn(q, k, v, n_back):
    N, M, H, Dh = q.shape
    nb = -(-M // ATT_BLOCK)
    pad = nb * ATT_BLOCK - M

    def blocks(t):
        t = jnp.pad(t, ((0, 0), (0, pad), (0, 0), (0, 0)))
        return t.reshape(N, nb, ATT_BLOCK, H, Dh)

    def with_prev(t):
        prev = jnp.concatenate([jnp.zeros_like(t[:, :1]), t[:, :-1]], axis=1)
        return jnp.concatenate([prev, t], axis=2)

    qb = blocks(q)
    kc = with_prev(blocks(k))
    vc = with_prev(blocks(v))
    s = jnp.einsum('nbqhd,nbkhd->nbhqk', qb, kc).astype(jnp.float32) * (Dh ** -0.5)
    qi = jnp.arange(ATT_BLOCK)[:, None]
    kj = jnp.arange(2 * ATT_BLOCK)[None, :]
    dist = qi + ATT_BLOCK - kj
    key_pos = (jnp.arange(nb) * ATT_BLOCK)[:, None, None] + kj - ATT_BLOCK
    valid = (dist >= 0) & (dist <= n_back) & (key_pos >= 0)
    s = jnp.where(valid[None, :, None], s, NEG_INF)
    m = jnp.max(s, -1, keepdims=True)
    p = jnp.exp(s - m)
    den = jnp.sum(p, -1)
    o = jnp.einsum('nbhqk,nbkhd->nbqhd', p.astype(v.dtype), vc)
    o = o / jnp.swapaxes(den, 2, 3)[..., None].astype(o.dtype)
    lse = jnp.swapaxes(m[..., 0] + jnp.log(den), 2, 3)
    return (o.reshape(N, nb * ATT_BLOCK, H, Dh)[:, :M],
            lse.reshape(N, nb * ATT_BLOCK, H)[:, :M])


def _mix_dilations(outs, lses):
    wts = jax.nn.softmax(jnp.stack(lses, 0), axis=0)
    return jnp.einsum('pnth,pnthd->nthd', wts.astype(outs[0].dtype), jnp.stack(outs, 0))


def _to_strided(t, d):
    N, T, H, Dh = t.shape
    return t.reshape(N, T // d, d, H, Dh).transpose(0, 2, 1, 3, 4).reshape(N * d, T // d, H, Dh)


def _dilated_prompt(q, k, v):
    N, T, H, Dh = q.shape
    outs, lses = [], []
    for w, d in DIL_PATTERNS:
        o, lse = _band_attn(_to_strided(q, d), _to_strided(k, d), _to_strided(v, d), w // d)
        outs.append(o.reshape(N, d, T // d, H, Dh).transpose(0, 2, 1, 3, 4).reshape(N, T, H, Dh))
        lses.append(lse.reshape(N, d, T // d, H).transpose(0, 2, 1, 3).reshape(N, T, H))
    return _mix_dilations(outs, lses)


def _dilated_sample(q, kc, vc):
    N, T, H, Dh = q.shape
    L = kc.shape[1] - T
    t_idx = jnp.arange(T)[:, None]
    outs, lses = [], []
    for w, d in DIL_PATTERNS:
        j = jnp.arange(w // d + 1)[None, :]
        idx = L + t_idx - j * d
        valid = idx >= 0
        idx = jnp.maximum(idx, 0)
        kg = kc[:, idx]
        vg = vc[:, idx]
        s = jnp.einsum('nthd,ntjhd->nthj', q, kg).astype(jnp.float32) * (Dh ** -0.5)
        s = jnp.where(valid[None, :, None, :], s, NEG_INF)
        m = jnp.max(s, -1, keepdims=True)
        p = jnp.exp(s - m)
        den = jnp.sum(p, -1)
        o = jnp.einsum('nthj,ntjhd->nthd', p.astype(vc.dtype), vg) / den[..., None].astype(vc.dtype)
        outs.append(o)
        lses.append(m[..., 0] + jnp.log(den))
    return _mix_dilations(outs, lses)


def _even_mixer(h, w_in, ln_g, ln_b, w_s, b_s, w_out, k_buf, v_buf):
    N, T, _ = h.shape
    z = h @ w_in
    u_a = jax.nn.gelu(z[..., :W_A])
    v_a = _layernorm(jax.nn.gelu(z[..., W_A:2 * W_A]), ln_g, ln_b)
    q = z[..., 2 * W_A:2 * W_A + W_B].reshape(N, T, H_B, HD_B)
    k = z[..., 2 * W_A + W_B:2 * W_A + 2 * W_B].reshape(N, T, H_B, HD_B)
    v = z[..., 2 * W_A + 2 * W_B:].reshape(N, T, H_B, HD_B)
    a_out = _chunk_sgu(u_a.reshape(N, T, G_A, A_GROUP_DIM), v_a.reshape(N, T, G_A, A_GROUP_DIM),
                       w_s, b_s).reshape(N, T, W_A)
    if k_buf is None:
        b_out = _dilated_prompt(q, k, v)
        keep = min(WIN_MAX, T)
        k_new, v_new = k[:, T - keep:], v[:, T - keep:]
    else:
        kc = jnp.concatenate([k_buf.astype(k.dtype), k], axis=1)
        vc = jnp.concatenate([v_buf.astype(v.dtype), v], axis=1)
        b_out = _dilated_sample(q, kc, vc)
        k_new, v_new = kc[:, T:], vc[:, T:]
    out = jnp.concatenate([a_out, b_out.reshape(N, T, W_B)], axis=-1) @ w_out
    return out, v_a, k_new, v_new


def _rglru_mixer(h, w_in, conv_w, conv_b, w_a, b_a, w_x, b_x, lam, w_out, conv_buf, h0):
    N, T, _ = h.shape
    z = h @ w_in
    gate = z[..., :D_RNN]
    xr = z[..., D_RNN:]
    xc, new_buf = _causal_dwconv(xr, conv_buf, conv_w, conv_b)
    xb = xc.reshape(N, T, RG_HEADS, RG_BLOCK)
    r = jax.nn.sigmoid(jnp.einsum('ntgi,gio->ntgo', xb, w_a).reshape(N, T, D_RNN) + b_a)
    i = jax.nn.sigmoid(jnp.einsum('ntgi,gio->ntgo', xb, w_x).reshape(N, T, D_RNN) + b_x)
    log_a = -RG_C * r.astype(jnp.float32) * jax.nn.softplus(-lam.astype(jnp.float32))
    a = jnp.exp(log_a)
    bx = jnp.sqrt(-jnp.expm1(2.0 * log_a)) * (i * xc).astype(jnp.float32)
    bx = bx.at[:, 0].add(a[:, 0] * h0.astype(jnp.float32))

    def comb(lhs, rhs):
        return (lhs[0] * rhs[0], rhs[0] * lhs[1] + rhs[1])

    _, hs = lax.associative_scan(comb, (a, bx), axis=1)
    y = jax.nn.gelu(gate) * hs.astype(h.dtype)
    return y @ w_out, new_buf, hs[:, -1].astype(h0.dtype)


def _conv_ffn(h, w_up, conv_w, conv_b, w_down, buf):
    up = h @ w_up
    uc, new_buf = _causal_dwconv(up, buf, conv_w, conv_b)
    a, b = jnp.split(uc, 2, axis=-1)
    return (jax.nn.silu(a) * b) @ w_down, new_buf


def _trunk(x, c, win_k, win_v, rg_conv, rg_h, ffn_buf, P):
    n = x.shape[0]
    win_k_new, win_v_new, chunk_v, rg_conv_new, rg_h_new, ffn_new = [], [], [], [], [], []
    for l in range(DEPTH):
        mod = (jax.nn.silu(c) @ P['w_ada'][l] + P['b_ada'][l])[:, None, :]
        sh1, sc1, g1, sh2, sc2, g2 = jnp.split(mod, 6, axis=-1)
        h = _rmsnorm(x) * (1 + sc1) + sh1
        if l % 2 == 0:
            e = l // 2
            kb = None if win_k is None else win_k[e]
            vb = None if win_v is None else win_v[e]
            mo, v_a, kn, vn = _even_mixer(h, P['w_in_even'][e], P['ln_v_g'][e], P['ln_v_b'][e],
                                          P['w_sgu'][e], P['b_sgu'][e], P['w_out_even'][e], kb, vb)
            win_k_new.append(kn)
            win_v_new.append(vn)
            chunk_v.append(v_a)
        else:
            o = l // 2
            cb = jnp.zeros((n, RG_CONV - 1, D_RNN), x.dtype) if rg_conv is None else rg_conv[o]
            h0 = jnp.zeros((n, D_RNN), jnp.float32) if rg_h is None else rg_h[o]
            mo, cn, hn = _rglru_mixer(h, P['w_in_odd'][o], P['rg_conv_w'][o], P['rg_conv_b'][o],
                                      P['rg_w_a'][o], P['rg_b_a'][o], P['rg_w_x'][o], P['rg_b_x'][o],
                                      P['rg_lambda'][o], P['w_out_odd'][o], cb, h0)
            rg_conv_new.append(cn)
            rg_h_new.append(hn)
        x = x + g1 * mo
        h = _rmsnorm(x) * (1 + sc2) + sh2
        fb = jnp.zeros((n, FFN_CONV - 1, 2 * D_FF), x.dtype) if ffn_buf is None else ffn_buf[l]
        fo, fn = _conv_ffn(h, P['ffn_w_up'][l], P['ffn_conv_w'][l], P['ffn_conv_b'][l],
                           P['ffn_w_down'][l], fb)
        ffn_new.append(fn)
        x = x + g2 * fo
    y = _rmsnorm(x) * P['final_g']
    return (y, jnp.stack(win_k_new), jnp.stack(win_v_new), jnp.stack(chunk_v),
            jnp.stack(rg_conv_new), jnp.stack(rg_h_new), jnp.stack(ffn_new))


def setup_inputs(seed: int = 0) -> dict:
    key = jax.random.key(seed)
    ks = iter(jax.random.split(key, 48))

    def nrm(shape, s):
        return jax.random.normal(next(ks), shape, jnp.float32) * s

    L = min(WIN_MAX, PAST_LEN)
    F2 = 2 * D_FF
    a_init = jax.random.uniform(next(ks), (N_ODD, D_RNN), jnp.float32, 0.9, 0.999)
    return {
        'x_prompt': nrm((BATCH, SEQ, D_MODEL), 1.0),
        'x_sample': nrm((DEC_BATCH, DEC_SEQ, D_MODEL), 1.0),
        'cache_win_k': nrm((N_EVEN, DEC_BATCH, L, H_B, HD_B), 1.0),
        'cache_win_v': nrm((N_EVEN, DEC_BATCH, L, H_B, HD_B), 1.0),
        'state_rglru_conv': nrm((N_ODD, DEC_BATCH, RG_CONV - 1, D_RNN), 0.5),
        'state_rglru_h': nrm((N_ODD, DEC_BATCH, D_RNN), 0.5),
        'state_ffn_conv': nrm((DEPTH, DEC_BATCH, FFN_CONV - 1, F2), 0.5),
        'c_prompt': nrm((BATCH, D_MODEL), 1.0),
        'c_sample': nrm((DEC_BATCH, D_MODEL), 1.0),
        'w_ada': nrm((DEPTH, D_MODEL, 6 * D_MODEL), 0.5 * D_MODEL ** -0.5),
        'b_ada': nrm((DEPTH, 6 * D_MODEL), 0.02),
        'w_in_even': nrm((N_EVEN, D_MODEL, N_IN_EVEN), D_MODEL ** -0.5),
        'ln_v_g': 1.0 + nrm((N_EVEN, W_A), 0.02),
        'ln_v_b': nrm((N_EVEN, W_A), 0.02),
        'w_sgu': nrm((N_EVEN, G_A, CHUNK, CHUNK), CHUNK ** -0.5),
        'b_sgu': 1.0 + nrm((N_EVEN, G_A, CHUNK), 0.02),
        'w_out_even': nrm((N_EVEN, W_A + W_B, D_MODEL), (W_A + W_B) ** -0.5),
        'w_in_odd': nrm((N_ODD, D_MODEL, 2 * D_RNN), D_MODEL ** -0.5),
        'rg_conv_w': nrm((N_ODD, RG_CONV, D_RNN), RG_CONV ** -0.5),
        'rg_conv_b': nrm((N_ODD, D_RNN), 0.02),
        'rg_w_a': nrm((N_ODD, RG_HEADS, RG_BLOCK, RG_BLOCK), RG_BLOCK ** -0.5),
        'rg_b_a': nrm((N_ODD, D_RNN), 0.02),
        'rg_w_x': nrm((N_ODD, RG_HEADS, RG_BLOCK, RG_BLOCK), RG_BLOCK ** -0.5),
        'rg_b_x': nrm((N_ODD, D_RNN), 0.02),
        'rg_lambda': jnp.log(a_init) - jnp.log1p(-a_init),
        'w_out_odd': nrm((N_ODD, D_RNN, D_MODEL), D_RNN ** -0.5),
        'ffn_w_up': nrm((DEPTH, D_MODEL, F2), D_MODEL ** -0.5),
        'ffn_conv_w': nrm((DEPTH, FFN_CONV, F2), FFN_CONV ** -0.5),
        'ffn_conv_b': nrm((DEPTH, F2), 0.02),
        'ffn_w_down': nrm((DEPTH, D_FF, D_MODEL), D_FF ** -0.5),
        'final_g': 1.0 + nrm((D_MODEL,), 0.02),
    }


def reference(x_prompt, x_sample, cache_win_k, cache_win_v, state_rglru_conv, state_rglru_h,
              state_ffn_conv, c_prompt, c_sample, w_ada, b_ada, w_in_even, ln_v_g, ln_v_b,
              w_sgu, b_sgu, w_out_even, w_in_odd, rg_conv_w, rg_conv_b, rg_w_a, rg_b_a,
              rg_w_x, rg_b_x, rg_lambda, w_out_odd, ffn_w_up, ffn_conv_w, ffn_conv_b,
              ffn_w_down, final_g):
    P = dict(w_ada=w_ada, b_ada=b_ada, w_in_even=w_in_even, ln_v_g=ln_v_g, ln_v_b=ln_v_b,
             w_sgu=w_sgu, b_sgu=b_sgu, w_out_even=w_out_even, w_in_odd=w_in_odd,
             rg_conv_w=rg_conv_w, rg_conv_b=rg_conv_b, rg_w_a=rg_w_a, rg_b_a=rg_b_a,
             rg_w_x=rg_w_x, rg_b_x=rg_b_x, rg_lambda=rg_lambda, w_out_odd=w_out_odd,
             ffn_w_up=ffn_w_up, ffn_conv_w=ffn_conv_w, ffn_conv_b=ffn_conv_b,
             ffn_w_down=ffn_w_down, final_g=final_g)
    (y_prompt, win_k_prompt, win_v_prompt, _unused_prompt_chunk, rglru_conv_prompt,
     rglru_h_prompt, ffn_conv_prompt) = _trunk(x_prompt, c_prompt, None, None, None, None, None, P)
    (y_sample, win_k_sample, win_v_sample, chunk_v_sample, rglru_conv_sample,
     rglru_h_sample, ffn_conv_sample) = _trunk(x_sample, c_sample, cache_win_k, cache_win_v,
                                               state_rglru_conv, state_rglru_h, state_ffn_conv, P)
    return (y_prompt, y_sample, win_k_prompt, win_v_prompt, rglru_conv_prompt, rglru_h_prompt,
            ffn_conv_prompt, chunk_v_sample, win_k_sample, win_v_sample, rglru_conv_sample,
            rglru_h_sample, ffn_conv_sample)
```

```cpp
#include <hip/hip_runtime.h>
#include <hip/hip_cooperative_groups.h>
#include <cstdio>
#include <cstdint>
namespace cg = cooperative_groups;
namespace pg8 {
#define PG8_LAS __attribute__((address_space(3)))
typedef unsigned short bf16_t;
typedef short bf16x8 __attribute__((ext_vector_type(8)));
typedef float f32x4 __attribute__((ext_vector_type(4)));
typedef unsigned u32x4 __attribute__((ext_vector_type(4)));
constexpr int BM = 256, BK = 64, HALF = 128, HTB = HALF * BK * 2  , STAGE_BYTES = 8 * HTB, NXCD = 8, WGM = 8;

__host__ __device__ __forceinline__ int lds_byte(int r, int c) { const int st = (r >> 4) * 2 + (c >> 5), rr = r & 15, cc = c & 31, ob = rr * 64 + cc * 2; return st * 1024 + (ob ^ (((ob >> 9) & 1) << 5)); }
__host__ __device__ __forceinline__ void stage_rc(int b, int& R, int& C) { const int st = b / 1024, sb = b % 1024, swz = sb ^ (((sb >> 9) & 1) << 5); R = (st >> 1) * 16 + swz / 64; C = (st & 1) * 32 + (swz % 64) / 2; }
__host__ __device__ __forceinline__ int perm32(int rho) { const int n = rho >> 4, i = rho & 15; return 8 * (i >> 2) + 4 * n + (i & 3); }

struct Unit { int pm, pn; };
struct Gemm { const bf16_t* A; const bf16_t* Bt; int M, N, K; };

struct StaticOrder {
    int nM, nN, nwg, G, c;
    __host__ __device__ void init(int M, int N, int G_, int c_) { nM = M / BM; nN = N / BM; nwg = nM * nN; G = G_; c = c_; }
    __host__ __device__ bool next(int i, Unit& u) const {
        const long L = (long)i * G + c; if (L >= nwg) return false;
        int wgid = (int)L; { const int q = nwg / NXCD, r = nwg % NXCD, xcd = wgid % NXCD, off = wgid / NXCD; wgid = (xcd < r ? xcd * (q + 1) : r * (q + 1) + (xcd - r) * q) + off; }
        const int nig = WGM * nN, gid = wgid / nig, fm = gid * WGM, gsz = (nM - fm) < WGM ? (nM - fm) : WGM;
        u.pm = fm + ((wgid % nig) % gsz); u.pn = (wgid % nig) / gsz; return true;
    }
    __device__ __forceinline__ void a_ready(const Unit&) const {}
    __device__ __forceinline__ void done(const Unit&) const {}
};
__device__ __forceinline__ unsigned cvt_pk_bf16(float lo, float hi) { unsigned r; asm volatile("v_cvt_pk_bf16_f32 %0, %1, %2" : "=v"(r) : "v"(lo), "v"(hi)); return r; }
template <class Epi, class Sched, bool STAMP = false>
__device__ __forceinline__ void gemm_phase(PG8_LAS unsigned char* lds, const Gemm g, const Sched& S, const Epi& E, unsigned long long* stamps) {
    const int tid = threadIdx.x, wid = __builtin_amdgcn_readfirstlane(tid >> 6), lane = tid & 63, wr = wid >> 2, wc = wid & 3, fr = lane & 15, fq = lane >> 4;
    const int K = g.K, nt = K / BK;
    int ts_lo = 0, ts_hi = 0, nts = 0; const unsigned long long rt_entry = STAMP ? (unsigned long long)wall_clock64() : 0ull;
#define PG8_STAMP() do { if (STAMP && wid == 0 && nts < 64) { const unsigned long long _c = (unsigned long long)clock64(); \
        ts_lo = (lane == nts) ? (int)(unsigned)_c : ts_lo; ts_hi = (lane == nts) ? (int)(unsigned)(_c >> 32) : ts_hi; ++nts; } } while (0)
    PG8_STAMP();
    unsigned voffA[2], voffB[2];
#pragma unroll
    for (int i = 0; i < 2; ++i) { int R, C; stage_rc(tid * 16 + i * 8192, R, C); const int Rb = Epi::PERM ? ((R & ~31) + perm32(R & 31)) : R;
        voffA[i] = (unsigned)(R * K + C) * 2u; voffB[i] = (unsigned)(Rb * K + C) * 2u; }
    const size_t kstep = (size_t)(BK * 2);
    const size_t hstep = (size_t)HALF * K * 2;
    const size_t tstep = 2 * hstep;
    const unsigned ldsw = (unsigned)wid * 1024u;
    const int aoff = lds_byte(wr * 64 + fr, fq * 8), boff = lds_byte(wc * 32 + fr, fq * 8);
#define PG8_SA(b, h) (((b) * 2 + (h)) * HTB)
#define PG8_SB(b, h) ((4 + (b) * 2 + (h)) * HTB)
#define PG8_STAGE(bufoff, gbase, voff) do { _Pragma("unroll") for (int _i = 0; _i < 2; ++_i) \
        __builtin_amdgcn_global_load_lds((const unsigned*)((const char*)(gbase) + (voff)[_i]), (PG8_LAS unsigned*)(lds + (bufoff) + ldsw + _i * 8192), 16, 0, 0); } while (0)
#define PG8_LDA(dst, b, h) do { _Pragma("unroll") for (int m = 0; m < 4; ++m) _Pragma("unroll") for (int k = 0; k < 2; ++k) dst[m][k] = *(const PG8_LAS bf16x8*)(lds + PG8_SA(b, h) + aoff + m * 2048 + k * 1024); } while (0)
#define PG8_LDB(dst, b, h) do { _Pragma("unroll") for (int n = 0; n < 2; ++n) _Pragma("unroll") for (int k = 0; k < 2; ++k) dst[n][k] = *(const PG8_LAS bf16x8*)(lds + PG8_SB(b, h) + boff + n * 2048 + k * 1024); } while (0)
#define PG8_MMA(ai, bj, At, Bt) do { __builtin_amdgcn_s_setprio(1); _Pragma("unroll") for (int m = 0; m < 4; ++m) _Pragma("unroll") for (int n = 0; n < 2; ++n) _Pragma("unroll") for (int k = 0; k < 2; ++k) \
        acc[ai][bj][m][n] = __builtin_amdgcn_mfma_f32_16x16x32_bf16(Bt[n][k], At[m][k], acc[ai][bj][m][n], 0, 0, 0); __builtin_amdgcn_s_setprio(0); } while (0)
#define PG8_WAIT_V(n) asm volatile("s_waitcnt vmcnt(" #n ")" ::: "memory")
#define PG8_WAIT_L(n) asm volatile("s_waitcnt lgkmcnt(" #n ")" ::: "memory")
#define PG8_BAR __builtin_amdgcn_s_barrier()
#define PG8_SCHED __builtin_amdgcn_sched_barrier(0)
    Unit cur, nxt; int ui = 0;
    if (!S.next(0, cur)) return;
    f32x4 acc[2][2][4][2];
#pragma unroll
    for (int a = 0; a < 2; ++a)
#pragma unroll
        for (int b = 0; b < 2; ++b)
#pragma unroll
            for (int m = 0; m < 4; ++m)
#pragma unroll
                for (int n = 0; n < 2; ++n) acc[a][b][m][n] = (f32x4){0.f, 0.f, 0.f, 0.f};
    bf16x8 At[4][2], B0[2][2], B1[2][2];
    const char* cA = (const char*)g.A + (size_t)cur.pm * tstep; const char* cB = (const char*)g.Bt + (size_t)cur.pn * tstep;
    S.a_ready(cur);
    PG8_STAGE(PG8_SB(0, 0), cB, voffB); PG8_STAGE(PG8_SA(0, 0), cA, voffA); PG8_STAGE(PG8_SB(0, 1), cB + hstep, voffB); PG8_STAGE(PG8_SA(0, 1), cA + hstep, voffA);
    if (wr == 1) PG8_BAR;
    PG8_WAIT_V(4); PG8_BAR;
    PG8_STAGE(PG8_SB(1, 0), cB + kstep, voffB); PG8_STAGE(PG8_SA(1, 0), cA + kstep, voffA); PG8_STAGE(PG8_SB(1, 1), cB + hstep + kstep, voffB);
    PG8_WAIT_V(6); PG8_BAR;
    PG8_STAMP();
    for (;;) {
        const bool has_next = S.next(ui + 1, nxt);
        const char* nA = has_next ? (const char*)g.A + (size_t)nxt.pm * tstep : cA; const char* nB = has_next ? (const char*)g.Bt + (size_t)nxt.pn * tstep : cB;
        for (int t = 0; t < nt; t += 2) {
            const bool last = (t == nt - 2);
            const char* a1 = cA + (size_t)(t + 1) * kstep;
            const char* a2 = last ? nA : cA + (size_t)(t + 2) * kstep; const char* b2 = last ? nB : cB + (size_t)(t + 2) * kstep;
            const char* a3 = a2 + kstep; const char* b3 = b2 + kstep;
            if (last && has_next) S.a_ready(nxt);
            PG8_LDB(B0, 0, 0); PG8_SCHED; PG8_LDA(At, 0, 0); PG8_STAGE(PG8_SA(1, 1), a1 + hstep, voffA);
            PG8_WAIT_L(8); PG8_BAR; PG8_WAIT_L(0); PG8_MMA(0, 0, At, B0); PG8_BAR; PG8_SCHED;
            PG8_LDB(B1, 0, 1); PG8_STAGE(PG8_SB(0, 0), b2, voffB);
            PG8_BAR; PG8_WAIT_L(0); PG8_MMA(0, 1, At, B1); PG8_BAR;
            PG8_LDA(At, 0, 1); PG8_STAGE(PG8_SA(0, 0), a2, voffA);
            PG8_BAR; PG8_WAIT_L(0); PG8_MMA(1, 0, At, B0); PG8_BAR; PG8_SCHED;
            PG8_STAGE(PG8_SB(0, 1), b2 + hstep, voffB);
            PG8_WAIT_V(6); PG8_BAR; PG8_MMA(1, 1, At, B1); PG8_BAR;
            PG8_LDB(B0, 1, 0); PG8_SCHED; PG8_LDA(At, 1, 0); PG8_STAGE(PG8_SA(0, 1), a2 + hstep, voffA);
            PG8_WAIT_L(8); PG8_BAR; PG8_WAIT_L(0); PG8_MMA(0, 0, At, B0); PG8_BAR; PG8_SCHED;
            PG8_LDB(B1, 1, 1); PG8_STAGE(PG8_SB(1, 0), b3, voffB);
            PG8_BAR; PG8_WAIT_L(0); PG8_MMA(0, 1, At, B1); PG8_BAR;
            PG8_LDA(At, 1, 1); PG8_STAGE(PG8_SA(1, 0), a3, voffA);
            PG8_BAR; PG8_WAIT_L(0); PG8_MMA(1, 0, At, B0); PG8_BAR; PG8_SCHED;
            PG8_STAGE(PG8_SB(1, 1), b3 + hstep, voffB);
            PG8_WAIT_V(6); PG8_BAR; PG8_MMA(1, 1, At, B1); PG8_BAR;
        }
        PG8_STAMP();
        if constexpr (!Epi::AFTER_DRAIN) { E(acc, cur, wr, wc, fr, fq); S.done(cur); }
        PG8_STAMP();
        if (!has_next) break;
#pragma unroll
        for (int a = 0; a < 2; ++a)
#pragma unroll
            for (int b = 0; b < 2; ++b)
#pragma unroll
                for (int m = 0; m < 4; ++m)
#pragma unroll
                    for (int n = 0; n < 2; ++n) acc[a][b][m][n] = (f32x4){0.f, 0.f, 0.f, 0.f};
        cur = nxt; cA = nA; cB = nB; ++ui;
    }
    PG8_WAIT_V(0);
    if (wr == 0) PG8_BAR;
    PG8_BAR;
    if constexpr (Epi::AFTER_DRAIN) { E.fused(acc, cur, wr, wc, fr, fq, lds, wid, lane); S.done(cur); }
    PG8_STAMP();
    if (STAMP && wid == 0) { stamps[lane] = lane < nts ? (((unsigned long long)(unsigned)ts_hi << 32) | (unsigned)ts_lo) : 0ull;
        if (lane == 62) stamps[62] = rt_entry; if (lane == 63) stamps[63] = (unsigned long long)wall_clock64(); }
#undef PG8_STAMP
#undef PG8_SA
#undef PG8_SB
#undef PG8_STAGE
#undef PG8_LDA
#undef PG8_LDB
#undef PG8_MMA
#undef PG8_WAIT_V
#undef PG8_WAIT_L
#undef PG8_BAR
#undef PG8_SCHED
}
}
using pg8::bf16_t; using pg8::bf16x8; using pg8::f32x4; using pg8::u32x4;
typedef float f32x16 __attribute__((ext_vector_type(16)));
typedef short s16x4 __attribute__((ext_vector_type(4)));
typedef unsigned u32x2 __attribute__((ext_vector_type(2)));
#define DI __device__ __forceinline__
#define LAS __attribute__((address_space(3)))
typedef LAS unsigned char* ldsp;
#define MFMA32(a, b, c) __builtin_amdgcn_mfma_f32_32x32x16_bf16((a), (b), (c), 0, 0, 0)

#ifndef MULTI_LAUNCH
#define MULTI_LAUNCH 1
#endif

constexpr int DM = 1024, MP = 16384, MS = 32, MT = MP + MS, SEQ = 4096;
constexpr int NIE = 2560, DFF = 2816, F2 = 5632;
constexpr int NPH = 21;
constexpr int LDS_BYTES = 131072;

constexpr size_t al256(size_t x) { return (x + 255) & ~(size_t)255; }
constexpr size_t O_WT_IN_E = 0;
constexpr size_t O_WT_OUT_E = O_WT_IN_E + al256((size_t)NIE * DM * 2);
constexpr size_t O_WT_IN_O = O_WT_OUT_E + al256((size_t)DM * DM * 2);
constexpr size_t O_WT_OUT_O = O_WT_IN_O + al256((size_t)2048 * DM * 2);
constexpr size_t O_WT_UP = O_WT_OUT_O + al256((size_t)DM * DM * 2);
constexpr size_t SZ_WT_UP = (size_t)F2 * DM * 2;
constexpr size_t O_WT_DN = O_WT_UP + 2 * SZ_WT_UP;
constexpr size_t SZ_WT_DN = (size_t)DM * DFF * 2;
constexpr size_t O_WT_GA = O_WT_DN + 2 * SZ_WT_DN;
constexpr size_t O_WS_TRIL = O_WT_GA + (size_t)8 * 256 * 128 * 2;
constexpr size_t O_MOD = O_WS_TRIL + (size_t)4 * 128 * 128 * 2;
constexpr size_t O_X = O_MOD + al256((size_t)2 * 36 * 6144 * 4);
constexpr size_t O_H = O_X + (size_t)MT * DM * 4;
constexpr size_t O_AO = O_H + (size_t)MT * DM * 2;
constexpr size_t O_AGG = O_AO + (size_t)MT * DM * 2;
constexpr size_t O_BIG = O_AGG + (size_t)2 * 4 * 64 * 1024 * 4;
constexpr size_t O_Z = O_BIG;
constexpr size_t O_OP = O_Z + al256((size_t)MT * NIE * 2);
constexpr size_t O_LSE = O_OP + (size_t)3 * MP * 512 * 2;
constexpr size_t O_UP = O_BIG;
constexpr size_t O_ACT = O_UP + al256((size_t)MT * F2 * 2);
constexpr size_t O_ZO = O_BIG;
constexpr size_t O_AA = O_ZO + al256((size_t)MT * 2048 * 2);
constexpr size_t O_BB = O_AA + (size_t)MP * DM * 4;
constexpr size_t WS_NEED = O_ACT + (size_t)MT * DFF * 2;

constexpr size_t OUT_Y_P = 0;
constexpr size_t OUT_Y_S = OUT_Y_P + (size_t)MP * DM;
constexpr size_t OUT_WK_P = OUT_Y_S + (size_t)MS * DM;
constexpr size_t OUT_WV_P = OUT_WK_P + (size_t)4 * 2048 * 512;
constexpr size_t OUT_RC_P = OUT_WV_P + (size_t)4 * 2048 * 512;
constexpr size_t OUT_RH_P = OUT_RC_P + (size_t)4 * 3 * 1024;
constexpr size_t OUT_FC_P = OUT_RH_P + (size_t)4 * 1024;
constexpr size_t OUT_CV_S = OUT_FC_P + (size_t)2 * 4 * 2 * F2;
constexpr size_t OUT_WK_S = OUT_CV_S + (size_t)32 * 512;
constexpr size_t OUT_WV_S = OUT_WK_S + (size_t)32 * 2048 * 512;
constexpr size_t OUT_RC_S = OUT_WV_S + (size_t)32 * 2048 * 512;
constexpr size_t OUT_RH_S = OUT_RC_S + (size_t)32 * 3 * 1024;
constexpr size_t OUT_FC_S = OUT_RH_S + (size_t)32 * 1024;
constexpr size_t OUT_TOTAL = OUT_FC_S + (size_t)2 * 32 * 2 * F2;

enum { I_XP = 0, I_XS, I_CK, I_CV, I_SRC, I_SRH, I_SFC, I_CP, I_CS, I_WADA, I_BADA, I_WINE, I_LNG, I_LNB, I_WSGU, I_BSGU, I_WOUTE,
       I_WINO, I_RCW, I_RCB, I_RWA, I_RBA, I_RWX, I_RBX, I_RLAM, I_WOUTO, I_FUP, I_FCW, I_FCB, I_FDN, I_FING, N_IN };

struct Params { const float* in[N_IN]; float* out; unsigned char* ws; };

DI float bf2f(bf16_t b) { return __uint_as_float(((unsigned)b) << 16); }
DI float bfs2f(short b) { return __uint_as_float(((unsigned)(unsigned short)b) << 16); }
DI unsigned pk2(float lo, float hi) { return pg8::cvt_pk_bf16(lo, hi); }
DI bf16_t f2bf(float f) { return (bf16_t)(pk2(f, 0.f) & 0xffffu); }
DI float wave_sum(float v) {
#pragma unroll
    for (int o = 1; o < 64; o <<= 1) v += __shfl_xor(v, o);
    return v;
}
DI float wave_max(float v) {
#pragma unroll
    for (int o = 1; o < 64; o <<= 1) v = fmaxf(v, __shfl_xor(v, o));
    return v;
}
DI float gelu_tanh(float x) {
    const float u = 0.7978845608028654f * (x + 0.044715f * x * x * x);
    return x / (1.f + __expf(-2.f * u));
}
DI float sigmoidf(float x) { return 1.f / (1.f + __expf(-x)); }
DI int crow(int reg, int hf) { return (reg & 3) + 8 * (reg >> 2) + 4 * hf; }
DI int bidx_of(int row) { return row < MP ? (row >> 12) : 4 + (row - MP); }
DI void store_bf16x4(bf16_t* p, f32x4 v) { u32x2 o; o.x = pk2(v.x, v.y); o.y = pk2(v.z, v.w); *(u32x2*)p = o; }
DI bf16x8 pack_step(const f32x16& x, int s) {
    u32x4 p;
    p.x = pk2(x[8 * s + 0], x[8 * s + 1]); p.y = pk2(x[8 * s + 2], x[8 * s + 3]); p.z = pk2(x[8 * s + 4], x[8 * s + 5]); p.w = pk2(x[8 * s + 6], x[8 * s + 7]);
    return __builtin_bit_cast(bf16x8, p);
}
DI s16x4 tr_read(unsigned lds_addr) { s16x4 r; asm volatile("ds_read_b64_tr_b16 %0, %1\n\ts_waitcnt lgkmcnt(0)" : "=&v"(r) : "v"(lds_addr) : "memory"); return r; }

DI void transpose_tile(const float* __restrict__ src, int K, int N, bf16_t* dst, int item, ldsp lds) {
    LAS float* scr = (LAS float*)lds;
    const int nb = N >> 6, kb = item / nb, nbi = item - kb * nb, k0 = kb * 64, n0 = nbi * 64, tid = threadIdx.x;
#pragma unroll
    for (int i = 0; i < 8; ++i) { const int idx = tid + 512 * i, r = idx >> 6, c = idx & 63; scr[r * 65 + c] = src[(size_t)(k0 + r) * N + n0 + c]; }
    __syncthreads();
    const int n = tid >> 3, kc = (tid & 7) * 8;
    u32x4 o;
    o.x = pk2(scr[(kc + 0) * 65 + n], scr[(kc + 1) * 65 + n]); o.y = pk2(scr[(kc + 2) * 65 + n], scr[(kc + 3) * 65 + n]);
    o.z = pk2(scr[(kc + 4) * 65 + n], scr[(kc + 5) * 65 + n]); o.w = pk2(scr[(kc + 6) * 65 + n], scr[(kc + 7) * 65 + n]);
    *(u32x4*)(dst + (size_t)(n0 + n) * K + k0 + kc) = o;
    __syncthreads();
}

DI void adaln_item(const Params& p, int item, ldsp lds) {
    const int l = item / 96, j0 = (item % 96) * 64, tid = threadIdx.x, w = tid >> 6, lane = tid & 63;
    LAS float* s = (LAS float*)lds;
    LAS float* part = (LAS float*)(lds + 18 * 1024 * 4);
    const float* W = p.in[I_WADA] + (size_t)l * 1024 * 6144;
    float* MOD = (float*)(p.ws + O_MOD);
    for (int half = 0; half < 2; ++half) {
        for (int idx = tid; idx < 18 * 1024; idx += 512) {
            const int r = idx >> 10, k = idx & 1023, rr = half * 18 + r;
            const float c = rr < 4 ? p.in[I_CP][rr * 1024 + k] : p.in[I_CS][(rr - 4) * 1024 + k];
            s[idx] = c / (1.f + __expf(-c));
        }
        __syncthreads();
        float acc[18];
#pragma unroll
        for (int r = 0; r < 18; ++r) acc[r] = 0.f;
        const int kbase = w * 128;
        for (int k = 0; k < 128; k += 4) {
            const float* wp = W + (size_t)(kbase + k) * 6144 + j0 + lane;
            const float w0 = wp[0], w1 = wp[6144], w2 = wp[2 * 6144], w3 = wp[3 * 6144];
#pragma unroll
            for (int r = 0; r < 18; ++r) { const f32x4 sv = *(LAS f32x4*)(s + r * 1024 + kbase + k); acc[r] += sv.x * w0 + sv.y * w1 + sv.z * w2 + sv.w * w3; }
        }
#pragma unroll
        for (int r = 0; r < 18; ++r) part[(w * 18 + r) * 64 + lane] = acc[r];
        __syncthreads();
        for (int idx = tid; idx < 18 * 64; idx += 512) {
            const int r = idx >> 6, j = idx & 63; float sum = 0.f;
#pragma unroll
            for (int ww = 0; ww < 8; ++ww) sum += part[(ww * 18 + r) * 64 + j];
            MOD[(size_t)(l * 36 + half * 18 + r) * 6144 + j0 + j] = sum + p.in[I_BADA][l * 6144 + j0 + j];
        }
        __syncthreads();
    }
}

constexpr int P0_ADA = 192;
constexpr int T_INE = 16 * 40, T_OUTE = 256, T_INO = 16 * 32, T_OUTO = 256, T_UP = 16 * 88, T_DN = 44 * 16, T_G = 4;
constexpr int P0_TR = T_INE + T_OUTE + T_INO + T_OUTO + 2 * T_UP + 2 * T_DN + 16 * T_G;
constexpr int P0_TRIL = 4;
constexpr int P0_COPY = 2047;
constexpr int P0_ITEMS = P0_ADA + P0_TR + P0_TRIL + P0_COPY;

DI void phase0(const Params& p, ldsp lds) {
    unsigned char* ws = p.ws;
    for (int it = blockIdx.x; it < P0_ITEMS; it += gridDim.x) {
        int r = it;
        if (r < P0_ADA) { adaln_item(p, r, lds); continue; } r -= P0_ADA;
        if (r < P0_TR) {
            if (r < T_INE) { transpose_tile(p.in[I_WINE], 1024, NIE, (bf16_t*)(ws + O_WT_IN_E), r, lds); continue; } r -= T_INE;
            if (r < T_OUTE) { transpose_tile(p.in[I_WOUTE], 1024, 1024, (bf16_t*)(ws + O_WT_OUT_E), r, lds); continue; } r -= T_OUTE;
            if (r < T_INO) { transpose_tile(p.in[I_WINO], 1024, 2048, (bf16_t*)(ws + O_WT_IN_O), r, lds); continue; } r -= T_INO;
            if (r < T_OUTO) { transpose_tile(p.in[I_WOUTO], 1024, 1024, (bf16_t*)(ws + O_WT_OUT_O), r, lds); continue; } r -= T_OUTO;
            if (r < 2 * T_UP) { const int l = r / T_UP; transpose_tile(p.in[I_FUP] + (size_t)l * 1024 * F2, 1024, F2, (bf16_t*)(ws + O_WT_UP + l * SZ_WT_UP), r - l * T_UP, lds); continue; } r -= 2 * T_UP;
            if (r < 2 * T_DN) { const int l = r / T_DN; transpose_tile(p.in[I_FDN] + (size_t)l * DFF * 1024, DFF, 1024, (bf16_t*)(ws + O_WT_DN + l * SZ_WT_DN), r - l * T_DN, lds); continue; } r -= 2 * T_DN;
            { const int which = r / (8 * T_G), rr = r % (8 * T_G), g = rr / T_G, ti = rr % T_G;
              transpose_tile(p.in[which ? I_RWX : I_RWA] + (size_t)g * 128 * 128, 128, 128, (bf16_t*)(ws + O_WT_GA) + (size_t)(g * 256 + which * 128) * 128, ti, lds); continue; }
        }
        r -= P0_TR;
        if (r < P0_TRIL) {
            bf16_t* dst = (bf16_t*)(ws + O_WS_TRIL) + (size_t)r * 16384; const float* src = p.in[I_WSGU] + (size_t)r * 16384;
            for (int idx = threadIdx.x; idx < 16384; idx += 512) { const int t = idx >> 7, s = idx & 127; dst[idx] = f2bf(s <= t ? src[idx] : 0.f); }
            continue;
        }
        r -= P0_TRIL;
        {
            const size_t PER_B = (size_t)2047 * 128;
#pragma unroll 4
            for (int i = 0; i < 16; ++i) {
                const size_t e = (size_t)r * 8192 + (size_t)i * 512 + threadIdx.x;
                const int which = (int)(e / (32 * PER_B)); const size_t rem = e - (size_t)which * 32 * PER_B; const int b = (int)(rem / PER_B); const size_t q = rem - (size_t)b * PER_B;
                const f32x4* src = (const f32x4*)(p.in[which ? I_CV : I_CK] + (size_t)b * 2048 * 512 + 512) + q;
                f32x4* dst = (f32x4*)(p.out + (which ? OUT_WV_S : OUT_WK_S) + (size_t)b * 2048 * 512) + q;
                *dst = *src;
            }
        }
    }
}

DI void norm_phase(const float* xp, const float* xs, const float* mod, int sh_off, int sc_off, bf16_t* H) {
    const int lane = threadIdx.x & 63, gw = blockIdx.x * 8 + (threadIdx.x >> 6), ngw = gridDim.x * 8;
    for (int row = gw; row < MT; row += ngw) {
        const float* src = row < MP ? xp + (size_t)row * DM : xs + (size_t)(row - MP) * DM;
        const float* mrow = mod + (size_t)bidx_of(row) * 6144;
        f32x4 v[4]; float ss = 0.f;
#pragma unroll
        for (int j = 0; j < 4; ++j) { v[j] = *((const f32x4*)src + lane + 64 * j); ss += v[j].x * v[j].x + v[j].y * v[j].y + v[j].z * v[j].z + v[j].w * v[j].w; }
        const float rs = rsqrtf(wave_sum(ss) * (1.f / DM) + 1e-6f);
#pragma unroll
        for (int j = 0; j < 4; ++j) {
            const int col = 4 * (lane + 64 * j);
            const f32x4 sc = *(const f32x4*)(mrow + sc_off + col), sh = *(const f32x4*)(mrow + sh_off + col);
            f32x4 h; h.x = v[j].x * rs * (1.f + sc.x) + sh.x; h.y = v[j].y * rs * (1.f + sc.y) + sh.y; h.z = v[j].z * rs * (1.f + sc.z) + sh.z; h.w = v[j].w * rs * (1.f + sc.w) + sh.w;
            store_bf16x4(H + (size_t)row * DM + col, h);
        }
    }
}
DI void final_norm_phase(const float* X, const float* g, float* yp, float* ys) {
    const int lane = threadIdx.x & 63, gw = blockIdx.x * 8 + (threadIdx.x >> 6), ngw = gridDim.x * 8;
    for (int row = gw; row < MT; row += ngw) {
        const float* src = X + (size_t)row * DM; float* dst = row < MP ? yp + (size_t)row * DM : ys + (size_t)(row - MP) * DM;
        f32x4 v[4]; float ss = 0.f;
#pragma unroll
        for (int j = 0; j < 4; ++j) { v[j] = *((const f32x4*)src + lane + 64 * j); ss += v[j].x * v[j].x + v[j].y * v[j].y + v[j].z * v[j].z + v[j].w * v[j].w; }
        const float rs = rsqrtf(wave_sum(ss) * (1.f / DM) + 1e-6f);
#pragma unroll
        for (int j = 0; j < 4; ++j) { const f32x4 gg = *((const f32x4*)g + lane + 64 * j); *((f32x4*)dst + lane + 64 * j) = v[j] * rs * gg; }
    }
}

template <class Q> struct EpiWrap {
    static constexpr bool PERM = false, AFTER_DRAIN = false;
    Q q;
    DI void operator()(const f32x4 (&acc)[2][2][4][2], const pg8::Unit& u, int wr, int wc, int fr, int fq) const {
#pragma unroll
        for (int ai = 0; ai < 2; ++ai)
#pragma unroll
            for (int m = 0; m < 4; ++m) {
                const int row = u.pm * 256 + ai * 128 + wr * 64 + m * 16 + fr;
#pragma unroll
                for (int bj = 0; bj < 2; ++bj)
#pragma unroll
                    for (int n = 0; n < 2; ++n) q.quad(row, u.pn * 256 + bj * 128 + wc * 32 + n * 16 + 4 * fq, acc[ai][bj][m][n]);
            }
    }
};

template <class Q> DI void sample_tail(const bf16_t* As, const bf16_t* Bt, int N, int K, const Q& q) {
    const int wave = threadIdx.x >> 6, lane = threadIdx.x & 63, nch = K >> 3;
    for (int qd = blockIdx.x; qd < (N >> 2); qd += gridDim.x) {
        float s[4][4];
#pragma unroll
        for (int r = 0; r < 4; ++r)
#pragma unroll
            for (int c = 0; c < 4; ++c) s[r][c] = 0.f;
        for (int ch = lane; ch < nch; ch += 64) {
            bf16x8 a[4], w[4];
#pragma unroll
            for (int r = 0; r < 4; ++r) a[r] = *(const bf16x8*)(As + (size_t)(4 * wave + r) * K + ch * 8);
#pragma unroll
            for (int c = 0; c < 4; ++c) w[c] = *(const bf16x8*)(Bt + (size_t)(4 * qd + c) * K + ch * 8);
#pragma unroll
            for (int j = 0; j < 8; ++j) {
                float af[4], wf[4];
#pragma unroll
                for (int r = 0; r < 4; ++r) af[r] = bfs2f(a[r][j]);
#pragma unroll
                for (int c = 0; c < 4; ++c) wf[c] = bfs2f(w[c][j]);
#pragma unroll
                for (int r = 0; r < 4; ++r)
#pragma unroll
                    for (int c = 0; c < 4; ++c) s[r][c] += af[r] * wf[c];
            }
        }
#pragma unroll
        for (int r = 0; r < 4; ++r)
#pragma unroll
            for (int c = 0; c < 4; ++c) s[r][c] = wave_sum(s[r][c]);
        f32x4 v;
        v.x = lane == 0 ? s[0][0] : lane == 1 ? s[1][0] : lane == 2 ? s[2][0] : s[3][0];
        v.y = lane == 0 ? s[0][1] : lane == 1 ? s[1][1] : lane == 2 ? s[2][1] : s[3][1];
        v.z = lane == 0 ? s[0][2] : lane == 1 ? s[1][2] : lane == 2 ? s[2][2] : s[3][2];
        v.w = lane == 0 ? s[0][3] : lane == 1 ? s[1][3] : lane == 2 ? s[2][3] : s[3][3];
        if (lane < 4) q.quad(MP + 4 * wave + lane, 4 * qd, v);
    }
}

template <class Q> DI void gemm_all(ldsp lds, const bf16_t* A, const bf16_t* Bt, int N, int K, const Q& q) {
    pg8::Gemm g{A, Bt, MP, N, K};
    pg8::StaticOrder S; S.init(MP, N, (int)gridDim.x, (int)blockIdx.x);
    EpiWrap<Q> E{q};
    pg8::gemm_phase<EpiWrap<Q>, pg8::StaticOrder, false>(lds, g, S, E, nullptr);
    sample_tail(A + (size_t)MP * K, Bt, N, K, q);
}

struct QInE {
    bf16_t* Z;
    DI void quad(int row, int col, f32x4 v) const {
        if (col < 1024) { v.x = gelu_tanh(v.x); v.y = gelu_tanh(v.y); v.z = gelu_tanh(v.z); v.w = gelu_tanh(v.w); }
        store_bf16x4(Z + (size_t)row * NIE + col, v);
    }
};
struct QRes {
    const float *rp, *rs; float* X; const float* g;
    DI void quad(int row, int col, f32x4 v) const {
        const float* r = row < MP ? rp + (size_t)row * DM : rs + (size_t)(row - MP) * DM;
        const f32x4 x = *(const f32x4*)(r + col), gg = *(const f32x4*)(g + (size_t)bidx_of(row) * 6144 + col);
        *(f32x4*)(X + (size_t)row * DM + col) = x + gg * v;
    }
};
struct QUp {
    bf16_t* UP;
    DI void quad(int row, int col, f32x4 v) const { store_bf16x4(UP + (size_t)row * F2 + col, v); }
};
struct QInO {
    bf16_t* ZO;
    DI void quad(int row, int col, f32x4 v) const {
        if (col < 1024) { v.x = gelu_tanh(v.x); v.y = gelu_tanh(v.y); v.z = gelu_tanh(v.z); v.w = gelu_tanh(v.w); }
        store_bf16x4(ZO + (size_t)row * 2048 + col, v);
    }
};

constexpr float SC_LOG2E = 0.125f * 1.4426950408889634f;
DI void attn_item(const bf16_t* Z, bf16_t* OP, float* LSE, int item, ldsp lds) {
    const int pat = item >> 9, rem = item & 511, b = rem >> 7, hd = (rem >> 4) & 7, blk = rem & 15;
    const int d = pat == 0 ? 1 : (pat == 1 ? 4 : 16);
    const int r = pat == 0 ? 0 : (pat == 1 ? (blk >> 2) : blk), mblk = pat == 0 ? blk : (pat == 1 ? (blk & 3) : 0);
    const int w = threadIdx.x >> 6, lane = threadIdx.x & 63, ql = lane & 31, hf = lane >> 5;
    const int m0 = mblk * 256 + 32 * w;
    const bf16_t* Zb = Z + (size_t)(b * SEQ + r) * NIE;
    const size_t vs = (size_t)d * NIE;
    bf16x8 qf[4];
    { const bf16_t* qrow = Zb + (size_t)(m0 + ql) * vs + 1024 + hd * 64 + 8 * hf;
#pragma unroll
      for (int s = 0; s < 4; ++s) qf[s] = *(const bf16x8*)(qrow + 16 * s); }
    f32x16 o0, o1;
#pragma unroll
    for (int i = 0; i < 16; ++i) { o0[i] = 0.f; o1[i] = 0.f; }
    float mrun = -1e30f, lrun = 0.f;
    ldsp vimg = lds + w * 4608;
    const unsigned vaddr = (unsigned)(size_t)vimg;
    const int i16 = lane & 15, tq = i16 >> 2, tp = i16 & 3, tb = (lane >> 4) & 1;
    const int mq = m0 + ql;
    for (int jt = 0; jt < 5; ++jt) {
        const int kt0 = m0 - 128 + 32 * jt;
        if (kt0 < 0) continue;
        bf16x8 kf[4];
        { const bf16_t* krow = Zb + (size_t)(kt0 + ql) * vs + 1536 + hd * 64 + 8 * hf;
#pragma unroll
          for (int s = 0; s < 4; ++s) kf[s] = *(const bf16x8*)(krow + 16 * s); }
        u32x4 vt[4];
#pragma unroll
        for (int i = 0; i < 4; ++i) vt[i] = *(const u32x4*)(Zb + (size_t)(kt0 + 8 * i + (lane >> 3)) * vs + 2048 + hd * 64 + (lane & 7) * 8);
        f32x16 st;
#pragma unroll
        for (int i = 0; i < 16; ++i) st[i] = 0.f;
#pragma unroll
        for (int s = 0; s < 4; ++s) st = MFMA32(kf[s], qf[s], st);
        float mx = -1e30f;
#pragma unroll
        for (int i = 0; i < 16; ++i) {
            const int dist = mq - (kt0 + crow(i, hf));
            const float sv = (dist >= 0 && dist <= 128) ? st[i] * SC_LOG2E : -1e30f;
            st[i] = sv; mx = fmaxf(mx, sv);
        }
        mx = fmaxf(mx, __shfl_xor(mx, 32));
        const float mnew = fmaxf(mrun, mx), alpha = exp2f(mrun - mnew);
        mrun = mnew;
        float psum = 0.f;
#pragma unroll
        for (int i = 0; i < 16; ++i) { const float pv = exp2f(st[i] - mnew); st[i] = pv; psum += pv; }
        lrun = lrun * alpha + psum;
#pragma unroll
        for (int i = 0; i < 16; ++i) { o0[i] *= alpha; o1[i] *= alpha; }
#pragma unroll
        for (int i = 0; i < 4; ++i) *(LAS u32x4*)(vimg + (8 * i + (lane >> 3)) * 144 + (lane & 7) * 16) = vt[i];
        asm volatile("s_waitcnt lgkmcnt(0)" ::: "memory");
        const bf16x8 pf0 = pack_step(st, 0), pf1 = pack_step(st, 1);
#pragma unroll
        for (int dt = 0; dt < 2; ++dt) {
#pragma unroll
            for (int s = 0; s < 2; ++s) {
                const s16x4 lo = tr_read(vaddr + (16 * s + 4 * hf + tq) * 144 + (2 * dt + tb) * 32 + 8 * tp);
                const s16x4 hi = tr_read(vaddr + (16 * s + 8 + 4 * hf + tq) * 144 + (2 * dt + tb) * 32 + 8 * tp);
                const bf16x8 vf = __builtin_shufflevector(lo, hi, 0, 1, 2, 3, 4, 5, 6, 7);
                if (dt == 0) o0 = MFMA32(vf, s == 0 ? pf0 : pf1, o0); else o1 = MFMA32(vf, s == 0 ? pf0 : pf1, o1);
            }
        }
    }
    lrun += __shfl_xor(lrun, 32);
    const float inv = 1.f / lrun;
    const size_t token = (size_t)b * SEQ + r + (size_t)d * mq;
    bf16_t* op = OP + ((size_t)pat * MP + token) * 512 + hd * 64;
#pragma unroll
    for (int g4 = 0; g4 < 4; ++g4) {
        f32x4 a, c;
        a.x = o0[4 * g4] * inv; a.y = o0[4 * g4 + 1] * inv; a.z = o0[4 * g4 + 2] * inv; a.w = o0[4 * g4 + 3] * inv;
        c.x = o1[4 * g4] * inv; c.y = o1[4 * g4 + 1] * inv; c.z = o1[4 * g4 + 2] * inv; c.w = o1[4 * g4 + 3] * inv;
        store_bf16x4(op + 8 * g4 + 4 * hf, a);
        store_bf16x4(op + 32 + 8 * g4 + 4 * hf, c);
    }
    if (hf == 0) LSE[((size_t)pat * MP + token) * 8 + hd] = mrun * 0.6931471805599453f + __logf(lrun);
}

DI void sgu_item(const Params& p, const bf16_t* Z, bf16_t* AO, int item, ldsp lds) {
    const int b = item >> 7, c = (item >> 2) & 31, g = item & 3, tid = threadIdx.x;
    const int row0 = b * SEQ + c * 128;
    LAS float* stat = (LAS float*)(lds + 128 * 272);
    {
        const int row = tid >> 2, part = tid & 3;
        const bf16_t* ptr = Z + (size_t)(row0 + row) * NIE + 512 + part * 128;
        float s = 0.f, ss = 0.f;
#pragma unroll 4
        for (int i = 0; i < 16; ++i) { const bf16x8 v = *(const bf16x8*)(ptr + 8 * i);
#pragma unroll
            for (int j = 0; j < 8; ++j) { const float f = bfs2f(v[j]); s += f; ss += f * f; } }
        s += __shfl_xor(s, 1); s += __shfl_xor(s, 2); ss += __shfl_xor(ss, 1); ss += __shfl_xor(ss, 2);
        const float mu = s * (1.f / 512.f), var = fmaxf(ss * (1.f / 512.f) - mu * mu, 0.f);
        if (part == 0) { stat[row * 2] = mu; stat[row * 2 + 1] = rsqrtf(var + 1e-6f); }
    }
    __syncthreads();
    {
        const int st = tid >> 2, dch = tid & 3;
        const float mu = stat[st * 2], rstd = stat[st * 2 + 1];
        const float* lg = p.in[I_LNG] + g * 128; const float* lb = p.in[I_LNB] + g * 128;
#pragma unroll
        for (int i = 0; i < 4; ++i) {
            const int d0 = dch * 32 + i * 8;
            const bf16x8 v = *(const bf16x8*)(Z + (size_t)(row0 + st) * NIE + 512 + g * 128 + d0);
#pragma unroll
            for (int j = 0; j < 8; ++j) { const float val = (bfs2f(v[j]) - mu) * rstd * lg[d0 + j] + lb[d0 + j]; *(LAS bf16_t*)(lds + (d0 + j) * 272 + st * 2) = f2bf(val); }
        }
    }
    __syncthreads();
    const int w = tid >> 6, lane = tid & 63, ql = lane & 31, hf = lane >> 5, tt = w >> 1, dp = w & 1;
    f32x16 c0, c1;
#pragma unroll
    for (int i = 0; i < 16; ++i) { c0[i] = 0.f; c1[i] = 0.f; }
    const bf16_t* WS = (const bf16_t*)(p.ws + O_WS_TRIL) + (size_t)(g * 128 + 32 * tt + ql) * 128 + 8 * hf;
    const int nks = 2 * tt + 2;
    for (int ks = 0; ks < nks; ++ks) {
        const bf16x8 a = *(const bf16x8*)(WS + 16 * ks);
        const bf16x8 b0 = *(LAS bf16x8*)(lds + (64 * dp + ql) * 272 + (16 * ks + 8 * hf) * 2);
        const bf16x8 b1 = *(LAS bf16x8*)(lds + (64 * dp + 32 + ql) * 272 + (16 * ks + 8 * hf) * 2);
        c0 = MFMA32(a, b0, c0); c1 = MFMA32(a, b1, c1);
    }
    const float* bs = p.in[I_BSGU] + g * 128;
#pragma unroll
    for (int i = 0; i < 16; ++i) {
        const int t = 32 * tt + crow(i, hf); const float bias = bs[t];
        const int dd0 = g * 128 + 64 * dp + ql;
        const size_t zr = (size_t)(row0 + t) * NIE, ar = (size_t)(row0 + t) * DM;
        AO[ar + dd0] = f2bf(bf2f(Z[zr + dd0]) * (c0[i] + bias));
        AO[ar + dd0 + 32] = f2bf(bf2f(Z[zr + dd0 + 32]) * (c1[i] + bias));
    }
    __syncthreads();
}

DI void sgu_sample_item(const Params& p, const bf16_t* Z, bf16_t* AO) {
    const int tid = threadIdx.x, row = tid >> 4, part = tid & 15;
    const bf16_t* zr = Z + (size_t)(MP + row) * NIE;
    float vals[32]; float s = 0.f, ss = 0.f;
#pragma unroll
    for (int i = 0; i < 4; ++i) { const bf16x8 v = *(const bf16x8*)(zr + 512 + part * 32 + 8 * i);
#pragma unroll
        for (int j = 0; j < 8; ++j) { const float f = bfs2f(v[j]); vals[8 * i + j] = f; s += f; ss += f * f; } }
#pragma unroll
    for (int o = 1; o < 16; o <<= 1) { s += __shfl_xor(s, o); ss += __shfl_xor(ss, o); }
    const float mu = s * (1.f / 512.f), rstd = rsqrtf(fmaxf(ss * (1.f / 512.f) - mu * mu, 0.f) + 1e-6f);
    const int g = part >> 2;
    const float w00 = p.in[I_WSGU][(size_t)g * 16384], b0 = p.in[I_BSGU][g * 128];
#pragma unroll
    for (int i = 0; i < 32; ++i) {
        const int c = part * 32 + i;
        const float vl = (vals[i] - mu) * rstd * p.in[I_LNG][c] + p.in[I_LNB][c];
        p.out[OUT_CV_S + (size_t)row * 512 + c] = vl;
        AO[(size_t)(MP + row) * DM + c] = f2bf(bf2f(zr[c]) * (w00 * vl + b0));
    }
}

DI void attn_sample_item(const Params& p, const bf16_t* Z, bf16_t* AO, int item, ldsp lds) {
    const int bs = item >> 3, hd = item & 7, tid = threadIdx.x, wave = tid >> 6, lane = tid & 63;
    LAS float* qv = (LAS float*)lds; LAS float* sc = qv + 64; LAS float* red = sc + 512;
    if (tid < 64) qv[tid] = bf2f(Z[(size_t)(MP + bs) * NIE + 1024 + hd * 64 + tid]);
    __syncthreads();
    const float* ck = p.in[I_CK] + (size_t)bs * 2048 * 512 + hd * 64;
    const float* cv = p.in[I_CV] + (size_t)bs * 2048 * 512 + hd * 64;
    const bf16_t* zs = Z + (size_t)(MP + bs) * NIE + hd * 64;
    if (tid < 387) {
        const int pat = tid / 129, j = tid - pat * 129, d = pat == 0 ? 1 : (pat == 1 ? 4 : 16);
        float dot = 0.f;
        if (j > 0) { const f32x4* kr = (const f32x4*)(ck + (size_t)(2048 - j * d) * 512);
#pragma unroll
            for (int i = 0; i < 16; ++i) { const f32x4 kk = kr[i]; dot += kk.x * qv[4 * i] + kk.y * qv[4 * i + 1] + kk.z * qv[4 * i + 2] + kk.w * qv[4 * i + 3]; } }
        else {
#pragma unroll 8
            for (int i = 0; i < 64; ++i) dot += bf2f(zs[1536 + i]) * qv[i]; }
        sc[tid] = dot * 0.125f;
    }
    __syncthreads();
    float mx = -1e30f;
    for (int i = lane; i < 387; i += 64) mx = fmaxf(mx, sc[i]);
    mx = wave_max(mx);
    float sum = 0.f;
    for (int i = lane; i < 387; i += 64) sum += __expf(sc[i] - mx);
    sum = wave_sum(sum);
    float acc = 0.f;
    for (int i = wave; i < 387; i += 8) {
        const int pat = i / 129, j = i - pat * 129, d = pat == 0 ? 1 : (pat == 1 ? 4 : 16);
        const float vv = j > 0 ? cv[(size_t)(2048 - j * d) * 512 + lane] : bf2f(zs[2048 + lane]);
        acc += __expf(sc[i] - mx) * vv;
    }
    red[wave * 64 + lane] = acc;
    __syncthreads();
    if (tid < 64) { float t = 0.f;
#pragma unroll
        for (int ww = 0; ww < 8; ++ww) t += red[ww * 64 + tid];
        AO[(size_t)(MP + bs) * DM + 512 + hd * 64 + tid] = f2bf(t / sum); }
    __syncthreads();
}

constexpr int P3_ATT = 1536, P3_SGU = 512, P3_SATT = 256;
DI void phase3(const Params& p, ldsp lds) {
    const bf16_t* Z = (const bf16_t*)(p.ws + O_Z); bf16_t* AO = (bf16_t*)(p.ws + O_AO);
    bf16_t* OP = (bf16_t*)(p.ws + O_OP); float* LSE = (float*)(p.ws + O_LSE);
    for (int it = blockIdx.x; it < P3_ATT + P3_SGU + P3_SATT + 1; it += gridDim.x) {
        int r = it;
        if (r < P3_SGU) { sgu_item(p, Z, AO, r, lds); continue; } r -= P3_SGU;
        if (r < P3_ATT) { attn_item(Z, OP, LSE, r, lds); continue; } r -= P3_ATT;
        if (r < P3_SATT) { attn_sample_item(p, Z, AO, r, lds); continue; }
        sgu_sample_item(p, Z, AO);
    }
}

DI void phase4(const Params& p) {
    const bf16_t* OP = (const bf16_t*)(p.ws + O_OP); const float* LSE = (const float*)(p.ws + O_LSE); bf16_t* AO = (bf16_t*)(p.ws + O_AO);
    const size_t nthr = (size_t)gridDim.x * 512;
    for (size_t idx = (size_t)blockIdx.x * 512 + threadIdx.x; idx < (size_t)MP * 64; idx += nthr) {
        const size_t token = idx >> 6; const int c8 = (int)(idx & 63), head = c8 >> 3;
        const float l0 = LSE[token * 8 + head], l1 = LSE[((size_t)MP + token) * 8 + head], l2 = LSE[((size_t)2 * MP + token) * 8 + head];
        const float mx = fmaxf(l0, fmaxf(l1, l2));
        float w0 = __expf(l0 - mx), w1 = __expf(l1 - mx), w2 = __expf(l2 - mx);
        const float inv = 1.f / (w0 + w1 + w2); w0 *= inv; w1 *= inv; w2 *= inv;
        const bf16x8 a = *(const bf16x8*)(OP + token * 512 + c8 * 8), b = *(const bf16x8*)(OP + ((size_t)MP + token) * 512 + c8 * 8), c = *(const bf16x8*)(OP + ((size_t)2 * MP + token) * 512 + c8 * 8);
        float o[8];
#pragma unroll
        for (int j = 0; j < 8; ++j) o[j] = w0 * bfs2f(a[j]) + w1 * bfs2f(b[j]) + w2 * bfs2f(c[j]);
        u32x4 ov; ov.x = pk2(o[0], o[1]); ov.y = pk2(o[2], o[3]); ov.z = pk2(o[4], o[5]); ov.w = pk2(o[6], o[7]);
        *(u32x4*)(AO + token * DM + 512 + c8 * 8) = ov;
    }
    const bf16_t* Z = (const bf16_t*)(p.ws + O_Z);
    for (size_t idx = (size_t)blockIdx.x * 512 + threadIdx.x; idx < (size_t)(4 * 2048 + MS) * 128; idx += nthr) {
        const int rr = (int)(idx >> 7), c8 = (int)(idx & 127), kv = c8 >> 6, cc = (c8 & 63) * 8;
        const bf16_t* src; float* dst;
        if (rr < 4 * 2048) { const int b = rr >> 11, t = rr & 2047; src = Z + (size_t)(b * SEQ + 2048 + t) * NIE; dst = p.out + (kv ? OUT_WV_P : OUT_WK_P) + (size_t)rr * 512 + cc; }
        else { const int bs = rr - 4 * 2048; src = Z + (size_t)(MP + bs) * NIE; dst = p.out + (kv ? OUT_WV_S : OUT_WK_S) + ((size_t)bs * 2048 + 2047) * 512 + cc; }
        const bf16x8 v = *(const bf16x8*)(src + 1536 + kv * 512 + cc);
        f32x4 a, b2; a.x = bfs2f(v[0]); a.y = bfs2f(v[1]); a.z = bfs2f(v[2]); a.w = bfs2f(v[3]); b2.x = bfs2f(v[4]); b2.y = bfs2f(v[5]); b2.z = bfs2f(v[6]); b2.w = bfs2f(v[7]);
        *(f32x4*)dst = a; *(f32x4*)(dst + 4) = b2;
    }
}

DI void convgate_phase(const Params& p, int l) {
    const bf16_t* UP = (const bf16_t*)(p.ws + O_UP); bf16_t* ACT = (bf16_t*)(p.ws + O_ACT);
    const float* cw = p.in[I_FCW] + (size_t)l * 3 * F2; const float* cb = p.in[I_FCB] + (size_t)l * F2;
    const size_t nthr = (size_t)gridDim.x * 512, gtid = (size_t)blockIdx.x * 512 + threadIdx.x;
    constexpr int NCH = DFF / 8;
    for (size_t u = gtid; u < (size_t)(MP / 16) * NCH; u += nthr) {
        const int rb = (int)(u / NCH), ch = (int)(u - (size_t)rb * NCH), c0 = ch * 8, row0 = rb * 16, t0 = row0 & 4095;
        float wa[3][8], wb[3][8], ba[8], bb[8];
#pragma unroll
        for (int k = 0; k < 3; ++k)
#pragma unroll
            for (int j = 0; j < 8; ++j) { wa[k][j] = cw[k * F2 + c0 + j]; wb[k][j] = cw[k * F2 + DFF + c0 + j]; }
#pragma unroll
        for (int j = 0; j < 8; ++j) { ba[j] = cb[c0 + j]; bb[j] = cb[DFF + c0 + j]; }
        float a2[8], a1[8], b2[8], b1[8];
        if (t0 == 0) {
#pragma unroll
            for (int j = 0; j < 8; ++j) { a2[j] = a1[j] = b2[j] = b1[j] = 0.f; }
        } else {
            const bf16x8 va2 = *(const bf16x8*)(UP + (size_t)(row0 - 2) * F2 + c0), va1 = *(const bf16x8*)(UP + (size_t)(row0 - 1) * F2 + c0);
            const bf16x8 vb2 = *(const bf16x8*)(UP + (size_t)(row0 - 2) * F2 + DFF + c0), vb1 = *(const bf16x8*)(UP + (size_t)(row0 - 1) * F2 + DFF + c0);
#pragma unroll
            for (int j = 0; j < 8; ++j) { a2[j] = bfs2f(va2[j]); a1[j] = bfs2f(va1[j]); b2[j] = bfs2f(vb2[j]); b1[j] = bfs2f(vb1[j]); }
        }
#pragma unroll 4
        for (int i = 0; i < 16; ++i) {
            const bf16x8 va = *(const bf16x8*)(UP + (size_t)(row0 + i) * F2 + c0), vb = *(const bf16x8*)(UP + (size_t)(row0 + i) * F2 + DFF + c0);
            float o[8];
#pragma unroll
            for (int j = 0; j < 8; ++j) {
                const float ca = bfs2f(va[j]), cbv = bfs2f(vb[j]);
                const float av = ba[j] + wa[0][j] * a2[j] + wa[1][j] * a1[j] + wa[2][j] * ca;
                const float bv = bb[j] + wb[0][j] * b2[j] + wb[1][j] * b1[j] + wb[2][j] * cbv;
                o[j] = av / (1.f + __expf(-av)) * bv;
                a2[j] = a1[j]; a1[j] = ca; b2[j] = b1[j]; b1[j] = cbv;
            }
            u32x4 ov; ov.x = pk2(o[0], o[1]); ov.y = pk2(o[2], o[3]); ov.z = pk2(o[4], o[5]); ov.w = pk2(o[6], o[7]);
            *(u32x4*)(ACT + (size_t)(row0 + i) * DFF + c0) = ov;
        }
    }
    const float* st = p.in[I_SFC] + (size_t)l * 32 * 2 * F2; float* sto = p.out + OUT_FC_S + (size_t)l * 32 * 2 * F2;
    for (size_t u = gtid; u < (size_t)MS * DFF; u += nthr) {
        const int bs = (int)(u / DFF), c = (int)(u - (size_t)bs * DFF);
        const float* s0 = st + (size_t)(bs * 2) * F2; const float* s1 = s0 + F2;
        const bf16_t* ur = UP + (size_t)(MP + bs) * F2;
        const float av = cb[c] + cw[c] * s0[c] + cw[F2 + c] * s1[c] + cw[2 * F2 + c] * bf2f(ur[c]);
        const float bv = cb[DFF + c] + cw[DFF + c] * s0[DFF + c] + cw[F2 + DFF + c] * s1[DFF + c] + cw[2 * F2 + DFF + c] * bf2f(ur[DFF + c]);
        ACT[(size_t)(MP + bs) * DFF + c] = f2bf(av / (1.f + __expf(-av)) * bv);
        sto[(size_t)(bs * 2) * F2 + c] = s1[c]; sto[(size_t)(bs * 2) * F2 + DFF + c] = s1[DFF + c];
        sto[(size_t)(bs * 2 + 1) * F2 + c] = bf2f(ur[c]); sto[(size_t)(bs * 2 + 1) * F2 + DFF + c] = bf2f(ur[DFF + c]);
    }
    float* stp = p.out + OUT_FC_P + (size_t)l * 4 * 2 * F2;
    for (size_t u = gtid; u < (size_t)4 * 2 * F2; u += nthr) {
        const int bi = (int)(u / F2), c = (int)(u - (size_t)bi * F2), b = bi >> 1, i = bi & 1;
        stp[u] = bf2f(UP[(size_t)(b * SEQ + 4094 + i) * F2 + c]);
    }
}

DI void rglru_gate_item(const Params& p, int item, ldsp lds) {
    const int mt = item >> 3, g = item & 7, tid = threadIdx.x;
    const bf16_t* ZO = (const bf16_t*)(p.ws + O_ZO);
    {
        const int chunk = tid & 15, rg = tid >> 4, c0 = g * 128 + chunk * 8;
        float cw[4][8], cb[8];
#pragma unroll
        for (int k = 0; k < 4; ++k)
#pragma unroll
            for (int j = 0; j < 8; ++j) cw[k][j] = p.in[I_RCW][k * 1024 + c0 + j];
#pragma unroll
        for (int j = 0; j < 8; ++j) cb[j] = p.in[I_RCB][c0 + j];
        if (mt < 64) {
            const int row0 = mt * 256 + rg * 8, t0 = row0 & 4095;
            float p3[8], p2[8], p1[8];
            if (t0 == 0) {
#pragma unroll
                for (int j = 0; j < 8; ++j) p3[j] = p2[j] = p1[j] = 0.f;
            } else {
                const bf16x8 v3 = *(const bf16x8*)(ZO + (size_t)(row0 - 3) * 2048 + 1024 + c0), v2 = *(const bf16x8*)(ZO + (size_t)(row0 - 2) * 2048 + 1024 + c0), v1 = *(const bf16x8*)(ZO + (size_t)(row0 - 1) * 2048 + 1024 + c0);
#pragma unroll
                for (int j = 0; j < 8; ++j) { p3[j] = bfs2f(v3[j]); p2[j] = bfs2f(v2[j]); p1[j] = bfs2f(v1[j]); }
            }
#pragma unroll
            for (int i = 0; i < 8; ++i) {
                const bf16x8 vc = *(const bf16x8*)(ZO + (size_t)(row0 + i) * 2048 + 1024 + c0);
                float o[8];
#pragma unroll
                for (int j = 0; j < 8; ++j) { const float cur = bfs2f(vc[j]); o[j] = cb[j] + cw[0][j] * p3[j] + cw[1][j] * p2[j] + cw[2][j] * p1[j] + cw[3][j] * cur; p3[j] = p2[j]; p2[j] = p1[j]; p1[j] = cur; }
                u32x4 ov; ov.x = pk2(o[0], o[1]); ov.y = pk2(o[2], o[3]); ov.z = pk2(o[4], o[5]); ov.w = pk2(o[6], o[7]);
                *(LAS u32x4*)(lds + (rg * 8 + i) * 272 + chunk * 16) = ov;
            }
        } else {
#pragma unroll
            for (int i = 0; i < 8; ++i) {
                const int rt = rg * 8 + i;
                u32x4 ov; ov.x = ov.y = ov.z = ov.w = 0u;
                if (rt < MS) {
                    const float* st = p.in[I_SRC] + (size_t)rt * 3 * 1024 + c0;
                    const bf16x8 vc = *(const bf16x8*)(ZO + (size_t)(MP + rt) * 2048 + 1024 + c0);
                    float o[8];
#pragma unroll
                    for (int j = 0; j < 8; ++j) o[j] = cb[j] + cw[0][j] * st[j] + cw[1][j] * st[1024 + j] + cw[2][j] * st[2048 + j] + cw[3][j] * bfs2f(vc[j]);
                    ov.x = pk2(o[0], o[1]); ov.y = pk2(o[2], o[3]); ov.z = pk2(o[4], o[5]); ov.w = pk2(o[6], o[7]);
                    float* so = p.out + OUT_RC_S + (size_t)rt * 3 * 1024 + c0;
#pragma unroll
                    for (int j = 0; j < 8; ++j) { so[j] = st[1024 + j]; so[1024 + j] = st[2048 + j]; so[2048 + j] = bfs2f(vc[j]); }
                }
                *(LAS u32x4*)(lds + rt * 272 + chunk * 16) = ov;
            }
        }
    }
    __syncthreads();
    const int w = tid >> 6, lane = tid & 63, ql = lane & 31, hf = lane >> 5;
    bf16x8 af[8];
#pragma unroll
    for (int ks = 0; ks < 8; ++ks) af[ks] = *(LAS bf16x8*)(lds + (32 * w + ql) * 272 + (16 * ks + 8 * hf) * 2);
    const bf16_t* WG = (const bf16_t*)(p.ws + O_WT_GA) + (size_t)(g * 256 + ql) * 128 + 8 * hf;
    float* AA = (float*)(p.ws + O_AA); float* BB = (float*)(p.ws + O_BB); bf16_t* Y = (bf16_t*)(p.ws + O_AO);
    for (int n = 0; n < 4; ++n) {
        f32x16 ar, ai;
#pragma unroll
        for (int i = 0; i < 16; ++i) { ar[i] = 0.f; ai[i] = 0.f; }
#pragma unroll
        for (int ks = 0; ks < 8; ++ks) {
            const bf16x8 br = *(const bf16x8*)(WG + (size_t)(32 * n) * 128 + 16 * ks), bi = *(const bf16x8*)(WG + (size_t)(32 * (n + 4)) * 128 + 16 * ks);
            ar = MFMA32(af[ks], br, ar); ai = MFMA32(af[ks], bi, ai);
        }
        const int o = 32 * n + ql, col = g * 128 + o;
        const float ba = p.in[I_RBA][col], bx = p.in[I_RBX][col], lam = p.in[I_RLAM][col];
        const float sp = log1pf(__expf(-lam));
#pragma unroll
        for (int i = 0; i < 16; ++i) {
            const int rt = 32 * w + crow(i, hf);
            const float r = sigmoidf(ar[i] + ba), ig = sigmoidf(ai[i] + bx);
            const float la = -8.f * r * sp, a = __expf(la), mult = sqrtf(-expm1f(2.f * la));
            const float xcv = bf2f(*(LAS bf16_t*)(lds + rt * 272 + o * 2));
            const float bv = mult * (ig * xcv);
            if (mt < 64) { const size_t e = (size_t)(mt * 256 + rt) * DM + col; AA[e] = a; BB[e] = bv; }
            else if (rt < MS) {
                const float h = a * p.in[I_SRH][(size_t)rt * 1024 + col] + bv;
                p.out[OUT_RH_S + (size_t)rt * 1024 + col] = h;
                Y[(size_t)(MP + rt) * DM + col] = f2bf(bf2f(ZO[(size_t)(MP + rt) * 2048 + col]) * h);
            }
        }
    }
    __syncthreads();
}

DI void scan_pass1(const Params& p) {
    const float* AA = (const float*)(p.ws + O_AA); const float* BB = (const float*)(p.ws + O_BB);
    float* AGP = (float*)(p.ws + O_AGG); float* AGH = AGP + 4 * 64 * 1024;
    { const bf16_t* ZO = (const bf16_t*)(p.ws + O_ZO);
      for (size_t u = (size_t)blockIdx.x * 512 + threadIdx.x; u < (size_t)4 * 3 * 1024; u += (size_t)gridDim.x * 512) {
          const int bi = (int)(u >> 10), c = (int)(u & 1023), b = bi / 3, i = bi - 3 * b;
          p.out[OUT_RC_P + u] = bf2f(ZO[(size_t)(b * SEQ + 4093 + i) * 2048 + 1024 + c]); } }
    for (int it = blockIdx.x; it < 512; it += gridDim.x) {
        const int b = it >> 7, ci = (it >> 1) & 63, c = (it & 1) * 512 + threadIdx.x;
        const size_t base = (size_t)(b * SEQ + ci * 64) * DM + c;
        float P = 1.f, H = 0.f;
#pragma unroll 16
        for (int t = 0; t < 64; ++t) { const float a = AA[base + (size_t)t * DM], bb = BB[base + (size_t)t * DM]; H = a * H + bb; P *= a; }
        AGP[(size_t)(b * 64 + ci) * 1024 + c] = P; AGH[(size_t)(b * 64 + ci) * 1024 + c] = H;
    }
}
DI void scan_pass2(const Params& p) {
    const float* AA = (const float*)(p.ws + O_AA); const float* BB = (const float*)(p.ws + O_BB);
    const float* AGP = (const float*)(p.ws + O_AGG); const float* AGH = AGP + 4 * 64 * 1024;
    const bf16_t* ZO = (const bf16_t*)(p.ws + O_ZO); bf16_t* Y = (bf16_t*)(p.ws + O_AO);
    for (int it = blockIdx.x; it < 512; it += gridDim.x) {
        const int b = it >> 7, ci = (it >> 1) & 63, c = (it & 1) * 512 + threadIdx.x;
        float h = 0.f;
        for (int j = 0; j < ci; ++j) h = AGP[(size_t)(b * 64 + j) * 1024 + c] * h + AGH[(size_t)(b * 64 + j) * 1024 + c];
        const size_t row0 = (size_t)(b * SEQ + ci * 64);
#pragma unroll 16
        for (int t = 0; t < 64; ++t) {
            const size_t e = (row0 + t) * DM + c;
            h = AA[e] * h + BB[e];
            Y[e] = f2bf(bf2f(ZO[(row0 + t) * 2048 + c]) * h);
        }
        if (ci == 63) p.out[OUT_RH_P + (size_t)b * 1024 + c] = h;
    }
}

DI void run_phase(const Params& p, int ph, ldsp lds) {
    unsigned char* ws = p.ws;
    float* MOD = (float*)(ws + O_MOD); float* X = (float*)(ws + O_X); bf16_t* H = (bf16_t*)(ws + O_H); bf16_t* AO = (bf16_t*)(ws + O_AO);
    switch (ph) {
    case 0: phase0(p, lds); break;
    case 1: norm_phase(p.in[I_XP], p.in[I_XS], MOD, 0, 1024, H); break;
    case 2: { QInE q{(bf16_t*)(ws + O_Z)};
              gemm_all(lds, H, (const bf16_t*)(ws + O_WT_IN_E), NIE, 1024, q); } break;
    case 3: phase3(p, lds); break;
    case 4: phase4(p); break;
    case 5: { QRes q{p.in[I_XP], p.in[I_XS], X, MOD + 2048}; gemm_all(lds, AO, (const bf16_t*)(ws + O_WT_OUT_E), 1024, 1024, q); } break;
    case 6: norm_phase(X, X + (size_t)MP * DM, MOD, 3072, 4096, H); break;
    case 7: { QUp q{(bf16_t*)(ws + O_UP)}; gemm_all(lds, H, (const bf16_t*)(ws + O_WT_UP), F2, 1024, q); } break;
    case 8: convgate_phase(p, 0); break;
    case 9: { QRes q{X, X + (size_t)MP * DM, X, MOD + 5120}; gemm_all(lds, (const bf16_t*)(ws + O_ACT), (const bf16_t*)(ws + O_WT_DN), 1024, DFF, q); } break;
    case 10: norm_phase(X, X + (size_t)MP * DM, MOD + 36 * 6144, 0, 1024, H); break;
    case 11: { QInO q{(bf16_t*)(ws + O_ZO)}; gemm_all(lds, H, (const bf16_t*)(ws + O_WT_IN_O), 2048, 1024, q); } break;
    case 12: for (int it = blockIdx.x; it < 65 * 8; it += gridDim.x) rglru_gate_item(p, it, lds); break;
    case 13: scan_pass1(p); break;
    case 14: scan_pass2(p); break;
    case 15: { QRes q{X, X + (size_t)MP * DM, X, MOD + 36 * 6144 + 2048}; gemm_all(lds, AO, (const bf16_t*)(ws + O_WT_OUT_O), 1024, 1024, q); } break;
    case 16: norm_phase(X, X + (size_t)MP * DM, MOD + 36 * 6144, 3072, 4096, H); break;
    case 17: { QUp q{(bf16_t*)(ws + O_UP)};
               gemm_all(lds, H, (const bf16_t*)(ws + O_WT_UP + SZ_WT_UP), F2, 1024, q); } break;
    case 18: convgate_phase(p, 1); break;
    case 19: { QRes q{X, X + (size_t)MP * DM, X, MOD + 36 * 6144 + 5120}; gemm_all(lds, (const bf16_t*)(ws + O_ACT), (const bf16_t*)(ws + O_WT_DN + SZ_WT_DN), 1024, DFF, q); } break;
    case 20: final_norm_phase(X, p.in[I_FING], p.out + OUT_Y_P, p.out + OUT_Y_S); break;
    default: break;
    }
}

__global__ void __launch_bounds__(512, 2) fwd_mega(Params p, int ph_lo, int ph_hi) {
    extern __shared__ __attribute__((aligned(16))) unsigned char shm[];
    ldsp lds = (ldsp)shm;
    cg::grid_group grid = cg::this_grid();
#define PHASE(k) if (ph_lo <= (k) && (k) < ph_hi) { run_phase(p, (k), lds); if ((k) + 1 < ph_hi) grid.sync(); }
    PHASE(0) PHASE(1) PHASE(2) PHASE(3) PHASE(4) PHASE(5) PHASE(6) PHASE(7) PHASE(8) PHASE(9) PHASE(10)
    PHASE(11) PHASE(12) PHASE(13) PHASE(14) PHASE(15) PHASE(16) PHASE(17) PHASE(18) PHASE(19) PHASE(20)
#undef PHASE
}

extern "C" void kernel_launch(void* const* d_in, const int* in_sizes, int n_in, void* d_out, int out_size, void* d_ws, size_t ws_size, hipStream_t stream) {
    static int grid = 0;
    if (grid == 0) {
        if (n_in != N_IN || (size_t)out_size != OUT_TOTAL || ws_size < WS_NEED) { fprintf(stderr, "kernel_launch: unexpected shapes: n_in %d out %d ws %zu (need %zu)\n", n_in, out_size, ws_size, (size_t)WS_NEED); grid = -1; return; }
        int dev = 0, cus = 0, per_cu = 0;
        hipGetDevice(&dev); hipDeviceGetAttribute(&cus, hipDeviceAttributeMultiprocessorCount, dev);
        if (hipFuncSetAttribute((const void*)fwd_mega, hipFuncAttributeMaxDynamicSharedMemorySize, LDS_BYTES) != hipSuccess) { fprintf(stderr, "kernel_launch: hipFuncSetAttribute failed\n"); grid = -1; return; }
        if (hipOccupancyMaxActiveBlocksPerMultiprocessor(&per_cu, (const void*)fwd_mega, 512, LDS_BYTES) != hipSuccess || per_cu < 1) { fprintf(stderr, "kernel_launch: occupancy query says %d\n", per_cu); per_cu = 1; }
        (void)hipGetLastError();
        grid = cus;
        if (grid > 256) grid = 256;
    }
    if (grid < 0) return;
    Params p{};
    for (int i = 0; i < N_IN; ++i) p.in[i] = (const float*)d_in[i];
    p.out = (float*)d_out; p.ws = (unsigned char*)d_ws;
#if MULTI_LAUNCH
    for (int ph = 0; ph < NPH; ++ph) { int lo = ph, hi = ph + 1; hipLaunchKernelGGL(fwd_mega, dim3(grid), dim3(512), LDS_BYTES, stream, p, lo, hi); }
#else
    int lo = 0, hi = NPH;
    void* args[] = {&p, &lo, &hi};
    hipError_t e = hipLaunchCooperativeKernel((const void*)fwd_mega, dim3(grid), dim3(512), args, LDS_BYTES, stream);
    if (e != hipSuccess) fprintf(stderr, "kernel_launch: cooperative launch failed: %s (grid %d)\n", hipGetErrorString(e), grid);
#endif
}
```

```cpp
#include <hip/hip_runtime.h>
#include <hip/hip_cooperative_groups.h>
#include <cstdio>
#include <cstdint>
namespace cg = cooperative_groups;
namespace pg8 {
#define PG8_LAS __attribute__((address_space(3)))
typedef unsigned short bf16_t;
typedef short bf16x8 __attribute__((ext_vector_type(8)));
typedef float f32x4 __attribute__((ext_vector_type(4)));
typedef unsigned u32x4 __attribute__((ext_vector_type(4)));
constexpr int BM = 256, BK = 64, HALF = 128, HTB = HALF * BK * 2  , STAGE_BYTES = 8 * HTB, NXCD = 8, WGM = 8;

__host__ __device__ __forceinline__ int lds_byte(int r, int c) { const int st = (r >> 4) * 2 + (c >> 5), rr = r & 15, cc = c & 31, ob = rr * 64 + cc * 2; return st * 1024 + (ob ^ (((ob >> 9) & 1) << 5)); }
__host__ __device__ __forceinline__ void stage_rc(int b, int& R, int& C) { const int st = b / 1024, sb = b % 1024, swz = sb ^ (((sb >> 9) & 1) << 5); R = (st >> 1) * 16 + swz / 64; C = (st & 1) * 32 + (swz % 64) / 2; }
__host__ __device__ __forceinline__ int perm32(int rho) { const int n = rho >> 4, i = rho & 15; return 8 * (i >> 2) + 4 * n + (i & 3); }

struct Unit { int pm, pn; };
struct Gemm { const bf16_t* A; const bf16_t* Bt; int M, N, K; };

struct StaticOrder {
    int nM, nN, nwg, G, c;
    __host__ __device__ void init(int M, int N, int G_, int c_) { nM = M / BM; nN = N / BM; nwg = nM * nN; G = G_; c = c_; }
    __host__ __device__ bool next(int i, Unit& u) const {
        const long L = (long)i * G + c; if (L >= nwg) return false;
        int wgid = (int)L; { const int q = nwg / NXCD, r = nwg % NXCD, xcd = wgid % NXCD, off = wgid / NXCD; wgid = (xcd < r ? xcd * (q + 1) : r * (q + 1) + (xcd - r) * q) + off; }
        const int nig = WGM * nN, gid = wgid / nig, fm = gid * WGM, gsz = (nM - fm) < WGM ? (nM - fm) : WGM;
        u.pm = fm + ((wgid % nig) % gsz); u.pn = (wgid % nig) / gsz; return true;
    }
    __device__ __forceinline__ void a_ready(const Unit&) const {}
    __device__ __forceinline__ void done(const Unit&) const {}
};
__device__ __forceinline__ unsigned cvt_pk_bf16(float lo, float hi) { unsigned r; asm volatile("v_cvt_pk_bf16_f32 %0, %1, %2" : "=v"(r) : "v"(lo), "v"(hi)); return r; }
template <class Epi, class Sched, bool STAMP = false>
__device__ __forceinline__ void gemm_phase(PG8_LAS unsigned char* lds, const Gemm g, const Sched& S, const Epi& E, unsigned long long* stamps) {
    const int tid = threadIdx.x, wid = __builtin_amdgcn_readfirstlane(tid >> 6), lane = tid & 63, wr = wid >> 2, wc = wid & 3, fr = lane & 15, fq = lane >> 4;
    const int K = g.K, nt = K / BK;
    int ts_lo = 0, ts_hi = 0, nts = 0; const unsigned long long rt_entry = STAMP ? (unsigned long long)wall_clock64() : 0ull;
#define PG8_STAMP() do { if (STAMP && wid == 0 && nts < 64) { const unsigned long long _c = (unsigned long long)clock64(); \
        ts_lo = (lane == nts) ? (int)(unsigned)_c : ts_lo; ts_hi = (lane == nts) ? (int)(unsigned)(_c >> 32) : ts_hi; ++nts; } } while (0)
    PG8_STAMP();
    unsigned voffA[2], voffB[2];
#pragma unroll
    for (int i = 0; i < 2; ++i) { int R, C; stage_rc(tid * 16 + i * 8192, R, C); const int Rb = Epi::PERM ? ((R & ~31) + perm32(R & 31)) : R;
        voffA[i] = (unsigned)(R * K + C) * 2u; voffB[i] = (unsigned)(Rb * K + C) * 2u; }
    const size_t kstep = (size_t)(BK * 2);
    const size_t hstep = (size_t)HALF * K * 2;
    const size_t tstep = 2 * hstep;
    const unsigned ldsw = (unsigned)wid * 1024u;
    const int aoff = lds_byte(wr * 64 + fr, fq * 8), boff = lds_byte(wc * 32 + fr, fq * 8);
#define PG8_SA(b, h) (((b) * 2 + (h)) * HTB)
#define PG8_SB(b, h) ((4 + (b) * 2 + (h)) * HTB)
#define PG8_STAGE(bufoff, gbase, voff) do { _Pragma("unroll") for (int _i = 0; _i < 2; ++_i) \
        __builtin_amdgcn_global_load_lds((const unsigned*)((const char*)(gbase) + (voff)[_i]), (PG8_LAS unsigned*)(lds + (bufoff) + ldsw + _i * 8192), 16, 0, 0); } while (0)
#define PG8_LDA(dst, b, h) do { _Pragma("unroll") for (int m = 0; m < 4; ++m) _Pragma("unroll") for (int k = 0; k < 2; ++k) dst[m][k] = *(const PG8_LAS bf16x8*)(lds + PG8_SA(b, h) + aoff + m * 2048 + k * 1024); } while (0)
#define PG8_LDB(dst, b, h) do { _Pragma("unroll") for (int n = 0; n < 2; ++n) _Pragma("unroll") for (int k = 0; k < 2; ++k) dst[n][k] = *(const PG8_LAS bf16x8*)(lds + PG8_SB(b, h) + boff + n * 2048 + k * 1024); } while (0)
#define PG8_MMA(ai, bj, At, Bt) do { __builtin_amdgcn_s_setprio(1); _Pragma("unroll") for (int m = 0; m < 4; ++m) _Pragma("unroll") for (int n = 0; n < 2; ++n) _Pragma("unroll") for (int k = 0; k < 2; ++k) \
        acc[ai][bj][m][n] = __builtin_amdgcn_mfma_f32_16x16x32_bf16(Bt[n][k], At[m][k], acc[ai][bj][m][n], 0, 0, 0); __builtin_amdgcn_s_setprio(0); } while (0)
#define PG8_WAIT_V(n) asm volatile("s_waitcnt vmcnt(" #n ")" ::: "memory")
#define PG8_WAIT_L(n) asm volatile("s_waitcnt lgkmcnt(" #n ")" ::: "memory")
#define PG8_BAR __builtin_amdgcn_s_barrier()
#define PG8_SCHED __builtin_amdgcn_sched_barrier(0)
    Unit cur, nxt; int ui = 0;
    if (!S.next(0, cur)) return;
    f32x4 acc[2][2][4][2];
#pragma unroll
    for (int a = 0; a < 2; ++a)
#pragma unroll
        for (int b = 0; b < 2; ++b)
#pragma unroll
            for (int m = 0; m < 4; ++m)
#pragma unroll
                for (int n = 0; n < 2; ++n) acc[a][b][m][n] = (f32x4){0.f, 0.f, 0.f, 0.f};
    bf16x8 At[4][2], B0[2][2], B1[2][2];
    const char* cA = (const char*)g.A + (size_t)cur.pm * tstep; const char* cB = (const char*)g.Bt + (size_t)cur.pn * tstep;
    S.a_ready(cur);
    PG8_STAGE(PG8_SB(0, 0), cB, voffB); PG8_STAGE(PG8_SA(0, 0), cA, voffA); PG8_STAGE(PG8_SB(0, 1), cB + hstep, voffB); PG8_STAGE(PG8_SA(0, 1), cA + hstep, voffA);
    if (wr == 1) PG8_BAR;
    PG8_WAIT_V(4); PG8_BAR;
    PG8_STAGE(PG8_SB(1, 0), cB + kstep, voffB); PG8_STAGE(PG8_SA(1, 0), cA + kstep, voffA); PG8_STAGE(PG8_SB(1, 1), cB + hstep + kstep, voffB);
    PG8_WAIT_V(6); PG8_BAR;
    PG8_STAMP();
    for (;;) {
        const bool has_next = S.next(ui + 1, nxt);
        const char* nA = has_next ? (const char*)g.A + (size_t)nxt.pm * tstep : cA; const char* nB = has_next ? (const char*)g.Bt + (size_t)nxt.pn * tstep : cB;
        for (int t = 0; t < nt; t += 2) {
            const bool last = (t == nt - 2);
            const char* a1 = cA + (size_t)(t + 1) * kstep;
            const char* a2 = last ? nA : cA + (size_t)(t + 2) * kstep; const char* b2 = last ? nB : cB + (size_t)(t + 2) * kstep;
            const char* a3 = a2 + kstep; const char* b3 = b2 + kstep;
            if (last && has_next) S.a_ready(nxt);
            PG8_LDB(B0, 0, 0); PG8_SCHED; PG8_LDA(At, 0, 0); PG8_STAGE(PG8_SA(1, 1), a1 + hstep, voffA);
            PG8_WAIT_L(8); PG8_BAR; PG8_WAIT_L(0); PG8_MMA(0, 0, At, B0); PG8_BAR; PG8_SCHED;
            PG8_LDB(B1, 0, 1); PG8_STAGE(PG8_SB(0, 0), b2, voffB);
            PG8_BAR; PG8_WAIT_L(0); PG8_MMA(0, 1, At, B1); PG8_BAR;
            PG8_LDA(At, 0, 1); PG8_STAGE(PG8_SA(0, 0), a2, voffA);
            PG8_BAR; PG8_WAIT_L(0); PG8_MMA(1, 0, At, B0); PG8_BAR; PG8_SCHED;
            PG8_STAGE(PG8_SB(0, 1), b2 + hstep, voffB);
            PG8_WAIT_V(6); PG8_BAR; PG8_MMA(1, 1, At, B1); PG8_BAR;
            PG8_LDB(B0, 1, 0); PG8_SCHED; PG8_LDA(At, 1, 0); PG8_STAGE(PG8_SA(0, 1), a2 + hstep, voffA);
            PG8_WAIT_L(8); PG8_BAR; PG8_WAIT_L(0); PG8_MMA(0, 0, At, B0); PG8_BAR; PG8_SCHED;
            PG8_LDB(B1, 1, 1); PG8_STAGE(PG8_SB(1, 0), b3, voffB);
            PG8_BAR; PG8_WAIT_L(0); PG8_MMA(0, 1, At, B1); PG8_BAR;
            PG8_LDA(At, 1, 1); PG8_STAGE(PG8_SA(1, 0), a3, voffA);
            PG8_BAR; PG8_WAIT_L(0); PG8_MMA(1, 0, At, B0); PG8_BAR; PG8_SCHED;
            PG8_STAGE(PG8_SB(1, 1), b3 + hstep, voffB);
            PG8_WAIT_V(6); PG8_BAR; PG8_MMA(1, 1, At, B1); PG8_BAR;
        }
        PG8_STAMP();
        if constexpr (!Epi::AFTER_DRAIN) { E(acc, cur, wr, wc, fr, fq); S.done(cur); }
        PG8_STAMP();
        if (!has_next) break;
#pragma unroll
        for (int a = 0; a < 2; ++a)
#pragma unroll
            for (int b = 0; b < 2; ++b)
#pragma unroll
                for (int m = 0; m < 4; ++m)
#pragma unroll
                    for (int n = 0; n < 2; ++n) acc[a][b][m][n] = (f32x4){0.f, 0.f, 0.f, 0.f};
        cur = nxt; cA = nA; cB = nB; ++ui;
    }
    PG8_WAIT_V(0);
    if (wr == 0) PG8_BAR;
    PG8_BAR;
    if constexpr (Epi::AFTER_DRAIN) { E.fused(acc, cur, wr, wc, fr, fq, lds, wid, lane); S.done(cur); }
    PG8_STAMP();
    if (STAMP && wid == 0) { stamps[lane] = lane < nts ? (((unsigned long long)(unsigned)ts_hi << 32) | (unsigned)ts_lo) : 0ull;
        if (lane == 62) stamps[62] = rt_entry; if (lane == 63) stamps[63] = (unsigned long long)wall_clock64(); }
#undef PG8_STAMP
#undef PG8_SA
#undef PG8_SB
#undef PG8_STAGE
#undef PG8_LDA
#undef PG8_LDB
#undef PG8_MMA
#undef PG8_WAIT_V
#undef PG8_WAIT_L
#undef PG8_BAR
#undef PG8_SCHED
}
}
#define LAS __attribute__((address_space(3)))

#define XB_TMO      128
#define XB_XCNT(j)  (256  + 64 * (j))
#define XB_XSUB(j)  (1280 + 64 * (j))
#define XB_XGEN(j)  (2304 + 64 * (j))
#define XB_TOP      3328
#define XB_TOPGEN   3392
#define XCD_BAR_WORDS 3456
#define XB_SPIN_CAP (1u << 18)

__device__ __forceinline__ unsigned xb_ld(unsigned* p)              { return __hip_atomic_load(p, __ATOMIC_RELAXED, __HIP_MEMORY_SCOPE_AGENT); }
__device__ __forceinline__ unsigned xb_add(unsigned* p, unsigned v) { return __hip_atomic_fetch_add(p, v, __ATOMIC_RELAXED, __HIP_MEMORY_SCOPE_AGENT); }
__device__ __forceinline__ unsigned xb_xcc_id() { return (unsigned)__builtin_amdgcn_s_getreg((3 << 11) | 20) & 0xFu; }
#define XB_SPIN(cond, bar) do { unsigned _sp = 0; while (cond) { __builtin_amdgcn_s_sleep(1); \
    if ((++_sp & 255u) == 0u) { if (xb_ld(&(bar)[XB_TMO])) break; if (_sp > XB_SPIN_CAP) { atomicAdd(&(bar)[XB_TMO], 1u); break; } } } } while (0)

struct XcdBarrier {
    unsigned* bar; unsigned x;
    volatile LAS unsigned* st;
};

__device__ __forceinline__ XcdBarrier xcd_barrier_post(unsigned* bar, volatile LAS unsigned* st) {
    XcdBarrier b; b.bar = bar; b.x = xb_xcc_id(); b.st = st;
    if (threadIdx.x == 0) (void)xb_add(&bar[XB_XCNT(b.x)], 1u);
    return b;
}
__device__ __forceinline__ void xcd_barrier_complete(unsigned* bar, unsigned x, unsigned& nloc, unsigned& nx) {
    const unsigned G = gridDim.x * gridDim.y * gridDim.z;
    unsigned sum, cnt, mine, sp = 0u;
    for (;;) {
        sum = 0u; cnt = 0u; mine = 0u;
#pragma unroll
        for (unsigned j = 0; j < 16; ++j) { const unsigned c = xb_ld(&bar[XB_XCNT(j)]); sum += c; cnt += (c > 0u) ? 1u : 0u; mine = (j == x) ? c : mine; }
        if (sum == G) break;
        __builtin_amdgcn_s_sleep(1);
        if ((++sp & 255u) == 0u) { if (xb_ld(&bar[XB_TMO])) break; if (sp > XB_SPIN_CAP) { atomicAdd(&bar[XB_TMO], 1u); break; } }
    }
    nloc = mine > 0u ? mine : 1u; nx = cnt > 0u ? cnt : 1u;
}

__device__ __forceinline__ void xcd_barrier(const XcdBarrier& b) {
    asm volatile("s_waitcnt vmcnt(0)" ::: "memory");
    __syncthreads();
    if (threadIdx.x == 0) {
        unsigned* bar = b.bar;
        __builtin_amdgcn_s_waitcnt(0);
        unsigned nloc = b.st[0], nx = b.st[1];
        if (nloc == 0u) { xcd_barrier_complete(bar, b.x, nloc, nx); b.st[0] = nloc; b.st[1] = nx; }
        const unsigned old = xb_add(&bar[XB_XSUB(b.x)], 1u);
        const unsigned gen = old / nloc;
        if (old + 1u == (gen + 1u) * nloc) {
            __builtin_amdgcn_fence(__ATOMIC_RELEASE, "agent");
            asm volatile("s_waitcnt vmcnt(0)" ::: "memory");
            const unsigned og = xb_add(&bar[XB_TOP], 1u);
            const unsigned tg = og / nx;
            if (og + 1u == (tg + 1u) * nx) xb_add(&bar[XB_TOPGEN], 1u);
            else XB_SPIN(xb_ld(&bar[XB_TOPGEN]) == tg, bar);
            __builtin_amdgcn_fence(__ATOMIC_ACQUIRE, "agent");
            xb_add(&bar[XB_XGEN(b.x)], 1u);
            asm volatile("s_waitcnt vmcnt(0)" ::: "memory");
        } else {
            XB_SPIN(xb_ld(&bar[XB_XGEN(b.x)]) == gen, bar);
            __builtin_amdgcn_fence(__ATOMIC_ACQUIRE, "agent");
            asm volatile("s_waitcnt vmcnt(0)" ::: "memory");
        }
    }
    __syncthreads();
}
using pg8::bf16_t; using pg8::bf16x8; using pg8::f32x4; using pg8::u32x4;
typedef float f32x16 __attribute__((ext_vector_type(16)));
typedef short s16x4 __attribute__((ext_vector_type(4)));
typedef unsigned u32x2 __attribute__((ext_vector_type(2)));
#define DI __device__ __forceinline__
typedef LAS unsigned char* ldsp;
#define MFMA32(a, b, c) __builtin_amdgcn_mfma_f32_32x32x16_bf16((a), (b), (c), 0, 0, 0)

#ifndef DOUBLE_MASK
#define DOUBLE_MASK 0
#endif
#ifndef COPY_TWICE
#define COPY_TWICE 0
#endif
#ifndef ADA_TWICE
#define ADA_TWICE 0
#endif
#ifndef TR_TWICE
#define TR_TWICE 0
#endif
#ifndef P3_TWICE
#define P3_TWICE 0
#endif
#ifndef MULTI_LAUNCH
#define MULTI_LAUNCH 0
#endif

constexpr int DM = 1024, MP = 16384, MS = 32, MT = MP + MS, SEQ = 4096;
constexpr int NIE = 2560, DFF = 2816, F2 = 5632;
constexpr int NPH = 21;
constexpr int LDS_BYTES = 131072 + 256;

constexpr size_t al256(size_t x) { return (x + 255) & ~(size_t)255; }
constexpr size_t O_WT_IN_E = 0;
constexpr size_t O_WT_OUT_E = O_WT_IN_E + al256((size_t)NIE * DM * 2);
constexpr size_t O_WT_IN_O = O_WT_OUT_E + al256((size_t)DM * DM * 2);
constexpr size_t O_WT_OUT_O = O_WT_IN_O + al256((size_t)2048 * DM * 2);
constexpr size_t O_WT_UP = O_WT_OUT_O + al256((size_t)DM * DM * 2);
constexpr size_t SZ_WT_UP = (size_t)F2 * DM * 2;
constexpr size_t O_WT_DN = O_WT_UP + 2 * SZ_WT_UP;
constexpr size_t SZ_WT_DN = (size_t)DM * DFF * 2;
constexpr size_t O_WT_GA = O_WT_DN + 2 * SZ_WT_DN;
constexpr size_t O_WS_TRIL = O_WT_GA + (size_t)8 * 256 * 128 * 2;
constexpr size_t O_MOD = O_WS_TRIL + (size_t)4 * 128 * 128 * 2;
constexpr size_t O_X = O_MOD + al256((size_t)2 * 36 * 6144 * 4);
constexpr size_t O_H = O_X + (size_t)MT * DM * 4;
constexpr size_t O_AO = O_H + (size_t)MT * DM * 2;
constexpr size_t O_AGG = O_AO + (size_t)MT * DM * 2;
constexpr size_t O_SLOT = O_AGG + (size_t)2 * 4 * 64 * 1024 * 4;
constexpr size_t O_BIG = al256(O_SLOT + (size_t)4 * 4 * MP * 4);
constexpr int CNT_WORD = 3600;
constexpr size_t O_Z = O_BIG;
constexpr size_t O_OP = O_Z + al256((size_t)MT * NIE * 2);
constexpr size_t O_LSE = O_OP + (size_t)3 * MP * 512 * 2;
constexpr size_t O_UP = O_BIG;
constexpr size_t O_ACT = O_UP + al256((size_t)MT * F2 * 2);
constexpr size_t O_ZO = O_BIG;
constexpr size_t O_AA = O_ZO + al256((size_t)MT * 2048 * 2);
constexpr size_t O_BB = O_AA + (size_t)MP * DM * 4;
constexpr size_t O_BAR = al256(O_ACT + (size_t)MT * DFF * 2);
constexpr size_t BAR_BYTES = 16384;
constexpr size_t WS_NEED = O_BAR + BAR_BYTES;

constexpr size_t OUT_Y_P = 0;
constexpr size_t OUT_Y_S = OUT_Y_P + (size_t)MP * DM;
constexpr size_t OUT_WK_P = OUT_Y_S + (size_t)MS * DM;
constexpr size_t OUT_WV_P = OUT_WK_P + (size_t)4 * 2048 * 512;
constexpr size_t OUT_RC_P = OUT_WV_P + (size_t)4 * 2048 * 512;
constexpr size_t OUT_RH_P = OUT_RC_P + (size_t)4 * 3 * 1024;
constexpr size_t OUT_FC_P = OUT_RH_P + (size_t)4 * 1024;
constexpr size_t OUT_CV_S = OUT_FC_P + (size_t)2 * 4 * 2 * F2;
constexpr size_t OUT_WK_S = OUT_CV_S + (size_t)32 * 512;
constexpr size_t OUT_WV_S = OUT_WK_S + (size_t)32 * 2048 * 512;
constexpr size_t OUT_RC_S = OUT_WV_S + (size_t)32 * 2048 * 512;
constexpr size_t OUT_RH_S = OUT_RC_S + (size_t)32 * 3 * 1024;
constexpr size_t OUT_FC_S = OUT_RH_S + (size_t)32 * 1024;
constexpr size_t OUT_TOTAL = OUT_FC_S + (size_t)2 * 32 * 2 * F2;

enum { I_XP = 0, I_XS, I_CK, I_CV, I_SRC, I_SRH, I_SFC, I_CP, I_CS, I_WADA, I_BADA, I_WINE, I_LNG, I_LNB, I_WSGU, I_BSGU, I_WOUTE,
       I_WINO, I_RCW, I_RCB, I_RWA, I_RBA, I_RWX, I_RBX, I_RLAM, I_WOUTO, I_FUP, I_FCW, I_FCB, I_FDN, I_FING, N_IN };

struct Params { const float* in[N_IN]; float* out; unsigned char* ws; };

DI float bf2f(bf16_t b) { return __uint_as_float(((unsigned)b) << 16); }
DI float bfs2f(short b) { return __uint_as_float(((unsigned)(unsigned short)b) << 16); }
DI unsigned pk2(float lo, float hi) { return pg8::cvt_pk_bf16(lo, hi); }
DI bf16_t f2bf(float f) { return (bf16_t)(pk2(f, 0.f) & 0xffffu); }
DI float wave_sum(float v) {
#pragma unroll
    for (int o = 1; o < 64; o <<= 1) v += __shfl_xor(v, o);
    return v;
}
DI float wave_max(float v) {
#pragma unroll
    for (int o = 1; o < 64; o <<= 1) v = fmaxf(v, __shfl_xor(v, o));
    return v;
}
DI float gelu_tanh(float x) {
    const float u2 = (-2.f * 0.7978845608028654f * 1.4426950408889634f) * (x + 0.044715f * x * x * x);
    return x * __builtin_amdgcn_rcpf(1.f + __builtin_amdgcn_exp2f(u2));
}
DI float sigmoidf(float x) { return 1.f / (1.f + __expf(-x)); }
DI float fexp2(float x) { return __builtin_amdgcn_exp2f(x); }
DI float frcp(float x) { return __builtin_amdgcn_rcpf(x); }
DI float fsigmoid(float x) { return frcp(1.f + fexp2(-1.4426950408889634f * x)); }
DI int crow(int reg, int hf) { return (reg & 3) + 8 * (reg >> 2) + 4 * hf; }
DI int bidx_of(int row) { return row < MP ? (row >> 12) : 4 + (row - MP); }
DI void store_bf16x4(bf16_t* p, f32x4 v) { u32x2 o; o.x = pk2(v.x, v.y); o.y = pk2(v.z, v.w); *(u32x2*)p = o; }
DI bf16x8 pack_step(const f32x16& x, int s) {
    u32x4 p;
    p.x = pk2(x[8 * s + 0], x[8 * s + 1]); p.y = pk2(x[8 * s + 2], x[8 * s + 3]); p.z = pk2(x[8 * s + 4], x[8 * s + 5]); p.w = pk2(x[8 * s + 6], x[8 * s + 7]);
    return __builtin_bit_cast(bf16x8, p);
}
DI s16x4 tr_read(unsigned lds_addr) { s16x4 r; asm volatile("ds_read_b64_tr_b16 %0, %1\n\ts_waitcnt lgkmcnt(0)" : "=&v"(r) : "v"(lds_addr) : "memory"); return r; }

DI void transpose_item(const float* __restrict__ W, int K, int N, bf16_t* WT, int item, LAS float* scr, int lane, bool pair_up = false) {
    const int nblk = N >> 5, kb = item / nblk, nb = item - kb * nblk, k0 = 64 * kb, n0 = 32 * nb;
    int r0 = n0; if (pair_up) { const int half = n0 >= DFF ? 1 : 0, chn = n0 - half * DFF; r0 = 256 * (chn >> 7) + 128 * half + (chn & 127); }
    float tv[32];
#pragma unroll
    for (int i = 0; i < 32; ++i) tv[i] = W[(size_t)(k0 + 2 * i + (lane >> 5)) * N + n0 + (lane & 31)];
#pragma unroll
    for (int i = 0; i < 32; ++i) scr[(2 * i + (lane >> 5)) * 33 + (lane & 31)] = tv[i];
    asm volatile("s_waitcnt lgkmcnt(0)" ::: "memory");
    const int c = lane & 7;
#pragma unroll
    for (int j = 0; j < 4; ++j) { const int n = (lane >> 3) + 8 * j; const LAS float* sp = scr + (8 * c) * 33 + n;
        u32x4 o; o.x = pk2(sp[0 * 33], sp[1 * 33]); o.y = pk2(sp[2 * 33], sp[3 * 33]); o.z = pk2(sp[4 * 33], sp[5 * 33]); o.w = pk2(sp[6 * 33], sp[7 * 33]);
        *(u32x4*)(WT + (size_t)(r0 + n) * K + k0 + 8 * c) = o; }
    asm volatile("s_waitcnt lgkmcnt(0)" ::: "memory");
}

DI void adaln_item(const Params& p, int item, ldsp lds) {
    const int qr = item & 3, l = (item >> 2) / 96, j0 = ((item >> 2) % 96) * 64, tid = threadIdx.x, w = tid >> 6, lane = tid & 63;
    LAS float* s = (LAS float*)lds;
    LAS float* part = (LAS float*)(lds + 9 * 1024 * 4);
    const float* W = p.in[I_WADA] + (size_t)l * 1024 * 6144;
    float* MOD = (float*)(p.ws + O_MOD);
    for (int idx = tid; idx < 9 * 1024; idx += 512) {
        const int r = idx >> 10, k = idx & 1023, rr = qr * 9 + r;
        const float c = rr < 4 ? p.in[I_CP][rr * 1024 + k] : p.in[I_CS][(rr - 4) * 1024 + k];
        s[idx] = c / (1.f + __expf(-c));
    }
    __syncthreads();
    float acc[9];
#pragma unroll
    for (int r = 0; r < 9; ++r) acc[r] = 0.f;
    const int kbase = w * 128;
    for (int k = 0; k < 128; k += 32) {
        float wv[32];
#pragma unroll
        for (int i = 0; i < 32; ++i) wv[i] = W[(size_t)(kbase + k + i) * 6144 + j0 + lane];
#pragma unroll
        for (int i = 0; i < 32; i += 4) {
#pragma unroll
            for (int r = 0; r < 9; ++r) { const f32x4 sv = *(LAS f32x4*)(s + r * 1024 + kbase + k + i); acc[r] += sv.x * wv[i] + sv.y * wv[i + 1] + sv.z * wv[i + 2] + sv.w * wv[i + 3]; }
        }
    }
#pragma unroll
    for (int r = 0; r < 9; ++r) part[(w * 9 + r) * 64 + lane] = acc[r];
    __syncthreads();
    for (int idx = tid; idx < 9 * 64; idx += 512) {
        const int r = idx >> 6, j = idx & 63; float sum = 0.f;
#pragma unroll
        for (int ww = 0; ww < 8; ++ww) sum += part[(ww * 9 + r) * 64 + j];
        MOD[(size_t)(l * 36 + qr * 9 + r) * 6144 + j0 + j] = sum + p.in[I_BADA][l * 6144 + j0 + j];
    }
    __syncthreads();
}

constexpr int P0_ADA = 768;
constexpr int T_INE = 16 * 80, T_OUTE = 16 * 32, T_INO = 16 * 64, T_OUTO = 16 * 32, T_UP = 16 * 176, T_DN = 44 * 32, T_G = 2 * 4;
constexpr int P0_TR = T_INE + T_OUTE + T_INO + T_OUTO + 2 * T_UP + 2 * T_DN + 16 * T_G;
constexpr int P0_TRIL = 16;
constexpr int P0_WITEMS = P0_TR + P0_TRIL;
constexpr int CTR_WORD = 3584;

DI void p0_wave_item(const Params& p, int r, LAS float* scr, int lane) {
    unsigned char* ws = p.ws;
    if (r < T_INE) { transpose_item(p.in[I_WINE], 1024, NIE, (bf16_t*)(ws + O_WT_IN_E), r, scr, lane); return; } r -= T_INE;
    if (r < T_OUTE) { transpose_item(p.in[I_WOUTE], 1024, 1024, (bf16_t*)(ws + O_WT_OUT_E), r, scr, lane); return; } r -= T_OUTE;
    if (r < T_INO) { transpose_item(p.in[I_WINO], 1024, 2048, (bf16_t*)(ws + O_WT_IN_O), r, scr, lane); return; } r -= T_INO;
    if (r < T_OUTO) { transpose_item(p.in[I_WOUTO], 1024, 1024, (bf16_t*)(ws + O_WT_OUT_O), r, scr, lane); return; } r -= T_OUTO;
    if (r < 2 * T_UP) { const int l = r / T_UP; transpose_item(p.in[I_FUP] + (size_t)l * 1024 * F2, 1024, F2, (bf16_t*)(ws + O_WT_UP + l * SZ_WT_UP), r - l * T_UP, scr, lane, true); return; } r -= 2 * T_UP;
    if (r < 2 * T_DN) { const int l = r / T_DN; transpose_item(p.in[I_FDN] + (size_t)l * DFF * 1024, DFF, 1024, (bf16_t*)(ws + O_WT_DN + l * SZ_WT_DN), r - l * T_DN, scr, lane); return; } r -= 2 * T_DN;
    if (r < 16 * T_G) { const int which = r / (8 * T_G), rr = r % (8 * T_G), g = rr / T_G, ti = rr % T_G;
        transpose_item(p.in[which ? I_RWX : I_RWA] + (size_t)g * 128 * 128, 128, 128, (bf16_t*)(ws + O_WT_GA) + (size_t)(g * 256 + which * 128) * 128, ti, scr, lane); return; }
    r -= 16 * T_G;
    {
        const int g = r >> 2, q = r & 3;
        bf16_t* dst = (bf16_t*)(ws + O_WS_TRIL) + (size_t)g * 16384 + q * 4096; const float* src = p.in[I_WSGU] + (size_t)g * 16384 + q * 4096;
        for (int idx = lane; idx < 4096; idx += 64) { const int t = q * 32 + (idx >> 7), sidx = idx & 127; dst[idx] = f2bf(sidx <= t ? src[idx] : 0.f); }
    }
}

DI void phase0(const Params& p, ldsp lds, int rep) {
    for (int it = blockIdx.x; it < P0_ADA; it += gridDim.x) adaln_item(p, it, lds);
#if ADA_TWICE
    for (int it = blockIdx.x; it < P0_ADA; it += gridDim.x) adaln_item(p, it, lds);
#endif
    const int wave = threadIdx.x >> 6, lane = threadIdx.x & 63;
    LAS float* scr = (LAS float*)(lds + wave * 8448);
    for (int it = wave * (int)gridDim.x + (int)blockIdx.x; it < P0_WITEMS; it += 8 * (int)gridDim.x) p0_wave_item(p, it, scr, lane);
#if TR_TWICE
    for (int it = wave * (int)gridDim.x + (int)blockIdx.x; it < P0_WITEMS; it += 8 * (int)gridDim.x) p0_wave_item(p, it, scr, lane);
#endif
}

constexpr int COPY_ITEMS = 2048;
DI void copy_items(const Params& p, int lo, int hi, int first, int stride) {
    constexpr int PER_B = 2047 * 128;
    for (int r = lo + first; r < hi; r += 2 * stride) {
        const int r2 = r + stride; const bool two = r2 < hi;
        const int wb0 = r >> 5, rb0 = r & 31, wb1 = (two ? r2 : r) >> 5, rb1 = (two ? r2 : r) & 31;
        const f32x4* s0 = (const f32x4*)(p.in[(wb0 >> 5) ? I_CV : I_CK] + (size_t)(wb0 & 31) * 2048 * 512 + 512) + rb0 * 8192 + threadIdx.x;
        f32x4* d0 = (f32x4*)(p.out + ((wb0 >> 5) ? OUT_WV_S : OUT_WK_S) + (size_t)(wb0 & 31) * 2048 * 512) + rb0 * 8192 + threadIdx.x;
        const f32x4* s1 = (const f32x4*)(p.in[(wb1 >> 5) ? I_CV : I_CK] + (size_t)(wb1 & 31) * 2048 * 512 + 512) + rb1 * 8192 + threadIdx.x;
        f32x4* d1 = (f32x4*)(p.out + ((wb1 >> 5) ? OUT_WV_S : OUT_WK_S) + (size_t)(wb1 & 31) * 2048 * 512) + rb1 * 8192 + threadIdx.x;
        const int q0 = rb0 * 8192 + (int)threadIdx.x, q1 = rb1 * 8192 + (int)threadIdx.x;
        f32x4 v0[16], v1[16];
#pragma unroll
        for (int i = 0; i < 16; ++i) if (q0 + i * 512 < PER_B) v0[i] = __builtin_nontemporal_load(s0 + i * 512);
        if (two) {
#pragma unroll
            for (int i = 0; i < 16; ++i) if (q1 + i * 512 < PER_B) v1[i] = __builtin_nontemporal_load(s1 + i * 512);
        }
#pragma unroll
        for (int i = 0; i < 16; ++i) if (q0 + i * 512 < PER_B) __builtin_nontemporal_store(v0[i], d0 + i * 512);
        if (two) {
#pragma unroll
            for (int i = 0; i < 16; ++i) if (q1 + i * 512 < PER_B) __builtin_nontemporal_store(v1[i], d1 + i * 512);
        }
    }
}

DI void norm_phase(const float* xp, const float* xs, const float* mod, int sh_off, int sc_off, bf16_t* H) {
    const int lane = threadIdx.x & 63, gw = blockIdx.x * 8 + (threadIdx.x >> 6), ngw = gridDim.x * 8;
    for (int row0 = gw * 4; row0 < MT; row0 += ngw * 4) {
        f32x4 v[4][4];
#pragma unroll
        for (int r = 0; r < 4; ++r) { const int row = row0 + r; const float* src = row < MP ? xp + (size_t)row * DM : xs + (size_t)(row - MP) * DM;
#pragma unroll
            for (int j = 0; j < 4; ++j) v[r][j] = *((const f32x4*)src + lane + 64 * j); }
#pragma unroll
        for (int r = 0; r < 4; ++r) {
            const int row = row0 + r; const float* mrow = mod + (size_t)bidx_of(row) * 6144;
            float ss = 0.f;
#pragma unroll
            for (int j = 0; j < 4; ++j) ss += v[r][j].x * v[r][j].x + v[r][j].y * v[r][j].y + v[r][j].z * v[r][j].z + v[r][j].w * v[r][j].w;
            const float rs = rsqrtf(wave_sum(ss) * (1.f / DM) + 1e-6f);
#pragma unroll
            for (int j = 0; j < 4; ++j) {
                const int col = 4 * (lane + 64 * j);
                const f32x4 sc = *(const f32x4*)(mrow + sc_off + col), sh = *(const f32x4*)(mrow + sh_off + col);
                f32x4 h; h.x = v[r][j].x * rs * (1.f + sc.x) + sh.x; h.y = v[r][j].y * rs * (1.f + sc.y) + sh.y; h.z = v[r][j].z * rs * (1.f + sc.z) + sh.z; h.w = v[r][j].w * rs * (1.f + sc.w) + sh.w;
                store_bf16x4(H + (size_t)row * DM + col, h);
            }
        }
    }
}
DI void final_norm_phase(const float* X, const float* g, float* yp, float* ys) {
    const int lane = threadIdx.x & 63, gw = blockIdx.x * 8 + (threadIdx.x >> 6), ngw = gridDim.x * 8;
    f32x4 gg[4];
#pragma unroll
    for (int j = 0; j < 4; ++j) gg[j] = *((const f32x4*)g + lane + 64 * j);
    for (int row0 = gw * 4; row0 < MT; row0 += ngw * 4) {
        f32x4 v[4][4];
#pragma unroll
        for (int r = 0; r < 4; ++r) {
#pragma unroll
            for (int j = 0; j < 4; ++j) v[r][j] = *((const f32x4*)(X + (size_t)(row0 + r) * DM) + lane + 64 * j); }
#pragma unroll
        for (int r = 0; r < 4; ++r) {
            const int row = row0 + r; float* dst = row < MP ? yp + (size_t)row * DM : ys + (size_t)(row - MP) * DM;
            float ss = 0.f;
#pragma unroll
            for (int j = 0; j < 4; ++j) ss += v[r][j].x * v[r][j].x + v[r][j].y * v[r][j].y + v[r][j].z * v[r][j].z + v[r][j].w * v[r][j].w;
            const float rs = rsqrtf(wave_sum(ss) * (1.f / DM) + 1e-6f);
#pragma unroll
            for (int j = 0; j < 4; ++j) *((f32x4*)dst + lane + 64 * j) = v[r][j] * rs * gg[j];
        }
    }
}

DI void final_norm_samples(const bf16_t* X, const float* g, float* ys) {
    const int lane = threadIdx.x & 63, gw = blockIdx.x * 8 + (threadIdx.x >> 6);
    if (gw < MS) {
        const bf16_t* src = X + (size_t)(MP + gw) * DM; f32x4 v[4]; float ss = 0.f;
#pragma unroll
        for (int j = 0; j < 4; ++j) { const u32x2 raw = *((const u32x2*)src + lane + 64 * j);
            v[j].x = __uint_as_float(raw.x << 16); v[j].y = __uint_as_float(raw.x & 0xffff0000u); v[j].z = __uint_as_float(raw.y << 16); v[j].w = __uint_as_float(raw.y & 0xffff0000u);
            ss += v[j].x * v[j].x + v[j].y * v[j].y + v[j].z * v[j].z + v[j].w * v[j].w; }
        const float rs = rsqrtf(wave_sum(ss) * (1.f / DM) + 1e-6f);
#pragma unroll
        for (int j = 0; j < 4; ++j) *((f32x4*)(ys + (size_t)gw * DM) + lane + 64 * j) = v[j] * rs * *((const f32x4*)g + lane + 64 * j);
    }
}

template <class Q> struct EpiWrap {
    static constexpr bool PERM = false, AFTER_DRAIN = false;
    Q q;
    DI void operator()(const f32x4 (&acc)[2][2][4][2], const pg8::Unit& u, int wr, int wc, int fr, int fq) const {
#pragma unroll
        for (int ai = 0; ai < 2; ++ai)
#pragma unroll
            for (int m = 0; m < 4; ++m) {
                const int row = u.pm * 256 + ai * 128 + wr * 64 + m * 16 + fr;
#pragma unroll
                for (int bj = 0; bj < 2; ++bj)
#pragma unroll
                    for (int n = 0; n < 2; ++n) q.quad(row, u.pn * 256 + bj * 128 + wc * 32 + n * 16 + 4 * fq, acc[ai][bj][m][n]);
            }
    }
};

struct EpiResFused {
    static constexpr bool PERM = false, AFTER_DRAIN = true;
    const float *rp, *rsm; bf16_t* X; const float* g;
    int mode;
    const float *sc, *sh; bf16_t* H; const float* fg; float* Y;
    float* slots; unsigned* cnt;
    DI void fused(f32x4 (&acc)[2][2][4][2], const pg8::Unit& u, int wr, int wc, int fr, int fq, ldsp lds, int wid, int lane) const {
        LAS float* part = (LAS float*)lds; LAS float* rsv = part + 1024;
#pragma unroll
        for (int ai = 0; ai < 2; ++ai)
#pragma unroll
            for (int m = 0; m < 4; ++m) {
                const int rl = ai * 128 + wr * 64 + m * 16 + fr, row = u.pm * 256 + rl;
                const size_t mb = (size_t)(row >> 12) * 6144;
                float ss = 0.f;
#pragma unroll
                for (int bj = 0; bj < 2; ++bj)
#pragma unroll
                    for (int n = 0; n < 2; ++n) {
                        const int col = u.pn * 256 + bj * 128 + wc * 32 + n * 16 + 4 * fq;
                        f32x4 x;
                        if (rp) x = *(const f32x4*)(rp + (size_t)row * DM + col);
                        else { const u32x2 raw = *(const u32x2*)(X + (size_t)row * DM + col); x.x = __uint_as_float(raw.x << 16); x.y = __uint_as_float(raw.x & 0xffff0000u); x.z = __uint_as_float(raw.y << 16); x.w = __uint_as_float(raw.y & 0xffff0000u); }
                        const f32x4 gg = *(const f32x4*)(g + mb + col);
                        const f32x4 xn = x + gg * acc[ai][bj][m][n];
                        acc[ai][bj][m][n] = xn;
                        if (mode == 0) store_bf16x4(X + (size_t)row * DM + col, xn);
                        ss += xn.x * xn.x + xn.y * xn.y + xn.z * xn.z + xn.w * xn.w;
                    }
                ss += __shfl_xor(ss, 16); ss += __shfl_xor(ss, 32);
                if (fq == 0) part[wc * 256 + rl] = ss;
            }
        __syncthreads();
        const int tid = threadIdx.x;
        if (tid < 256) __hip_atomic_store(slots + (size_t)u.pn * MP + u.pm * 256 + tid, (part[tid] + part[256 + tid]) + (part[512 + tid] + part[768 + tid]), __ATOMIC_RELAXED, __HIP_MEMORY_SCOPE_AGENT);
        asm volatile("s_waitcnt vmcnt(0)" ::: "memory");
        __syncthreads();
        if (tid == 0) {
            __hip_atomic_fetch_add(cnt + u.pm, 1u, __ATOMIC_RELAXED, __HIP_MEMORY_SCOPE_AGENT);
            unsigned spins = 0;
            while (__hip_atomic_load(cnt + u.pm, __ATOMIC_RELAXED, __HIP_MEMORY_SCOPE_AGENT) < 4u) { __builtin_amdgcn_s_sleep(1); if (++spins > (1u << 22)) break; }
        }
        __syncthreads();
        if (tid < 256) {
            const float* sp = slots + u.pm * 256 + tid;
            const float t0 = __hip_atomic_load(sp, __ATOMIC_RELAXED, __HIP_MEMORY_SCOPE_AGENT), t1 = __hip_atomic_load(sp + MP, __ATOMIC_RELAXED, __HIP_MEMORY_SCOPE_AGENT);
            const float t2 = __hip_atomic_load(sp + 2 * MP, __ATOMIC_RELAXED, __HIP_MEMORY_SCOPE_AGENT), t3 = __hip_atomic_load(sp + 3 * MP, __ATOMIC_RELAXED, __HIP_MEMORY_SCOPE_AGENT);
            rsv[tid] = rsqrtf(((t0 + t1) + (t2 + t3)) * (1.f / DM) + 1e-6f);
        }
        __syncthreads();
#pragma unroll
        for (int ai = 0; ai < 2; ++ai)
#pragma unroll
            for (int m = 0; m < 4; ++m) {
                const int rl = ai * 128 + wr * 64 + m * 16 + fr, row = u.pm * 256 + rl;
                const size_t mb = (size_t)(row >> 12) * 6144;
                const float r = rsv[rl];
#pragma unroll
                for (int bj = 0; bj < 2; ++bj)
#pragma unroll
                    for (int n = 0; n < 2; ++n) {
                        const int col = u.pn * 256 + bj * 128 + wc * 32 + n * 16 + 4 * fq;
                        const f32x4 xn = acc[ai][bj][m][n];
                        if (mode == 0) {
                            const f32x4 s1 = *(const f32x4*)(sc + mb + col), s0 = *(const f32x4*)(sh + mb + col);
                            f32x4 h; h.x = xn.x * r * (1.f + s1.x) + s0.x; h.y = xn.y * r * (1.f + s1.y) + s0.y; h.z = xn.z * r * (1.f + s1.z) + s0.z; h.w = xn.w * r * (1.f + s1.w) + s0.w;
                            store_bf16x4(H + (size_t)row * DM + col, h);
                        } else {
                            const f32x4 f = *(const f32x4*)(fg + col);
                            *(f32x4*)(Y + (size_t)row * DM + col) = xn * r * f;
                        }
                    }
            }
        __syncthreads();
    }
    DI void quad(int row, int col, f32x4 v) const {
        f32x4 x;
        if (rsm) x = *(const f32x4*)(rsm + (size_t)(row - MP) * DM + col);
        else { const u32x2 raw = *(const u32x2*)(X + (size_t)row * DM + col); x.x = __uint_as_float(raw.x << 16); x.y = __uint_as_float(raw.x & 0xffff0000u); x.z = __uint_as_float(raw.y << 16); x.w = __uint_as_float(raw.y & 0xffff0000u); }
        const f32x4 gg = *(const f32x4*)(g + (size_t)bidx_of(row) * 6144 + col);
        store_bf16x4(X + (size_t)row * DM + col, x + gg * v);
    }
};

struct EpiUpGate {
    static constexpr bool PERM = true, AFTER_DRAIN = false;
    bf16_t* ACT; bf16_t* UPB; const float* cw; const float* cb;
    static DI float ror1(float v) { return __builtin_bit_cast(float, __builtin_amdgcn_update_dpp(0, __builtin_bit_cast(int, v), 0x121, 0xf, 0xf, false)); }
    static DI float ror2(float v) { return __builtin_bit_cast(float, __builtin_amdgcn_update_dpp(0, __builtin_bit_cast(int, v), 0x122, 0xf, 0xf, false)); }
    static DI float shr1(float old, float v) { return __builtin_bit_cast(float, __builtin_amdgcn_update_dpp(__builtin_bit_cast(int, old), __builtin_bit_cast(int, v), 0x111, 0xf, 0xf, false)); }
    static DI float shr2(float old, float v) { return __builtin_bit_cast(float, __builtin_amdgcn_update_dpp(__builtin_bit_cast(int, old), __builtin_bit_cast(int, v), 0x112, 0xf, 0xf, false)); }
    DI void operator()(const f32x4 (&acc)[2][2][4][2], const pg8::Unit& u, int wr, int wc, int fr, int fq) const {
        const int ch0 = 128 * u.pn + 32 * wc + 8 * fq;
        u32x4 pk[2][4]; float ev[2][4];
#pragma unroll
        for (int n = 0; n < 2; ++n) {
#pragma unroll
            for (int c = 0; c < 4; ++c) {
                const int ch = ch0 + 4 * n + c;
                const float wa0 = cw[ch], wa1 = cw[F2 + ch], wa2 = cw[2 * F2 + ch], ba = cb[ch];
                const float wb0 = cw[DFF + ch], wb1 = cw[F2 + DFF + ch], wb2 = cw[2 * F2 + DFF + ch], bb = cb[DFF + ch];
#pragma unroll
                for (int ai = 0; ai < 2; ++ai) {
                    float q1a = 0.f, q2a = 0.f, q1b = 0.f, q2b = 0.f;
#pragma unroll
                    for (int m = 0; m < 4; ++m) {
                        const float va = acc[ai][0][m][n][c], vb = acc[ai][1][m][n][c];
                        const float p1a = shr1(q1a, va), p2a = shr2(q2a, va), p1b = shr1(q1b, vb), p2b = shr2(q2b, vb);
                        if (m < 3) { q1a = ror1(va); q2a = ror2(va); q1b = ror1(vb); q2b = ror2(vb); }
                        const float ya = ba + wa0 * p2a + wa1 * p1a + wa2 * va;
                        const float yb = bb + wb0 * p2b + wb1 * p1b + wb2 * vb;
                        const float act = ya * __builtin_amdgcn_rcpf(1.f + __builtin_amdgcn_exp2f(-1.4426950408889634f * ya)) * yb;
                        if (c == 0 || c == 2) ev[ai][m] = act;
                        else if (n == 0 && c == 1) pk[ai][m].x = pk2(ev[ai][m], act);
                        else if (n == 0 && c == 3) pk[ai][m].y = pk2(ev[ai][m], act);
                        else if (n == 1 && c == 1) pk[ai][m].z = pk2(ev[ai][m], act);
                        else pk[ai][m].w = pk2(ev[ai][m], act);
                    }
                }
            }
        }
#pragma unroll
        for (int ai = 0; ai < 2; ++ai)
#pragma unroll
            for (int m = 0; m < 4; ++m) {
                const int row = u.pm * 256 + ai * 128 + wr * 64 + m * 16 + fr;
                if (!(m == 0 && fr < 2)) *(u32x4*)(ACT + (size_t)row * DFF + ch0) = pk[ai][m];
                if ((m == 3 && fr >= 14) || (m == 0 && fr < 2)) {
                    const int slot = m == 3 ? fr - 14 : 2 + fr;
                    bf16_t* hb = UPB + (size_t)((row >> 6) * 4 + slot) * F2;
                    store_bf16x4(hb + ch0, acc[ai][0][m][0]); store_bf16x4(hb + ch0 + 4, acc[ai][0][m][1]);
                    store_bf16x4(hb + DFF + ch0, acc[ai][1][m][0]); store_bf16x4(hb + DFF + ch0 + 4, acc[ai][1][m][1]);
                }
            }
    }
};
struct QUpS {
    bf16_t* UP;
    DI void quad(int row, int pcol, f32x4 v) const {
        const int within = pcol & 255, col = (within >> 7) * DFF + 128 * (pcol >> 8) + (within & 127);
        store_bf16x4(UP + (size_t)row * F2 + col, v);
    }
};

template <class Q> struct EpiWrapP {
    static constexpr bool PERM = true, AFTER_DRAIN = false;
    Q q;
    DI void operator()(const f32x4 (&acc)[2][2][4][2], const pg8::Unit& u, int wr, int wc, int fr, int fq) const {
#pragma unroll
        for (int ai = 0; ai < 2; ++ai)
#pragma unroll
            for (int m = 0; m < 4; ++m) {
                const int row = u.pm * 256 + ai * 128 + wr * 64 + m * 16 + fr;
#pragma unroll
                for (int bj = 0; bj < 2; ++bj) q.oct(row, u.pn * 256 + bj * 128 + wc * 32 + 8 * fq, acc[ai][bj][m][0], acc[ai][bj][m][1]);
            }
    }
};

template <class Q> DI void sample_tail(const bf16_t* As, const bf16_t* Bt, int N, int K, const Q& q) {
    const int wave = threadIdx.x >> 6, lane = threadIdx.x & 63, nch = K >> 3;
    for (int qd = blockIdx.x; qd < (N >> 2); qd += gridDim.x) {
        float s[4][4];
#pragma unroll
        for (int r = 0; r < 4; ++r)
#pragma unroll
            for (int c = 0; c < 4; ++c) s[r][c] = 0.f;
        for (int ch = lane; ch < nch; ch += 64) {
            bf16x8 a[4], w[4];
#pragma unroll
            for (int r = 0; r < 4; ++r) a[r] = *(const bf16x8*)(As + (size_t)(4 * wave + r) * K + ch * 8);
#pragma unroll
            for (int c = 0; c < 4; ++c) w[c] = *(const bf16x8*)(Bt + (size_t)(4 * qd + c) * K + ch * 8);
#pragma unroll
            for (int j = 0; j < 8; ++j) {
                float af[4], wf[4];
#pragma unroll
                for (int r = 0; r < 4; ++r) af[r] = bfs2f(a[r][j]);
#pragma unroll
                for (int c = 0; c < 4; ++c) wf[c] = bfs2f(w[c][j]);
#pragma unroll
                for (int r = 0; r < 4; ++r)
#pragma unroll
                    for (int c = 0; c < 4; ++c) s[r][c] += af[r] * wf[c];
            }
        }
        const bool b5 = (lane & 32) != 0, b4 = (lane & 16) != 0;
        float k0[2][4], k1[4];
#pragma unroll
        for (int rr = 0; rr < 2; ++rr)
#pragma unroll
            for (int c = 0; c < 4; ++c) { const float keep = b5 ? s[2 + rr][c] : s[rr][c], send = b5 ? s[rr][c] : s[2 + rr][c]; k0[rr][c] = keep + __shfl_xor(send, 32); }
#pragma unroll
        for (int c = 0; c < 4; ++c) { const float keep = b4 ? k0[1][c] : k0[0][c], send = b4 ? k0[0][c] : k0[1][c]; k1[c] = keep + __shfl_xor(send, 16); }
#pragma unroll
        for (int c = 0; c < 4; ++c) {
#pragma unroll
            for (int o = 8; o >= 1; o >>= 1) k1[c] += __shfl_xor(k1[c], o); }
        f32x4 v; v.x = k1[0]; v.y = k1[1]; v.z = k1[2]; v.w = k1[3];
        if ((lane & 15) == 0) q.quad(MP + 4 * wave + (lane >> 4), 4 * qd, v);
    }
}

template <class Q> DI void sample_tail_norm(const bf16_t* Xs  , const float* mod  , int sh_off, int sc_off, const bf16_t* Bt, int N, const Q& q) {
    const int wave = threadIdx.x >> 6, lane = threadIdx.x & 63;
    float af[4][16];
#pragma unroll
    for (int r = 0; r < 4; ++r) {
        const int bs = 4 * wave + r; const bf16_t* xr = Xs + (size_t)bs * DM; const float* mr = mod + (size_t)(4 + bs) * 6144;
        f32x4 xv[4]; float ss = 0.f;
#pragma unroll
        for (int it = 0; it < 2; ++it) { const bf16x8 raw = *(const bf16x8*)(xr + (lane + 64 * it) * 8);
            xv[2 * it].x = bfs2f(raw[0]); xv[2 * it].y = bfs2f(raw[1]); xv[2 * it].z = bfs2f(raw[2]); xv[2 * it].w = bfs2f(raw[3]);
            xv[2 * it + 1].x = bfs2f(raw[4]); xv[2 * it + 1].y = bfs2f(raw[5]); xv[2 * it + 1].z = bfs2f(raw[6]); xv[2 * it + 1].w = bfs2f(raw[7]); }
#pragma unroll
        for (int j = 0; j < 4; ++j) ss += xv[j].x * xv[j].x + xv[j].y * xv[j].y + xv[j].z * xv[j].z + xv[j].w * xv[j].w;
        const float rsx = rsqrtf(wave_sum(ss) * (1.f / DM) + 1e-6f);
#pragma unroll
        for (int it = 0; it < 2; ++it)
#pragma unroll
            for (int hh = 0; hh < 2; ++hh) {
                const int k0 = (lane + 64 * it) * 8 + 4 * hh;
                const f32x4 s1 = *(const f32x4*)(mr + sc_off + k0), s0 = *(const f32x4*)(mr + sh_off + k0), xx = xv[2 * it + hh];
                af[r][8 * it + 4 * hh + 0] = xx.x * rsx * (1.f + s1.x) + s0.x; af[r][8 * it + 4 * hh + 1] = xx.y * rsx * (1.f + s1.y) + s0.y;
                af[r][8 * it + 4 * hh + 2] = xx.z * rsx * (1.f + s1.z) + s0.z; af[r][8 * it + 4 * hh + 3] = xx.w * rsx * (1.f + s1.w) + s0.w;
            }
    }
    for (int qd = blockIdx.x; qd < (N >> 2); qd += gridDim.x) {
        float s[4][4];
#pragma unroll
        for (int r = 0; r < 4; ++r)
#pragma unroll
            for (int c = 0; c < 4; ++c) s[r][c] = 0.f;
#pragma unroll
        for (int it = 0; it < 2; ++it) {
            bf16x8 w[4];
#pragma unroll
            for (int c = 0; c < 4; ++c) w[c] = *(const bf16x8*)(Bt + (size_t)(4 * qd + c) * 1024 + (lane + 64 * it) * 8);
#pragma unroll
            for (int j = 0; j < 8; ++j)
#pragma unroll
                for (int c = 0; c < 4; ++c) { const float wf = bfs2f(w[c][j]);
#pragma unroll
                    for (int r = 0; r < 4; ++r) s[r][c] += af[r][8 * it + j] * wf; }
        }
        const bool b5 = (lane & 32) != 0, b4 = (lane & 16) != 0;
        float k0[2][4], k1[4];
#pragma unroll
        for (int rr = 0; rr < 2; ++rr)
#pragma unroll
            for (int c = 0; c < 4; ++c) { const float keep = b5 ? s[2 + rr][c] : s[rr][c], send = b5 ? s[rr][c] : s[2 + rr][c]; k0[rr][c] = keep + __shfl_xor(send, 32); }
#pragma unroll
        for (int c = 0; c < 4; ++c) { const float keep = b4 ? k0[1][c] : k0[0][c], send = b4 ? k0[0][c] : k0[1][c]; k1[c] = keep + __shfl_xor(send, 16); }
#pragma unroll
        for (int c = 0; c < 4; ++c) {
#pragma unroll
            for (int o = 8; o >= 1; o >>= 1) k1[c] += __shfl_xor(k1[c], o); }
        f32x4 v; v.x = k1[0]; v.y = k1[1]; v.z = k1[2]; v.w = k1[3];
        if ((lane & 15) == 0) q.quad(MP + 4 * wave + (lane >> 4), 4 * qd, v);
    }
}
template <class Q> DI void gemm_all_p_sn(ldsp lds, const bf16_t* A, const bf16_t* Bt, int N, const Q& q, const bf16_t* Xs, const float* mod, int sh_off, int sc_off) {
    pg8::Gemm g{A, Bt, MP, N, 1024};
    pg8::StaticOrder S; S.init(MP, N, (int)gridDim.x, (int)blockIdx.x);
    EpiWrapP<Q> E{q};
    pg8::gemm_phase<EpiWrapP<Q>, pg8::StaticOrder, false>(lds, g, S, E, nullptr);
    sample_tail_norm(Xs, mod, sh_off, sc_off, Bt, N, q);
}
DI void gemm_upgate(ldsp lds, const bf16_t* A, const bf16_t* Bt, const EpiUpGate& E, const QUpS& qs, const bf16_t* Xs, const float* mod, int sh_off, int sc_off) {
    pg8::Gemm g{A, Bt, MP, F2, 1024};
    pg8::StaticOrder S; S.init(MP, F2, (int)gridDim.x, (int)blockIdx.x);
    pg8::gemm_phase<EpiUpGate, pg8::StaticOrder, false>(lds, g, S, E, nullptr);
    sample_tail_norm(Xs, mod, sh_off, sc_off, Bt, F2, qs);
}
DI void gemm_res_fused(ldsp lds, const bf16_t* A, const bf16_t* Bt, int K, const EpiResFused& E) {
    pg8::Gemm g{A, Bt, MP, 1024, K};
    pg8::StaticOrder S; S.init(MP, 1024, (int)gridDim.x, (int)blockIdx.x);
    pg8::gemm_phase<EpiResFused, pg8::StaticOrder, false>(lds, g, S, E, nullptr);
    sample_tail(A + (size_t)MP * K, Bt, 1024, K, E);
}
template <class Q> DI void gemm_all_p(ldsp lds, const bf16_t* A, const bf16_t* Bt, int N, int K, const Q& q) {
    pg8::Gemm g{A, Bt, MP, N, K};
    pg8::StaticOrder S; S.init(MP, N, (int)gridDim.x, (int)blockIdx.x);
    EpiWrapP<Q> E{q};
    pg8::gemm_phase<EpiWrapP<Q>, pg8::StaticOrder, false>(lds, g, S, E, nullptr);
    sample_tail(A + (size_t)MP * K, Bt, N, K, q);
}
template <class Q> DI void gemm_all(ldsp lds, const bf16_t* A, const bf16_t* Bt, int N, int K, const Q& q) {
    pg8::Gemm g{A, Bt, MP, N, K};
    pg8::StaticOrder S; S.init(MP, N, (int)gridDim.x, (int)blockIdx.x);
    EpiWrap<Q> E{q};
    pg8::gemm_phase<EpiWrap<Q>, pg8::StaticOrder, false>(lds, g, S, E, nullptr);
    sample_tail(A + (size_t)MP * K, Bt, N, K, q);
}
DI void copy_share(const Params& p, int lo, int hi) {
    const int half = (int)gridDim.x >> 1;
    if ((int)blockIdx.x >= half) { copy_items(p, lo, hi, (int)blockIdx.x - half, (int)gridDim.x - half);
#if COPY_TWICE
        copy_items(p, lo, hi, (int)blockIdx.x - half, (int)gridDim.x - half);
#endif
    }
}

struct QInE {
    bf16_t* Z; float *wk_p, *wv_p, *wk_s, *wv_s;
    DI void quad(int row, int col, f32x4 v) const {
        if (col < 1024) { v.x = gelu_tanh(v.x); v.y = gelu_tanh(v.y); v.z = gelu_tanh(v.z); v.w = gelu_tanh(v.w); }
        store_bf16x4(Z + (size_t)row * NIE + col, v);
        if (col >= 1536) *(f32x4*)((col < 2048 ? wk_s : wv_s) + ((size_t)(row - MP) * 2048 + 2047) * 512 + ((col - 1536) & 511)) = v;
    }
    DI void oct(int row, int col, f32x4 a, f32x4 b) const {
        if (col < 1024) { a.x = gelu_tanh(a.x); a.y = gelu_tanh(a.y); a.z = gelu_tanh(a.z); a.w = gelu_tanh(a.w); b.x = gelu_tanh(b.x); b.y = gelu_tanh(b.y); b.z = gelu_tanh(b.z); b.w = gelu_tanh(b.w); }
        u32x4 o; o.x = pk2(a.x, a.y); o.y = pk2(a.z, a.w); o.z = pk2(b.x, b.y); o.w = pk2(b.z, b.w);
        *(u32x4*)(Z + (size_t)row * NIE + col) = o;
        if (col >= 1536 && (row & 2048)) {
            float* dst = (col < 2048 ? wk_p : wv_p) + ((size_t)((row >> 12) * 2048 + (row & 2047))) * 512 + ((col - 1536) & 511);
            *(f32x4*)dst = a; *(f32x4*)(dst + 4) = b;
        }
    }
};
struct QRes {
    const float *rp, *rs; float* X; const float* g;
    DI void quad(int row, int col, f32x4 v) const {
        const float* r = row < MP ? rp + (size_t)row * DM : rs + (size_t)(row - MP) * DM;
        const f32x4 x = *(const f32x4*)(r + col), gg = *(const f32x4*)(g + (size_t)bidx_of(row) * 6144 + col);
        *(f32x4*)(X + (size_t)row * DM + col) = x + gg * v;
    }
};
struct QUp {
    bf16_t* UP;
    DI void quad(int row, int col, f32x4 v) const { store_bf16x4(UP + (size_t)row * F2 + col, v); }
    DI void oct(int row, int col, f32x4 a, f32x4 b) const {
        u32x4 o; o.x = pk2(a.x, a.y); o.y = pk2(a.z, a.w); o.z = pk2(b.x, b.y); o.w = pk2(b.z, b.w);
        *(u32x4*)(UP + (size_t)row * F2 + col) = o;
    }
};
struct QInO {
    bf16_t* ZO;
    DI void quad(int row, int col, f32x4 v) const {
        if (col < 1024) { v.x = gelu_tanh(v.x); v.y = gelu_tanh(v.y); v.z = gelu_tanh(v.z); v.w = gelu_tanh(v.w); }
        store_bf16x4(ZO + (size_t)row * 2048 + col, v);
    }
    DI void oct(int row, int col, f32x4 a, f32x4 b) const {
        if (col < 1024) { a.x = gelu_tanh(a.x); a.y = gelu_tanh(a.y); a.z = gelu_tanh(a.z); a.w = gelu_tanh(a.w); b.x = gelu_tanh(b.x); b.y = gelu_tanh(b.y); b.z = gelu_tanh(b.z); b.w = gelu_tanh(b.w); }
        u32x4 o; o.x = pk2(a.x, a.y); o.y = pk2(a.z, a.w); o.z = pk2(b.x, b.y); o.w = pk2(b.z, b.w);
        *(u32x4*)(ZO + (size_t)row * 2048 + col) = o;
    }
};

constexpr float SC_LOG2E = 0.125f * 1.4426950408889634f;
DI void attn_item(const bf16_t* Z, bf16_t* OP, float* LSE, int item, ldsp lds) {
    const int pat = item >> 9, rem = item & 511, b = rem >> 7, hd = (rem >> 4) & 7, blk = rem & 15;
    const int d = pat == 0 ? 1 : (pat == 1 ? 4 : 16);
    const int r = pat == 0 ? 0 : (pat == 1 ? (blk >> 2) : blk), mblk = pat == 0 ? blk : (pat == 1 ? (blk & 3) : 0);
    const int w = threadIdx.x >> 6, lane = threadIdx.x & 63, ql = lane & 31, hf = lane >> 5;
    const int m0 = mblk * 256 + 32 * w;
    const bf16_t* Zb = Z + (size_t)(b * SEQ + r) * NIE;
    const size_t vs = (size_t)d * NIE;
    bf16x8 qf[4];
    { const bf16_t* qrow = Zb + (size_t)(m0 + ql) * vs + 1024 + hd * 64 + 8 * hf;
#pragma unroll
      for (int s = 0; s < 4; ++s) qf[s] = *(const bf16x8*)(qrow + 16 * s); }
    f32x16 o0, o1;
#pragma unroll
    for (int i = 0; i < 16; ++i) { o0[i] = 0.f; o1[i] = 0.f; }
    float mrun = -1e30f, lrun = 0.f;
    ldsp vimg = lds + w * 4608;
    const unsigned vaddr = (unsigned)(size_t)vimg;
    const int i16 = lane & 15, tq = i16 >> 2, tp = i16 & 3, tb = (lane >> 4) & 1;
    const unsigned traddr = vaddr + (4 * hf + tq) * 144 + tb * 32 + 8 * tp;
    const int mq = m0 + ql;
    const int jt_first = m0 >= 128 ? 0 : (128 - m0) >> 5;
    bf16x8 kf[4], kn[4]; u32x4 vt[4], vn[4];
    { const int kt0 = m0 - 128 + 32 * jt_first;
      const bf16_t* krow = Zb + (size_t)(kt0 + ql) * vs + 1536 + hd * 64 + 8 * hf;
#pragma unroll
      for (int s = 0; s < 4; ++s) kn[s] = *(const bf16x8*)(krow + 16 * s);
#pragma unroll
      for (int i = 0; i < 4; ++i) vn[i] = *(const u32x4*)(Zb + (size_t)(kt0 + 8 * i + (lane >> 3)) * vs + 2048 + hd * 64 + (lane & 7) * 8); }
    for (int jt = jt_first; jt < 5; ++jt) {
        const int kt0 = m0 - 128 + 32 * jt;
#pragma unroll
        for (int s = 0; s < 4; ++s) kf[s] = kn[s];
#pragma unroll
        for (int i = 0; i < 4; ++i) vt[i] = vn[i];
        if (jt < 4) {
            const int kt1 = kt0 + 32;
            const bf16_t* krow = Zb + (size_t)(kt1 + ql) * vs + 1536 + hd * 64 + 8 * hf;
#pragma unroll
            for (int s = 0; s < 4; ++s) kn[s] = *(const bf16x8*)(krow + 16 * s);
#pragma unroll
            for (int i = 0; i < 4; ++i) vn[i] = *(const u32x4*)(Zb + (size_t)(kt1 + 8 * i + (lane >> 3)) * vs + 2048 + hd * 64 + (lane & 7) * 8);
        }
        f32x16 st;
#pragma unroll
        for (int i = 0; i < 16; ++i) st[i] = 0.f;
#pragma unroll
        for (int s = 0; s < 4; ++s) st = MFMA32(kf[s], qf[s], st);
        float mx = -1e30f;
        if (jt == 0 || jt == 4) {
#pragma unroll
            for (int i = 0; i < 16; ++i) {
                const int dist = mq - (kt0 + crow(i, hf));
                const float sv = (dist >= 0 && dist <= 128) ? st[i] * SC_LOG2E : -1e30f;
                st[i] = sv; mx = fmaxf(mx, sv);
            }
        } else {
#pragma unroll
            for (int i = 0; i < 16; ++i) { const float sv = st[i] * SC_LOG2E; st[i] = sv; mx = fmaxf(mx, sv); }
        }
        mx = fmaxf(mx, __shfl_xor(mx, 32));
        const float mnew = fmaxf(mrun, mx), alpha = fexp2(mrun - mnew);
        mrun = mnew;
        float psum = 0.f;
#pragma unroll
        for (int i = 0; i < 16; ++i) { const float pv = fexp2(st[i] - mnew); st[i] = pv; psum += pv; }
        lrun = lrun * alpha + psum;
#pragma unroll
        for (int i = 0; i < 16; ++i) { o0[i] *= alpha; o1[i] *= alpha; }
#pragma unroll
        for (int i = 0; i < 4; ++i) *(LAS u32x4*)(vimg + (8 * i + (lane >> 3)) * 144 + (lane & 7) * 16) = vt[i];
        asm volatile("s_waitcnt lgkmcnt(0)" ::: "memory");
        const bf16x8 pf0 = pack_step(st, 0), pf1 = pack_step(st, 1);
        {
            s16x4 r0, r1, r2, r3, r4, r5, r6, r7;
            asm volatile("ds_read_b64_tr_b16 %0, %8\n\t"
                         "ds_read_b64_tr_b16 %1, %8 offset:1152\n\t"
                         "ds_read_b64_tr_b16 %2, %8 offset:2304\n\t"
                         "ds_read_b64_tr_b16 %3, %8 offset:3456\n\t"
                         "ds_read_b64_tr_b16 %4, %8 offset:64\n\t"
                         "ds_read_b64_tr_b16 %5, %8 offset:1216\n\t"
                         "ds_read_b64_tr_b16 %6, %8 offset:2368\n\t"
                         "ds_read_b64_tr_b16 %7, %8 offset:3520\n\t"
                         "s_waitcnt lgkmcnt(0)"
                         : "=&v"(r0), "=&v"(r1), "=&v"(r2), "=&v"(r3), "=&v"(r4), "=&v"(r5), "=&v"(r6), "=&v"(r7) : "v"(traddr) : "memory");
            o0 = MFMA32(__builtin_shufflevector(r0, r1, 0, 1, 2, 3, 4, 5, 6, 7), pf0, o0);
            o0 = MFMA32(__builtin_shufflevector(r2, r3, 0, 1, 2, 3, 4, 5, 6, 7), pf1, o0);
            o1 = MFMA32(__builtin_shufflevector(r4, r5, 0, 1, 2, 3, 4, 5, 6, 7), pf0, o1);
            o1 = MFMA32(__builtin_shufflevector(r6, r7, 0, 1, 2, 3, 4, 5, 6, 7), pf1, o1);
        }
    }
    lrun += __shfl_xor(lrun, 32);
    const float inv = 1.f / lrun;
    const size_t token = (size_t)b * SEQ + r + (size_t)d * mq;
    bf16_t* op = OP + ((size_t)pat * MP + token) * 512 + hd * 64;
#pragma unroll
    for (int g4 = 0; g4 < 4; ++g4) {
        f32x4 a, c;
        a.x = o0[4 * g4] * inv; a.y = o0[4 * g4 + 1] * inv; a.z = o0[4 * g4 + 2] * inv; a.w = o0[4 * g4 + 3] * inv;
        c.x = o1[4 * g4] * inv; c.y = o1[4 * g4 + 1] * inv; c.z = o1[4 * g4 + 2] * inv; c.w = o1[4 * g4 + 3] * inv;
        store_bf16x4(op + 8 * g4 + 4 * hf, a);
        store_bf16x4(op + 32 + 8 * g4 + 4 * hf, c);
    }
    if (hf == 0) LSE[((size_t)pat * MP + token) * 8 + hd] = mrun * 0.6931471805599453f + __logf(lrun);
}

DI void sgu_item(const Params& p, const bf16_t* Z, bf16_t* AO, int item, ldsp lds) {
    const int b = item >> 7, c = (item >> 2) & 31, g = item & 3, tid = threadIdx.x;
    const int row0 = b * SEQ + c * 128;
    LAS float* stat = (LAS float*)(lds + 128 * 272);
    const int w = tid >> 6, lane = tid & 63, ql = lane & 31, hf = lane >> 5, tt = w >> 1, dp = w & 1;
    const bf16_t* WS = (const bf16_t*)(p.ws + O_WS_TRIL) + (size_t)(g * 128 + 32 * tt + ql) * 128 + 8 * hf;
    bf16x8 afr[8];
#pragma unroll
    for (int ks = 0; ks < 8; ++ks) afr[ks] = *(const bf16x8*)(WS + 16 * ks);
    bf16_t u0[16], u1[16]; float bsv[16];
#pragma unroll
    for (int i = 0; i < 16; ++i) {
        const int t = 32 * tt + crow(i, hf); const size_t zr = (size_t)(row0 + t) * NIE + g * 128 + 64 * dp + ql;
        u0[i] = Z[zr]; u1[i] = Z[zr + 32]; bsv[i] = p.in[I_BSGU][g * 128 + t];
    }
    {
        const int row = tid >> 2, part = tid & 3;
        const bf16_t* ptr = Z + (size_t)(row0 + row) * NIE + 512 + part * 128;
        float s = 0.f, ss = 0.f;
#pragma unroll
        for (int i = 0; i < 16; ++i) { const bf16x8 v = *(const bf16x8*)(ptr + 8 * i);
#pragma unroll
            for (int j = 0; j < 8; ++j) { const float f = bfs2f(v[j]); s += f; ss += f * f; } }
        s += __shfl_xor(s, 1); s += __shfl_xor(s, 2); ss += __shfl_xor(ss, 1); ss += __shfl_xor(ss, 2);
        const float mu = s * (1.f / 512.f), var = fmaxf(ss * (1.f / 512.f) - mu * mu, 0.f);
        if (part == 0) { stat[row * 2] = mu; stat[row * 2 + 1] = rsqrtf(var + 1e-6f); }
    }
    __syncthreads();
    {
        const int st = tid >> 2, dch = tid & 3;
        const float mu = stat[st * 2], rstd = stat[st * 2 + 1];
        const float* lg = p.in[I_LNG] + g * 128; const float* lb = p.in[I_LNB] + g * 128;
#pragma unroll
        for (int i = 0; i < 4; ++i) {
            const int d0 = dch * 32 + i * 8;
            const bf16x8 v = *(const bf16x8*)(Z + (size_t)(row0 + st) * NIE + 512 + g * 128 + d0);
            const f32x4 g0 = *(const f32x4*)(lg + d0), g1 = *(const f32x4*)(lg + d0 + 4), h0 = *(const f32x4*)(lb + d0), h1 = *(const f32x4*)(lb + d0 + 4);
            const float gv[8] = {g0.x, g0.y, g0.z, g0.w, g1.x, g1.y, g1.z, g1.w}, hv[8] = {h0.x, h0.y, h0.z, h0.w, h1.x, h1.y, h1.z, h1.w};
#pragma unroll
            for (int j = 0; j < 8; ++j) { const float val = (bfs2f(v[j]) - mu) * rstd * gv[j] + hv[j]; *(LAS bf16_t*)(lds + (d0 + j) * 272 + st * 2) = f2bf(val); }
        }
    }
    __syncthreads();
    f32x16 c0, c1;
#pragma unroll
    for (int i = 0; i < 16; ++i) { c0[i] = 0.f; c1[i] = 0.f; }
#pragma unroll
    for (int ks = 0; ks < 8; ++ks) {
        if (ks >= 2 * tt + 2) break;
        const bf16x8 a = afr[ks];
        const bf16x8 b0 = *(LAS bf16x8*)(lds + (64 * dp + ql) * 272 + (16 * ks + 8 * hf) * 2);
        const bf16x8 b1 = *(LAS bf16x8*)(lds + (64 * dp + 32 + ql) * 272 + (16 * ks + 8 * hf) * 2);
        c0 = MFMA32(a, b0, c0); c1 = MFMA32(a, b1, c1);
    }
#pragma unroll
    for (int i = 0; i < 16; ++i) {
        const int t = 32 * tt + crow(i, hf);
        const size_t ar = (size_t)(row0 + t) * DM + g * 128 + 64 * dp + ql;
        AO[ar] = f2bf(bf2f(u0[i]) * (c0[i] + bsv[i]));
        AO[ar + 32] = f2bf(bf2f(u1[i]) * (c1[i] + bsv[i]));
    }
    __syncthreads();
}

DI void sgu_sample_item(const Params& p, const bf16_t* Z, bf16_t* AO, int row) {
    const int lane = threadIdx.x & 63;
    const bf16_t* zr = Z + (size_t)(MP + row) * NIE;
    const bf16x8 vv = *(const bf16x8*)(zr + 512 + lane * 8), uu = *(const bf16x8*)(zr + lane * 8);
    float vals[8]; float s = 0.f, ss = 0.f;
#pragma unroll
    for (int j = 0; j < 8; ++j) { const float f = bfs2f(vv[j]); vals[j] = f; s += f; ss += f * f; }
    s = wave_sum(s); ss = wave_sum(ss);
    const float mu = s * (1.f / 512.f), rstd = rsqrtf(fmaxf(ss * (1.f / 512.f) - mu * mu, 0.f) + 1e-6f);
    const int g = lane >> 4;
    const float w00 = p.in[I_WSGU][(size_t)g * 16384], b0 = p.in[I_BSGU][g * 128];
    float o[8];
#pragma unroll
    for (int j = 0; j < 8; ++j) {
        const int c = lane * 8 + j;
        const float vl = (vals[j] - mu) * rstd * p.in[I_LNG][c] + p.in[I_LNB][c];
        p.out[OUT_CV_S + (size_t)row * 512 + c] = vl;
        o[j] = bfs2f(uu[j]) * (w00 * vl + b0);
    }
    u32x4 ov; ov.x = pk2(o[0], o[1]); ov.y = pk2(o[2], o[3]); ov.z = pk2(o[4], o[5]); ov.w = pk2(o[6], o[7]);
    *(u32x4*)(AO + (size_t)(MP + row) * DM + lane * 8) = ov;
}

DI void attn_sample_item(const Params& p, const bf16_t* Z, bf16_t* AO, int item, ldsp lds) {
    const int bs = item >> 3, hd = item & 7, tid = threadIdx.x, wave = tid >> 6, lane = tid & 63;
    LAS float* sc = (LAS float*)lds; LAS float* red = sc + 512;
    const float* ck = p.in[I_CK] + (size_t)bs * 2048 * 512 + hd * 64;
    const float* cv = p.in[I_CV] + (size_t)bs * 2048 * 512 + hd * 64;
    const bf16_t* zs = Z + (size_t)(MP + bs) * NIE + hd * 64;
    const int piece = lane & 15, sub = lane >> 4;
    __syncthreads();
    f32x4 qv;
    { const bf16_t* qp = zs + 1024 + piece * 4; qv.x = bf2f(qp[0]); qv.y = bf2f(qp[1]); qv.z = bf2f(qp[2]); qv.w = bf2f(qp[3]); }
#pragma unroll
    for (int e0 = wave * 4; e0 < 388; e0 += 32) {
        const int e = e0 + sub, ec = e < 387 ? e : 386;
        const int pat = ec / 129, j = ec - pat * 129, d = pat == 0 ? 1 : (pat == 1 ? 4 : 16);
        f32x4 kk;
        if (j > 0) kk = *(const f32x4*)(ck + (size_t)(2048 - j * d) * 512 + piece * 4);
        else { const bf16_t* kp = zs + 1536 + piece * 4; kk.x = bf2f(kp[0]); kk.y = bf2f(kp[1]); kk.z = bf2f(kp[2]); kk.w = bf2f(kp[3]); }
        float dot = kk.x * qv.x + kk.y * qv.y + kk.z * qv.z + kk.w * qv.w;
        dot += __shfl_xor(dot, 1); dot += __shfl_xor(dot, 2); dot += __shfl_xor(dot, 4); dot += __shfl_xor(dot, 8);
        if (piece == 0 && e < 387) sc[e] = dot * 0.125f;
    }
    __syncthreads();
    float mx = -1e30f;
    for (int i = lane; i < 387; i += 64) mx = fmaxf(mx, sc[i]);
    mx = wave_max(mx);
    float sum = 0.f;
    for (int i = lane; i < 387; i += 64) sum += __expf(sc[i] - mx);
    sum = wave_sum(sum);
    float acc = 0.f;
    {
        float vv[49];
#pragma unroll
        for (int k = 0; k < 49; ++k) {
            const int i = wave + 8 * k, ic = i < 387 ? i : 386;
            const int pat = ic / 129, j = ic - pat * 129, d = pat == 0 ? 1 : (pat == 1 ? 4 : 16);
            vv[k] = j > 0 ? cv[(size_t)(2048 - j * d) * 512 + lane] : bf2f(zs[2048 + lane]);
        }
#pragma unroll
        for (int k = 0; k < 49; ++k) { const int i = wave + 8 * k; if (i < 387) acc += __expf(sc[i] - mx) * vv[k]; }
    }
    red[wave * 64 + lane] = acc;
    __syncthreads();
    if (tid < 64) { float t = 0.f;
#pragma unroll
        for (int ww = 0; ww < 8; ++ww) t += red[ww * 64 + tid];
        AO[(size_t)(MP + bs) * DM + 512 + hd * 64 + tid] = f2bf(t / sum); }
    __syncthreads();
}

constexpr int P3_ATT = 1536, P3_SGU = 512, P3_SATT = 256;
DI void phase3(const Params& p, ldsp lds) {
    const bf16_t* Z = (const bf16_t*)(p.ws + O_Z); bf16_t* AO = (bf16_t*)(p.ws + O_AO);
    bf16_t* OP = (bf16_t*)(p.ws + O_OP); float* LSE = (float*)(p.ws + O_LSE);
    const int x = (int)blockIdx.x & 7, li = (int)blockIdx.x >> 3;
    for (int j = 0; j < 2; ++j) { const int P = (j * 8 + x) * 8 + (li >> 2); sgu_item(p, Z, AO, P * 4 + (li & 3), lds);
#if P3_TWICE == 1
        sgu_item(p, Z, AO, P * 4 + (li & 3), lds);
#endif
    }
    for (int j = 0; j < 6; ++j) { const int G = (j * 8 + x) * 2 + (li >> 4); attn_item(Z, OP, LSE, G * 16 + (li & 15), lds);
#if P3_TWICE == 2
        attn_item(Z, OP, LSE, G * 16 + (li & 15), lds);
#endif
    }
    attn_sample_item(p, Z, AO, (int)blockIdx.x, lds);
    if (blockIdx.x >= 252) sgu_sample_item(p, Z, AO, ((int)blockIdx.x - 252) * 8 + ((int)threadIdx.x >> 6));
}

DI void phase4(const Params& p) {
    const bf16_t* OP = (const bf16_t*)(p.ws + O_OP); const float* LSE = (const float*)(p.ws + O_LSE); bf16_t* AO = (bf16_t*)(p.ws + O_AO);
    const size_t nthr = (size_t)gridDim.x * 512;
#pragma unroll 8
    for (size_t idx = (size_t)blockIdx.x * 512 + threadIdx.x; idx < (size_t)MP * 64; idx += nthr) {
        const size_t token = idx >> 6; const int c8 = (int)(idx & 63), head = c8 >> 3;
        const float l0 = LSE[token * 8 + head], l1 = LSE[((size_t)MP + token) * 8 + head], l2 = LSE[((size_t)2 * MP + token) * 8 + head];
        const float mx = fmaxf(l0, fmaxf(l1, l2));
        float w0 = __expf(l0 - mx), w1 = __expf(l1 - mx), w2 = __expf(l2 - mx);
        const float inv = 1.f / (w0 + w1 + w2); w0 *= inv; w1 *= inv; w2 *= inv;
        const bf16x8 a = *(const bf16x8*)(OP + token * 512 + c8 * 8), b = *(const bf16x8*)(OP + ((size_t)MP + token) * 512 + c8 * 8), c = *(const bf16x8*)(OP + ((size_t)2 * MP + token) * 512 + c8 * 8);
        float o[8];
#pragma unroll
        for (int j = 0; j < 8; ++j) o[j] = w0 * bfs2f(a[j]) + w1 * bfs2f(b[j]) + w2 * bfs2f(c[j]);
        u32x4 ov; ov.x = pk2(o[0], o[1]); ov.y = pk2(o[2], o[3]); ov.z = pk2(o[4], o[5]); ov.w = pk2(o[6], o[7]);
        *(u32x4*)(AO + token * DM + 512 + c8 * 8) = ov;
    }
}

DI void convgate_phase(const Params& p, int l) {
    const bf16_t* UP = (const bf16_t*)(p.ws + O_UP); bf16_t* ACT = (bf16_t*)(p.ws + O_ACT);
    const bf16_t* UPB = (const bf16_t*)(p.ws + O_UP);
    const float* cw = p.in[I_FCW] + (size_t)l * 3 * F2; const float* cb = p.in[I_FCB] + (size_t)l * F2;
    const size_t nthr = (size_t)gridDim.x * 512, gtid = (size_t)blockIdx.x * 512 + threadIdx.x;
    constexpr int NCH = DFF / 8;
    for (size_t u = gtid; u < (size_t)256 * 2 * NCH; u += nthr) {
        const int gi = (int)(u / NCH), ch = (int)(u - (size_t)gi * NCH), c0 = ch * 8, G = gi >> 1, which = gi & 1, row = 64 * G + which;
        const bool first = (row & 4095) < 2 && which == 0 ? true : false;
        const bool seq0 = ((64 * G) & 4095) == 0;
        const bf16_t* prev = UPB + (size_t)((G > 0 ? G - 1 : 0) * 4) * F2; const bf16_t* cur = UPB + (size_t)(G * 4) * F2;
        const bf16_t* r2 = which == 0 ? prev + 0 * F2 : prev + 1 * F2;
        const bf16_t* r1 = which == 0 ? prev + 1 * F2 : cur + 2 * F2;
        const bf16_t* r0 = which == 0 ? cur + 2 * F2 : cur + 3 * F2;
        const bool z2 = seq0, z1 = seq0 && which == 0;
        (void)first;
        const bf16x8 a2 = *(const bf16x8*)(r2 + c0), a1 = *(const bf16x8*)(r1 + c0), a0 = *(const bf16x8*)(r0 + c0);
        const bf16x8 b2 = *(const bf16x8*)(r2 + DFF + c0), b1 = *(const bf16x8*)(r1 + DFF + c0), b0 = *(const bf16x8*)(r0 + DFF + c0);
        float o[8];
#pragma unroll
        for (int j = 0; j < 8; ++j) {
            const float x2a = z2 ? 0.f : bfs2f(a2[j]), x1a = z1 ? 0.f : bfs2f(a1[j]), x2b = z2 ? 0.f : bfs2f(b2[j]), x1b = z1 ? 0.f : bfs2f(b1[j]);
            const float av = cb[c0 + j] + cw[c0 + j] * x2a + cw[F2 + c0 + j] * x1a + cw[2 * F2 + c0 + j] * bfs2f(a0[j]);
            const float bv = cb[DFF + c0 + j] + cw[DFF + c0 + j] * x2b + cw[F2 + DFF + c0 + j] * x1b + cw[2 * F2 + DFF + c0 + j] * bfs2f(b0[j]);
            o[j] = av / (1.f + __expf(-av)) * bv;
        }
        u32x4 ov; ov.x = pk2(o[0], o[1]); ov.y = pk2(o[2], o[3]); ov.z = pk2(o[4], o[5]); ov.w = pk2(o[6], o[7]);
        *(u32x4*)(ACT + (size_t)row * DFF + c0) = ov;
    }
    const float* st = p.in[I_SFC] + (size_t)l * 32 * 2 * F2; float* sto = p.out + OUT_FC_S + (size_t)l * 32 * 2 * F2;
    for (size_t u = gtid; u < (size_t)MS * DFF; u += nthr) {
        const int bs = (int)(u / DFF), c = (int)(u - (size_t)bs * DFF);
        const float* s0 = st + (size_t)(bs * 2) * F2; const float* s1 = s0 + F2;
        const bf16_t* ur = UP + (size_t)(MP + bs) * F2;
        const float av = cb[c] + cw[c] * s0[c] + cw[F2 + c] * s1[c] + cw[2 * F2 + c] * bf2f(ur[c]);
        const float bv = cb[DFF + c] + cw[DFF + c] * s0[DFF + c] + cw[F2 + DFF + c] * s1[DFF + c] + cw[2 * F2 + DFF + c] * bf2f(ur[DFF + c]);
        ACT[(size_t)(MP + bs) * DFF + c] = f2bf(av / (1.f + __expf(-av)) * bv);
        sto[(size_t)(bs * 2) * F2 + c] = s1[c]; sto[(size_t)(bs * 2) * F2 + DFF + c] = s1[DFF + c];
        sto[(size_t)(bs * 2 + 1) * F2 + c] = bf2f(ur[c]); sto[(size_t)(bs * 2 + 1) * F2 + DFF + c] = bf2f(ur[DFF + c]);
    }
    float* stp = p.out + OUT_FC_P + (size_t)l * 4 * 2 * F2;
    for (size_t u = gtid; u < (size_t)4 * 2 * F2; u += nthr) {
        const int bi = (int)(u / F2), c = (int)(u - (size_t)bi * F2), b = bi >> 1, i = bi & 1;
        stp[u] = bf2f(UPB[(size_t)((((b + 1) * SEQ - 1) >> 6) * 4 + i) * F2 + c]);
    }
}

DI void rglru_gate_item(const Params& p, int item, ldsp lds) {
    const int mt = item >> 3, g = item & 7, tid = threadIdx.x;
    const bf16_t* ZO = (const bf16_t*)(p.ws + O_ZO);
    {
        const int chunk = tid & 15, rg = tid >> 4, c0 = g * 128 + chunk * 8;
        float cw[4][8], cb[8];
#pragma unroll
        for (int k = 0; k < 4; ++k) { const f32x4 t0 = *(const f32x4*)(p.in[I_RCW] + k * 1024 + c0), t1 = *(const f32x4*)(p.in[I_RCW] + k * 1024 + c0 + 4);
            cw[k][0] = t0.x; cw[k][1] = t0.y; cw[k][2] = t0.z; cw[k][3] = t0.w; cw[k][4] = t1.x; cw[k][5] = t1.y; cw[k][6] = t1.z; cw[k][7] = t1.w; }
        { const f32x4 t0 = *(const f32x4*)(p.in[I_RCB] + c0), t1 = *(const f32x4*)(p.in[I_RCB] + c0 + 4);
          cb[0] = t0.x; cb[1] = t0.y; cb[2] = t0.z; cb[3] = t0.w; cb[4] = t1.x; cb[5] = t1.y; cb[6] = t1.z; cb[7] = t1.w; }
        if (mt < 64) {
            const int row0 = mt * 256 + rg * 8, t0 = row0 & 4095;
            float p3[8], p2[8], p1[8];
            if (t0 == 0) {
#pragma unroll
                for (int j = 0; j < 8; ++j) p3[j] = p2[j] = p1[j] = 0.f;
            } else {
                const bf16x8 v3 = *(const bf16x8*)(ZO + (size_t)(row0 - 3) * 2048 + 1024 + c0), v2 = *(const bf16x8*)(ZO + (size_t)(row0 - 2) * 2048 + 1024 + c0), v1 = *(const bf16x8*)(ZO + (size_t)(row0 - 1) * 2048 + 1024 + c0);
#pragma unroll
                for (int j = 0; j < 8; ++j) { p3[j] = bfs2f(v3[j]); p2[j] = bfs2f(v2[j]); p1[j] = bfs2f(v1[j]); }
            }
#pragma unroll
            for (int i = 0; i < 8; ++i) {
                const bf16x8 vc = *(const bf16x8*)(ZO + (size_t)(row0 + i) * 2048 + 1024 + c0);
                float o[8];
#pragma unroll
                for (int j = 0; j < 8; ++j) { const float cur = bfs2f(vc[j]); o[j] = cb[j] + cw[0][j] * p3[j] + cw[1][j] * p2[j] + cw[2][j] * p1[j] + cw[3][j] * cur; p3[j] = p2[j]; p2[j] = p1[j]; p1[j] = cur; }
                u32x4 ov; ov.x = pk2(o[0], o[1]); ov.y = pk2(o[2], o[3]); ov.z = pk2(o[4], o[5]); ov.w = pk2(o[6], o[7]);
                *(LAS u32x4*)(lds + (rg * 8 + i) * 272 + chunk * 16) = ov;
            }
        } else {
#pragma unroll
            for (int i = 0; i < 8; ++i) {
                const int rt = rg * 8 + i;
                u32x4 ov; ov.x = ov.y = ov.z = ov.w = 0u;
                if (rt < MS) {
                    const float* st = p.in[I_SRC] + (size_t)rt * 3 * 1024 + c0;
                    const bf16x8 vc = *(const bf16x8*)(ZO + (size_t)(MP + rt) * 2048 + 1024 + c0);
                    float o[8];
#pragma unroll
                    for (int j = 0; j < 8; ++j) o[j] = cb[j] + cw[0][j] * st[j] + cw[1][j] * st[1024 + j] + cw[2][j] * st[2048 + j] + cw[3][j] * bfs2f(vc[j]);
                    ov.x = pk2(o[0], o[1]); ov.y = pk2(o[2], o[3]); ov.z = pk2(o[4], o[5]); ov.w = pk2(o[6], o[7]);
                    float* so = p.out + OUT_RC_S + (size_t)rt * 3 * 1024 + c0;
#pragma unroll
                    for (int j = 0; j < 8; ++j) { so[j] = st[1024 + j]; so[1024 + j] = st[2048 + j]; so[2048 + j] = bfs2f(vc[j]); }
                }
                *(LAS u32x4*)(lds + rt * 272 + chunk * 16) = ov;
            }
        }
    }
    __syncthreads();
    const int w = tid >> 6, lane = tid & 63, ql = lane & 31, hf = lane >> 5;
    bf16x8 af[8];
#pragma unroll
    for (int ks = 0; ks < 8; ++ks) af[ks] = *(LAS bf16x8*)(lds + (32 * w + ql) * 272 + (16 * ks + 8 * hf) * 2);
    const bf16_t* WG = (const bf16_t*)(p.ws + O_WT_GA) + (size_t)(g * 256 + ql) * 128 + 8 * hf;
    unsigned* HP = (unsigned*)(p.ws + O_AA); float* AGP = (float*)(p.ws + O_BB); float* AGH = AGP + 512 * 1024; bf16_t* Y = (bf16_t*)(p.ws + O_AO);
    for (int n = 0; n < 4; ++n) {
        f32x16 ar, ai;
#pragma unroll
        for (int i = 0; i < 16; ++i) { ar[i] = 0.f; ai[i] = 0.f; }
#pragma unroll
        for (int ks = 0; ks < 8; ++ks) {
            const bf16x8 br = *(const bf16x8*)(WG + (size_t)(32 * n) * 128 + 16 * ks), bi = *(const bf16x8*)(WG + (size_t)(32 * (n + 4)) * 128 + 16 * ks);
            ar = MFMA32(af[ks], br, ar); ai = MFMA32(af[ks], bi, ai);
        }
        const int o = 32 * n + ql, col = g * 128 + o;
        const float ba = p.in[I_RBA][col], bx = p.in[I_RBX][col], lam = p.in[I_RLAM][col];
        const float sp8 = 8.f * 1.4426950408889634f * log1pf(__expf(-lam));
        float av[16], bv[16];
#pragma unroll
        for (int i = 0; i < 16; ++i) {
            const int rt = 32 * w + crow(i, hf);
            const float r = fsigmoid(ar[i] + ba), ig = fsigmoid(ai[i] + bx);
            const float la2 = -(r * sp8), a = fexp2(la2);
            const float em = fmaxf(1.f - a * a, 0.f);
            const float xcv = bf2f(*(LAS bf16_t*)(lds + rt * 272 + o * 2));
            av[i] = a; bv[i] = __builtin_amdgcn_sqrtf(em) * (ig * xcv);
        }
        if (mt < 64) {
            float gP[4], gH[4];
#pragma unroll
            for (int q = 0; q < 4; ++q) { float h = 0.f, P = 1.f;
#pragma unroll
                for (int j = 0; j < 4; ++j) { const int i = 4 * q + j; h = av[i] * h + bv[i]; P *= av[i]; bv[i] = h; av[i] = P; }
                gP[q] = P; gH[q] = h; }
            float Hc = 0.f, Pc = 1.f;
#pragma unroll
            for (int q = 0; q < 4; ++q) {
                const float oP = __shfl_xor(gP[q], 32), oH = __shfl_xor(gH[q], 32);
                const float P0 = hf ? oP : gP[q], H0 = hf ? oH : gH[q], P1 = hf ? gP[q] : oP, H1 = hf ? gH[q] : oH;
                const float mid = P0 * Hc + H0;
                const float inH = hf ? mid : Hc, inP = hf ? P0 * Pc : Pc;
#pragma unroll
                for (int j = 0; j < 4; ++j) { const int i = 4 * q + j; bv[i] += av[i] * inH; av[i] *= inP; }
                Hc = P1 * mid + H1; Pc = P1 * P0 * Pc;
            }
#pragma unroll
            for (int i = 0; i < 16; ++i) HP[(size_t)(mt * 256 + 32 * w + crow(i, hf)) * DM + col] = pk2(bv[i], av[i]);
            if (hf == 0) { LAS float* ag = (LAS float*)(lds + 256 * 272) + (w * 128 + o) * 2; ag[0] = Pc; ag[1] = Hc; }
        } else {
#pragma unroll
            for (int i = 0; i < 16; ++i) {
                const int rt = 32 * w + crow(i, hf);
                if (rt < MS) {
                    const float h = av[i] * p.in[I_SRH][(size_t)rt * 1024 + col] + bv[i];
                    p.out[OUT_RH_S + (size_t)rt * 1024 + col] = h;
                    Y[(size_t)(MP + rt) * DM + col] = f2bf(bf2f(ZO[(size_t)(MP + rt) * 2048 + col]) * h);
                }
            }
        }
    }
    __syncthreads();
    if (mt < 64 && tid < 128) {
        const LAS float* ag = (const LAS float*)(lds + 256 * 272);
        float cP = 1.f, cH = 0.f; const int col = g * 128 + tid;
#pragma unroll
        for (int ww = 0; ww < 8; ++ww) {
            AGP[(size_t)(mt * 8 + ww) * 1024 + col] = cP; AGH[(size_t)(mt * 8 + ww) * 1024 + col] = cH;
            const float P = ag[(ww * 128 + tid) * 2], Hh = ag[(ww * 128 + tid) * 2 + 1];
            cH = P * cH + Hh; cP *= P;
        }
        float* TP = AGP + 2 * 512 * 1024; TP[(size_t)mt * 1024 + col] = cP; TP[(size_t)(64 + mt) * 1024 + col] = cH;
    }
    __syncthreads();
}

DI void rglru_sample_item(const Params& p, int g, ldsp lds) {
    const int tid = threadIdx.x;
    const bf16_t* ZO = (const bf16_t*)(p.ws + O_ZO);
    if (tid < 512) {
        const int chunk = tid & 15, rt = tid >> 4, c0 = g * 128 + chunk * 8;
        const float* st = p.in[I_SRC] + (size_t)rt * 3 * 1024 + c0;
        const bf16x8 vc = *(const bf16x8*)(ZO + (size_t)(MP + rt) * 2048 + 1024 + c0);
        float o[8];
#pragma unroll
        for (int j = 0; j < 8; ++j) o[j] = p.in[I_RCB][c0 + j] + p.in[I_RCW][c0 + j] * st[j] + p.in[I_RCW][1024 + c0 + j] * st[1024 + j] + p.in[I_RCW][2048 + c0 + j] * st[2048 + j] + p.in[I_RCW][3072 + c0 + j] * bfs2f(vc[j]);
        u32x4 ov; ov.x = pk2(o[0], o[1]); ov.y = pk2(o[2], o[3]); ov.z = pk2(o[4], o[5]); ov.w = pk2(o[6], o[7]);
        *(LAS u32x4*)(lds + rt * 272 + chunk * 16) = ov;
        float* so = p.out + OUT_RC_S + (size_t)rt * 3 * 1024 + c0;
#pragma unroll
        for (int j = 0; j < 8; ++j) { so[j] = st[1024 + j]; so[1024 + j] = st[2048 + j]; so[2048 + j] = bfs2f(vc[j]); }
    }
    __syncthreads();
    const int n = tid >> 6, lane = tid & 63, ql = lane & 31, hf = lane >> 5;
    if (n < 4) {
        const bf16_t* WG = (const bf16_t*)(p.ws + O_WT_GA) + (size_t)(g * 256 + ql) * 128 + 8 * hf;
        f32x16 ar, ai;
#pragma unroll
        for (int i = 0; i < 16; ++i) { ar[i] = 0.f; ai[i] = 0.f; }
#pragma unroll
        for (int ks = 0; ks < 8; ++ks) {
            const bf16x8 af = *(LAS bf16x8*)(lds + ql * 272 + (16 * ks + 8 * hf) * 2);
            const bf16x8 br = *(const bf16x8*)(WG + (size_t)(32 * n) * 128 + 16 * ks), bi = *(const bf16x8*)(WG + (size_t)(32 * (n + 4)) * 128 + 16 * ks);
            ar = MFMA32(af, br, ar); ai = MFMA32(af, bi, ai);
        }
        const int o = 32 * n + ql, col = g * 128 + o;
        const float ba = p.in[I_RBA][col], bx = p.in[I_RBX][col], lam = p.in[I_RLAM][col];
        const float sp8 = 8.f * 1.4426950408889634f * log1pf(__expf(-lam));
        bf16_t* Y = (bf16_t*)(p.ws + O_AO);
#pragma unroll
        for (int i = 0; i < 16; ++i) {
            const int rt = crow(i, hf);
            const float r = fsigmoid(ar[i] + ba), ig = fsigmoid(ai[i] + bx);
            const float la2 = -(r * sp8), a = fexp2(la2), y = la2 * (2.f * 0.6931471805599453f);
            const float em = y > -0.1f ? -y * (1.f + y * (0.5f + y * (0.16666667f + y * (0.041666668f + y * 0.0083333333f)))) : 1.f - a * a;
            const float xcv = bf2f(*(LAS bf16_t*)(lds + rt * 272 + o * 2));
            const float bv = __builtin_amdgcn_sqrtf(em) * (ig * xcv);
            const float h = a * p.in[I_SRH][(size_t)rt * 1024 + col] + bv;
            p.out[OUT_RH_S + (size_t)rt * 1024 + col] = h;
            Y[(size_t)(MP + rt) * DM + col] = f2bf(bf2f(ZO[(size_t)(MP + rt) * 2048 + col]) * h);
        }
    }
    __syncthreads();
}

DI void scan_apply(const Params& p, ldsp lds) {
    if (blockIdx.x < 8) rglru_sample_item(p, (int)blockIdx.x, lds);
    const unsigned* HP = (const unsigned*)(p.ws + O_AA); const float* AGP = (const float*)(p.ws + O_BB); const float* AGH = AGP + 512 * 1024;
    const bf16_t* ZO = (const bf16_t*)(p.ws + O_ZO); bf16_t* Y = (bf16_t*)(p.ws + O_AO);
    for (size_t u = (size_t)blockIdx.x * 512 + threadIdx.x; u < (size_t)4 * 3 * 1024; u += (size_t)gridDim.x * 512) {
        const int bi = (int)(u >> 10), c = (int)(u & 1023), b = bi / 3, i = bi - 3 * b;
        p.out[OUT_RC_P + u] = bf2f(ZO[(size_t)(b * SEQ + 4093 + i) * 2048 + 1024 + c]);
    }
    const float* TP = AGP + 2 * 512 * 1024; const float* TH = TP + 64 * 1024;
    for (int chunk = blockIdx.x; chunk < 512; chunk += gridDim.x) {
        const int b = chunk >> 7, mt = chunk >> 3, c4 = (threadIdx.x & 255) * 4, rh = threadIdx.x >> 8;
        f32x4 T = {0.f, 0.f, 0.f, 0.f};
        {
            f32x4 tp[15], th[15];
#pragma unroll
            for (int k = 0; k < 15; ++k) { const int j = b * 16 + k, jc = j < mt ? j : b * 16; tp[k] = *(const f32x4*)(TP + (size_t)jc * 1024 + c4); th[k] = *(const f32x4*)(TH + (size_t)jc * 1024 + c4); }
#pragma unroll
            for (int k = 0; k < 15; ++k) if (b * 16 + k < mt) T = tp[k] * T + th[k];
        }
        const f32x4 h0 = *(const f32x4*)(AGH + (size_t)chunk * 1024 + c4) + *(const f32x4*)(AGP + (size_t)chunk * 1024 + c4) * T;
        const size_t row0 = (size_t)chunk * 32 + rh * 16;
        u32x4 wv[16]; u32x2 gt[16];
#pragma unroll
        for (int t = 0; t < 16; ++t) { wv[t] = *(const u32x4*)(HP + (row0 + t) * DM + c4); gt[t] = *(const u32x2*)(ZO + (row0 + t) * 2048 + c4); }
#pragma unroll
        for (int t = 0; t < 16; ++t) {
            const float y0 = __uint_as_float(gt[t].x << 16) * (__uint_as_float(wv[t].x << 16) + __uint_as_float(wv[t].x & 0xffff0000u) * h0.x);
            const float y1 = __uint_as_float(gt[t].x & 0xffff0000u) * (__uint_as_float(wv[t].y << 16) + __uint_as_float(wv[t].y & 0xffff0000u) * h0.y);
            const float y2 = __uint_as_float(gt[t].y << 16) * (__uint_as_float(wv[t].z << 16) + __uint_as_float(wv[t].z & 0xffff0000u) * h0.z);
            const float y3 = __uint_as_float(gt[t].y & 0xffff0000u) * (__uint_as_float(wv[t].w << 16) + __uint_as_float(wv[t].w & 0xffff0000u) * h0.w);
            u32x2 o; o.x = pk2(y0, y1); o.y = pk2(y2, y3);
            *(u32x2*)(Y + (row0 + t) * DM + c4) = o;
        }
        if ((chunk & 127) == 127 && rh == 0) *(f32x4*)(p.out + OUT_RH_P + (size_t)b * 1024 + c4) = *(const f32x4*)(TP + (size_t)mt * 1024 + c4) * T + *(const f32x4*)(TH + (size_t)mt * 1024 + c4);
    }
}

DI void run_phase(const Params& p, int ph, ldsp lds, int rep = 0) {
    unsigned char* ws = p.ws;
    float* MOD = (float*)(ws + O_MOD); bf16_t* X = (bf16_t*)(ws + O_X); bf16_t* H = (bf16_t*)(ws + O_H); bf16_t* AO = (bf16_t*)(ws + O_AO);
    float* SLOT = (float*)(ws + O_SLOT); unsigned* CNT = (unsigned*)(ws + O_BAR) + CNT_WORD;
    const float* MOD1 = MOD + 36 * 6144; const bf16_t* Xs = X + (size_t)MP * DM;
    if (gridDim.x != 256) return;
    switch (ph) {
    case 0: phase0(p, lds, rep); break;
    case 1: norm_phase(p.in[I_XP], p.in[I_XS], MOD, 0, 1024, H); break;
    case 2: { QInE q{(bf16_t*)(ws + O_Z), p.out + OUT_WK_P, p.out + OUT_WV_P, p.out + OUT_WK_S, p.out + OUT_WV_S};
              gemm_all_p(lds, H, (const bf16_t*)(ws + O_WT_IN_E), NIE, 1024, q); copy_share(p, 0, 600); } break;
    case 3: phase3(p, lds); break;
    case 4: phase4(p); break;
    case 5: { EpiResFused e{p.in[I_XP], p.in[I_XS], X, MOD + 2048, 0, MOD + 4096, MOD + 3072, H, nullptr, nullptr, SLOT, CNT};
              gemm_res_fused(lds, AO, (const bf16_t*)(ws + O_WT_OUT_E), 1024, e); } break;
    case 7: { EpiUpGate e{(bf16_t*)(ws + O_ACT), (bf16_t*)(ws + O_UP), p.in[I_FCW], p.in[I_FCB]}; QUpS qs{(bf16_t*)(ws + O_UP)};
              gemm_upgate(lds, H, (const bf16_t*)(ws + O_WT_UP), e, qs, Xs, MOD, 3072, 4096); copy_share(p, 600, 1324); } break;
    case 8: convgate_phase(p, 0); break;
    case 9: { EpiResFused e{nullptr, nullptr, X, MOD + 5120, 0, MOD1 + 1024, MOD1 + 0, H, nullptr, nullptr, SLOT + (size_t)4 * MP, CNT + 64};
              gemm_res_fused(lds, (const bf16_t*)(ws + O_ACT), (const bf16_t*)(ws + O_WT_DN), DFF, e); } break;
    case 11: { QInO q{(bf16_t*)(ws + O_ZO)}; gemm_all_p_sn(lds, H, (const bf16_t*)(ws + O_WT_IN_O), 2048, q, Xs, MOD1, 0, 1024); } break;
    case 12: for (int it = blockIdx.x; it < 64 * 8; it += gridDim.x) rglru_gate_item(p, it, lds); break;
    case 13: scan_apply(p, lds); break;
    case 15: { EpiResFused e{nullptr, nullptr, X, MOD1 + 2048, 0, MOD1 + 4096, MOD1 + 3072, H, nullptr, nullptr, SLOT + (size_t)8 * MP, CNT + 128};
               gemm_res_fused(lds, AO, (const bf16_t*)(ws + O_WT_OUT_O), 1024, e); } break;
    case 17: { EpiUpGate e{(bf16_t*)(ws + O_ACT), (bf16_t*)(ws + O_UP), p.in[I_FCW] + (size_t)3 * F2, p.in[I_FCB] + F2}; QUpS qs{(bf16_t*)(ws + O_UP)};
               gemm_upgate(lds, H, (const bf16_t*)(ws + O_WT_UP + SZ_WT_UP), e, qs, Xs, MOD1, 3072, 4096); copy_share(p, 1324, COPY_ITEMS); } break;
    case 18: convgate_phase(p, 1); break;
    case 19: { EpiResFused e{nullptr, nullptr, X, MOD1 + 5120, 1, nullptr, nullptr, nullptr, p.in[I_FING], p.out + OUT_Y_P, SLOT + (size_t)12 * MP, CNT + 192};
               gemm_res_fused(lds, (const bf16_t*)(ws + O_ACT), (const bf16_t*)(ws + O_WT_DN + SZ_WT_DN), DFF, e); } break;
    case 20: final_norm_samples(X, p.in[I_FING], p.out + OUT_Y_S); break;
    default: break;
    }
}

__global__ void __launch_bounds__(512, 2) fwd_mega(Params p, int ph_lo, int ph_hi) {
    extern __shared__ __attribute__((aligned(16))) unsigned char shm[];
    ldsp lds = (ldsp)shm;
    cg::grid_group grid = cg::this_grid();
    const bool fused = (ph_hi - ph_lo) > 1;
    volatile LAS unsigned* st = (volatile LAS unsigned*)(lds + 131072);
    if (threadIdx.x == 0) { st[0] = 0u; st[1] = 0u; st[2] = 0u; st[3] = 0u; }
    __syncthreads();
    XcdBarrier xb; xb.bar = (unsigned*)(p.ws + O_BAR); xb.x = 0; xb.st = st;
    if (fused) xb = xcd_barrier_post((unsigned*)(p.ws + O_BAR), st);
    if (ph_hi > 1000) grid.sync();
#define SEAM() xcd_barrier(xb)
#define PHASE(k) if (ph_lo <= (k) && (k) < ph_hi) { run_phase(p, (k), lds); if ((DOUBLE_MASK >> (k)) & 1) { SEAM(); run_phase(p, (k), lds, 1); } if ((k) + 1 < ph_hi) SEAM(); }
    PHASE(0) PHASE(1) PHASE(2) PHASE(3) PHASE(4) PHASE(5) PHASE(7) PHASE(8) PHASE(9)
    PHASE(11) PHASE(12) PHASE(13) PHASE(15) PHASE(17) PHASE(18) PHASE(19) PHASE(20)
#undef SEAM
#undef PHASE
}

extern "C" void kernel_launch(void* const* d_in, const int* in_sizes, int n_in, void* d_out, int out_size, void* d_ws, size_t ws_size, hipStream_t stream) {
    static int grid = 0;
    if (grid == 0) {
        if (n_in != N_IN || (size_t)out_size != OUT_TOTAL || ws_size < WS_NEED) { fprintf(stderr, "kernel_launch: unexpected shapes: n_in %d out %d ws %zu (need %zu)\n", n_in, out_size, ws_size, (size_t)WS_NEED); grid = -1; return; }
        int dev = 0, cus = 0, per_cu = 0;
        hipGetDevice(&dev); hipDeviceGetAttribute(&cus, hipDeviceAttributeMultiprocessorCount, dev);
        if (hipFuncSetAttribute((const void*)fwd_mega, hipFuncAttributeMaxDynamicSharedMemorySize, LDS_BYTES) != hipSuccess) { fprintf(stderr, "kernel_launch: hipFuncSetAttribute failed\n"); grid = -1; return; }
        if (hipOccupancyMaxActiveBlocksPerMultiprocessor(&per_cu, (const void*)fwd_mega, 512, LDS_BYTES) != hipSuccess || per_cu < 1) { fprintf(stderr, "kernel_launch: occupancy query says %d\n", per_cu); per_cu = 1; }
        (void)hipGetLastError();
        grid = cus;
        if (grid > 256) grid = 256;
    }
    if (grid < 0) return;
    Params p{};
    for (int i = 0; i < N_IN; ++i) p.in[i] = (const float*)d_in[i];
    p.out = (float*)d_out; p.ws = (unsigned char*)d_ws;
    if (hipMemsetAsync((unsigned char*)d_ws + O_BAR, 0, BAR_BYTES, stream) != hipSuccess) { fprintf(stderr, "kernel_launch: memset of barrier words failed\n"); return; }
#if MULTI_LAUNCH
    for (int ph = 0; ph < NPH; ++ph) { int lo = ph, hi = ph + 1; hipLaunchKernelGGL(fwd_mega, dim3(grid), dim3(512), LDS_BYTES, stream, p, lo, hi); }
#else
    int lo = 0, hi = NPH;
    void* args[] = {&p, &lo, &hi};
    hipError_t e = hipLaunchCooperativeKernel((const void*)fwd_mega, dim3(grid), dim3(512), args, LDS_BYTES, stream);
    if (e != hipSuccess) fprintf(stderr, "kernel_launch: cooperative launch failed: %s (grid %d)\n", hipGetErrorString(e), grid);
#endif
}
```

```cpp
#include <hip/hip_runtime.h>
#include <hip/hip_cooperative_groups.h>
#include <cstdio>
#include <cstdint>
namespace cg = cooperative_groups;
namespace pg8 {
#define PG8_LAS __attribute__((address_space(3)))
typedef unsigned short bf16_t;
typedef short bf16x8 __attribute__((ext_vector_type(8)));
typedef float f32x4 __attribute__((ext_vector_type(4)));
typedef unsigned u32x4 __attribute__((ext_vector_type(4)));
constexpr int BM = 256, BK = 64, HALF = 128, HTB = HALF * BK * 2  , STAGE_BYTES = 8 * HTB, NXCD = 8, WGM = 8;

__host__ __device__ __forceinline__ int lds_byte(int r, int c) { const int st = (r >> 4) * 2 + (c >> 5), rr = r & 15, cc = c & 31, ob = rr * 64 + cc * 2; return st * 1024 + (ob ^ (((ob >> 9) & 1) << 5)); }
__host__ __device__ __forceinline__ void stage_rc(int b, int& R, int& C) { const int st = b / 1024, sb = b % 1024, swz = sb ^ (((sb >> 9) & 1) << 5); R = (st >> 1) * 16 + swz / 64; C = (st & 1) * 32 + (swz % 64) / 2; }
__host__ __device__ __forceinline__ int perm32(int rho) { const int n = rho >> 4, i = rho & 15; return 8 * (i >> 2) + 4 * n + (i & 3); }

struct Unit { int pm, pn; };
struct Gemm { const bf16_t* A; const bf16_t* Bt; int M, N, K; };

struct StaticOrder {
    int nM, nN, nwg, G, c;
    __host__ __device__ void init(int M, int N, int G_, int c_) { nM = M / BM; nN = N / BM; nwg = nM * nN; G = G_; c = c_; }
    __host__ __device__ bool next(int i, Unit& u) const {
        const long L = (long)i * G + c; if (L >= nwg) return false;
        int wgid = (int)L; { const int q = nwg / NXCD, r = nwg % NXCD, xcd = wgid % NXCD, off = wgid / NXCD; wgid = (xcd < r ? xcd * (q + 1) : r * (q + 1) + (xcd - r) * q) + off; }
        const int nig = WGM * nN, gid = wgid / nig, fm = gid * WGM, gsz = (nM - fm) < WGM ? (nM - fm) : WGM;
        u.pm = fm + ((wgid % nig) % gsz); u.pn = (wgid % nig) / gsz; return true;
    }
    __device__ __forceinline__ void a_ready(const Unit&) const {}
    __device__ __forceinline__ void done(const Unit&) const {}
};
__device__ __forceinline__ unsigned cvt_pk_bf16(float lo, float hi) { unsigned r; asm volatile("v_cvt_pk_bf16_f32 %0, %1, %2" : "=v"(r) : "v"(lo), "v"(hi)); return r; }
template <class Epi, class Sched, bool STAMP = false>
__device__ __forceinline__ void gemm_phase(PG8_LAS unsigned char* lds, const Gemm g, const Sched& S, const Epi& E, unsigned long long* stamps) {
    const int tid = threadIdx.x, wid = __builtin_amdgcn_readfirstlane(tid >> 6), lane = tid & 63, wr = wid >> 2, wc = wid & 3, fr = lane & 15, fq = lane >> 4;
    const int K = g.K, nt = K / BK;
    int ts_lo = 0, ts_hi = 0, nts = 0; const unsigned long long rt_entry = STAMP ? (unsigned long long)wall_clock64() : 0ull;
#define PG8_STAMP() do { if (STAMP && wid == 0 && nts < 64) { const unsigned long long _c = (unsigned long long)clock64(); \
        ts_lo = (lane == nts) ? (int)(unsigned)_c : ts_lo; ts_hi = (lane == nts) ? (int)(unsigned)(_c >> 32) : ts_hi; ++nts; } } while (0)
    PG8_STAMP();
    unsigned voffA[2], voffB[2];
#pragma unroll
    for (int i = 0; i < 2; ++i) { int R, C; stage_rc(tid * 16 + i * 8192, R, C); const int Rb = Epi::PERM ? ((R & ~31) + perm32(R & 31)) : R;
        voffA[i] = (unsigned)(R * K + C) * 2u; voffB[i] = (unsigned)(Rb * K + C) * 2u; }
    const size_t kstep = (size_t)(BK * 2);
    const size_t hstep = (size_t)HALF * K * 2;
    const size_t tstep = 2 * hstep;
    const unsigned ldsw = (unsigned)wid * 1024u;
    const int aoff = lds_byte(wr * 64 + fr, fq * 8), boff = lds_byte(wc * 32 + fr, fq * 8);
#define PG8_SA(b, h) (((b) * 2 + (h)) * HTB)
#define PG8_SB(b, h) ((4 + (b) * 2 + (h)) * HTB)
#define PG8_STAGE(bufoff, gbase, voff) do { _Pragma("unroll") for (int _i = 0; _i < 2; ++_i) \
        __builtin_amdgcn_global_load_lds((const unsigned*)((const char*)(gbase) + (voff)[_i]), (PG8_LAS unsigned*)(lds + (bufoff) + ldsw + _i * 8192), 16, 0, 0); } while (0)
#define PG8_LDA(dst, b, h) do { _Pragma("unroll") for (int m = 0; m < 4; ++m) _Pragma("unroll") for (int k = 0; k < 2; ++k) dst[m][k] = *(const PG8_LAS bf16x8*)(lds + PG8_SA(b, h) + aoff + m * 2048 + k * 1024); } while (0)
#define PG8_LDB(dst, b, h) do { _Pragma("unroll") for (int n = 0; n < 2; ++n) _Pragma("unroll") for (int k = 0; k < 2; ++k) dst[n][k] = *(const PG8_LAS bf16x8*)(lds + PG8_SB(b, h) + boff + n * 2048 + k * 1024); } while (0)
#define PG8_MMA(ai, bj, At, Bt) do { __builtin_amdgcn_s_setprio(1); _Pragma("unroll") for (int m = 0; m < 4; ++m) _Pragma("unroll") for (int n = 0; n < 2; ++n) _Pragma("unroll") for (int k = 0; k < 2; ++k) \
        acc[ai][bj][m][n] = __builtin_amdgcn_mfma_f32_16x16x32_bf16(Bt[n][k], At[m][k], acc[ai][bj][m][n], 0, 0, 0); __builtin_amdgcn_s_setprio(0); } while (0)
#define PG8_WAIT_V(n) asm volatile("s_waitcnt vmcnt(" #n ")" ::: "memory")
#define PG8_WAIT_L(n) asm volatile("s_waitcnt lgkmcnt(" #n ")" ::: "memory")
#define PG8_BAR __builtin_amdgcn_s_barrier()
#define PG8_SCHED __builtin_amdgcn_sched_barrier(0)
    Unit cur, nxt; int ui = 0;
    if (!S.next(0, cur)) return;
    f32x4 acc[2][2][4][2];
#pragma unroll
    for (int a = 0; a < 2; ++a)
#pragma unroll
        for (int b = 0; b < 2; ++b)
#pragma unroll
            for (int m = 0; m < 4; ++m)
#pragma unroll
                for (int n = 0; n < 2; ++n) acc[a][b][m][n] = (f32x4){0.f, 0.f, 0.f, 0.f};
    bf16x8 At[4][2], B0[2][2], B1[2][2];
    const char* cA = (const char*)g.A + (size_t)cur.pm * tstep; const char* cB = (const char*)g.Bt + (size_t)cur.pn * tstep;
    S.a_ready(cur);
    PG8_STAGE(PG8_SB(0, 0), cB, voffB); PG8_STAGE(PG8_SA(0, 0), cA, voffA); PG8_STAGE(PG8_SB(0, 1), cB + hstep, voffB); PG8_STAGE(PG8_SA(0, 1), cA + hstep, voffA);
    if (wr == 1) PG8_BAR;
    PG8_WAIT_V(4); PG8_BAR;
    PG8_STAGE(PG8_SB(1, 0), cB + kstep, voffB); PG8_STAGE(PG8_SA(1, 0), cA + kstep, voffA); PG8_STAGE(PG8_SB(1, 1), cB + hstep + kstep, voffB);
    PG8_WAIT_V(6); PG8_BAR;
    PG8_STAMP();
    for (;;) {
        const bool has_next = S.next(ui + 1, nxt);
        const char* nA = has_next ? (const char*)g.A + (size_t)nxt.pm * tstep : cA; const char* nB = has_next ? (const char*)g.Bt + (size_t)nxt.pn * tstep : cB;
        for (int t = 0; t < nt; t += 2) {
            const bool last = (t == nt - 2);
            const char* a1 = cA + (size_t)(t + 1) * kstep;
            const char* a2 = last ? nA : cA + (size_t)(t + 2) * kstep; const char* b2 = last ? nB : cB + (size_t)(t + 2) * kstep;
            const char* a3 = a2 + kstep; const char* b3 = b2 + kstep;
            if (last && has_next) S.a_ready(nxt);
            PG8_LDB(B0, 0, 0); PG8_SCHED; PG8_LDA(At, 0, 0); PG8_STAGE(PG8_SA(1, 1), a1 + hstep, voffA);
            PG8_WAIT_L(8); PG8_BAR; PG8_WAIT_L(0); PG8_MMA(0, 0, At, B0); PG8_BAR; PG8_SCHED;
            PG8_LDB(B1, 0, 1); PG8_STAGE(PG8_SB(0, 0), b2, voffB);
            PG8_BAR; PG8_WAIT_L(0); PG8_MMA(0, 1, At, B1); PG8_BAR;
            PG8_LDA(At, 0, 1); PG8_STAGE(PG8_SA(0, 0), a2, voffA);
            PG8_BAR; PG8_WAIT_L(0); PG8_MMA(1, 0, At, B0); PG8_BAR; PG8_SCHED;
            PG8_STAGE(PG8_SB(0, 1), b2 + hstep, voffB);
            PG8_WAIT_V(6); PG8_BAR; PG8_MMA(1, 1, At, B1); PG8_BAR;
            PG8_LDB(B0, 1, 0); PG8_SCHED; PG8_LDA(At, 1, 0); PG8_STAGE(PG8_SA(0, 1), a2 + hstep, voffA);
            PG8_WAIT_L(8); PG8_BAR; PG8_WAIT_L(0); PG8_MMA(0, 0, At, B0); PG8_BAR; PG8_SCHED;
            PG8_LDB(B1, 1, 1); PG8_STAGE(PG8_SB(1, 0), b3, voffB);
            PG8_BAR; PG8_WAIT_L(0); PG8_MMA(0, 1, At, B1); PG8_BAR;
            PG8_LDA(At, 1, 1); PG8_STAGE(PG8_SA(1, 0), a3, voffA);
            PG8_BAR; PG8_WAIT_L(0); PG8_MMA(1, 0, At, B0); PG8_BAR; PG8_SCHED;
            PG8_STAGE(PG8_SB(1, 1), b3 + hstep, voffB);
            PG8_WAIT_V(6); PG8_BAR; PG8_MMA(1, 1, At, B1); PG8_BAR;
        }
        PG8_STAMP();
        if constexpr (!Epi::AFTER_DRAIN) { E(acc, cur, wr, wc, fr, fq); S.done(cur); }
        PG8_STAMP();
        if (!has_next) break;
#pragma unroll
        for (int a = 0; a < 2; ++a)
#pragma unroll
            for (int b = 0; b < 2; ++b)
#pragma unroll
                for (int m = 0; m < 4; ++m)
#pragma unroll
                    for (int n = 0; n < 2; ++n) acc[a][b][m][n] = (f32x4){0.f, 0.f, 0.f, 0.f};
        cur = nxt; cA = nA; cB = nB; ++ui;
    }
    PG8_WAIT_V(0);
    if (wr == 0) PG8_BAR;
    PG8_BAR;
    if constexpr (Epi::AFTER_DRAIN) { E.fused(acc, cur, wr, wc, fr, fq, lds, wid, lane); S.done(cur); }
    PG8_STAMP();
    if (STAMP && wid == 0) { stamps[lane] = lane < nts ? (((unsigned long long)(unsigned)ts_hi << 32) | (unsigned)ts_lo) : 0ull;
        if (lane == 62) stamps[62] = rt_entry; if (lane == 63) stamps[63] = (unsigned long long)wall_clock64(); }
#undef PG8_STAMP
#undef PG8_SA
#undef PG8_SB
#undef PG8_STAGE
#undef PG8_LDA
#undef PG8_LDB
#undef PG8_MMA
#undef PG8_WAIT_V
#undef PG8_WAIT_L
#undef PG8_BAR
#undef PG8_SCHED
}
}
#define LAS __attribute__((address_space(3)))

#define XB_TMO      128
#define XB_XCNT(j)  (256  + 64 * (j))
#define XB_XSUB(j)  (1280 + 64 * (j))
#define XB_XGEN(j)  (2304 + 64 * (j))
#define XB_TOP      3328
#define XB_TOPGEN   3392
#define XCD_BAR_WORDS 3456
#define XB_SPIN_CAP (1u << 18)

__device__ __forceinline__ unsigned xb_ld(unsigned* p)              { return __hip_atomic_load(p, __ATOMIC_RELAXED, __HIP_MEMORY_SCOPE_AGENT); }
__device__ __forceinline__ unsigned xb_add(unsigned* p, unsigned v) { return __hip_atomic_fetch_add(p, v, __ATOMIC_RELAXED, __HIP_MEMORY_SCOPE_AGENT); }
__device__ __forceinline__ unsigned xb_xcc_id() { return (unsigned)__builtin_amdgcn_s_getreg((3 << 11) | 20) & 0xFu; }
#define XB_SPIN(cond, bar) do { unsigned _sp = 0; while (cond) { __builtin_amdgcn_s_sleep(1); \
    if ((++_sp & 255u) == 0u) { if (xb_ld(&(bar)[XB_TMO])) break; if (_sp > XB_SPIN_CAP) { atomicAdd(&(bar)[XB_TMO], 1u); break; } } } } while (0)

struct XcdBarrier {
    unsigned* bar; unsigned x;
    volatile LAS unsigned* st;
};

__device__ __forceinline__ XcdBarrier xcd_barrier_post(unsigned* bar, volatile LAS unsigned* st) {
    XcdBarrier b; b.bar = bar; b.x = xb_xcc_id(); b.st = st;
    if (threadIdx.x == 0) (void)xb_add(&bar[XB_XCNT(b.x)], 1u);
    return b;
}
__device__ __forceinline__ void xcd_barrier_complete(unsigned* bar, unsigned x, unsigned& nloc, unsigned& nx) {
    const unsigned G = gridDim.x * gridDim.y * gridDim.z;
    unsigned sum, cnt, mine, sp = 0u;
    for (;;) {
        sum = 0u; cnt = 0u; mine = 0u;
#pragma unroll
        for (unsigned j = 0; j < 16; ++j) { const unsigned c = xb_ld(&bar[XB_XCNT(j)]); sum += c; cnt += (c > 0u) ? 1u : 0u; mine = (j == x) ? c : mine; }
        if (sum == G) break;
        __builtin_amdgcn_s_sleep(1);
        if ((++sp & 255u) == 0u) { if (xb_ld(&bar[XB_TMO])) break; if (sp > XB_SPIN_CAP) { atomicAdd(&bar[XB_TMO], 1u); break; } }
    }
    nloc = mine > 0u ? mine : 1u; nx = cnt > 0u ? cnt : 1u;
}

__device__ __forceinline__ void xcd_barrier(const XcdBarrier& b) {
    asm volatile("s_waitcnt vmcnt(0)" ::: "memory");
    __syncthreads();
    if (threadIdx.x == 0) {
        unsigned* bar = b.bar;
        __builtin_amdgcn_s_waitcnt(0);
        unsigned nloc = b.st[0], nx = b.st[1];
        if (nloc == 0u) { xcd_barrier_complete(bar, b.x, nloc, nx); b.st[0] = nloc; b.st[1] = nx; }
        const unsigned old = xb_add(&bar[XB_XSUB(b.x)], 1u);
        const unsigned gen = old / nloc;
        if (old + 1u == (gen + 1u) * nloc) {
            __builtin_amdgcn_fence(__ATOMIC_RELEASE, "agent");
            asm volatile("s_waitcnt vmcnt(0)" ::: "memory");
            const unsigned og = xb_add(&bar[XB_TOP], 1u);
            const unsigned tg = og / nx;
            if (og + 1u == (tg + 1u) * nx) xb_add(&bar[XB_TOPGEN], 1u);
            else XB_SPIN(xb_ld(&bar[XB_TOPGEN]) == tg, bar);
            __builtin_amdgcn_fence(__ATOMIC_ACQUIRE, "agent");
            xb_add(&bar[XB_XGEN(b.x)], 1u);
            asm volatile("s_waitcnt vmcnt(0)" ::: "memory");
        } else {
            XB_SPIN(xb_ld(&bar[XB_XGEN(b.x)]) == gen, bar);
            __builtin_amdgcn_fence(__ATOMIC_ACQUIRE, "agent");
            asm volatile("s_waitcnt vmcnt(0)" ::: "memory");
        }
    }
    __syncthreads();
}
using pg8::bf16_t; using pg8::bf16x8; using pg8::f32x4; using pg8::u32x4;
typedef float f32x16 __attribute__((ext_vector_type(16)));
typedef short s16x4 __attribute__((ext_vector_type(4)));
typedef unsigned u32x2 __attribute__((ext_vector_type(2)));
#define DI __device__ __forceinline__
typedef LAS unsigned char* ldsp;
#define MFMA32(a, b, c) __builtin_amdgcn_mfma_f32_32x32x16_bf16((a), (b), (c), 0, 0, 0)

#ifndef DOUBLE_MASK
#define DOUBLE_MASK 0
#endif
#ifndef COPY_TWICE
#define COPY_TWICE 0
#endif
#ifndef ADA_TWICE
#define ADA_TWICE 0
#endif
#ifndef TR_TWICE
#define TR_TWICE 0
#endif
#ifndef P3_TWICE
#define P3_TWICE 0
#endif
#ifndef MULTI_LAUNCH
#define MULTI_LAUNCH 0
#endif

constexpr int DM = 1024, MP = 16384, MS = 32, MT = MP + MS, SEQ = 4096;
constexpr int NIE = 2560, DFF = 2816, F2 = 5632;
constexpr int NPH = 21;
constexpr int LDS_BYTES = 131072 + 256;

constexpr size_t al256(size_t x) { return (x + 255) & ~(size_t)255; }
constexpr size_t O_WT_IN_E = 0;
constexpr size_t O_WT_OUT_E = O_WT_IN_E + al256((size_t)NIE * DM * 2);
constexpr size_t O_WT_IN_O = O_WT_OUT_E + al256((size_t)DM * DM * 2);
constexpr size_t O_WT_OUT_O = O_WT_IN_O + al256((size_t)2048 * DM * 2);
constexpr size_t O_WT_UP = O_WT_OUT_O + al256((size_t)DM * DM * 2);
constexpr size_t SZ_WT_UP = (size_t)F2 * DM * 2;
constexpr size_t O_WT_DN = O_WT_UP + 2 * SZ_WT_UP;
constexpr size_t SZ_WT_DN = (size_t)DM * DFF * 2;
constexpr size_t O_WT_GA = O_WT_DN + 2 * SZ_WT_DN;
constexpr size_t O_WS_TRIL = O_WT_GA + (size_t)8 * 256 * 128 * 2;
constexpr size_t O_MOD = O_WS_TRIL + (size_t)4 * 128 * 128 * 2;
constexpr size_t O_X = O_MOD + al256((size_t)2 * 36 * 6144 * 4);
constexpr size_t O_H = O_X + (size_t)MT * DM * 4;
constexpr size_t O_AO = O_H + (size_t)MT * DM * 2;
constexpr size_t O_AGG = O_AO + (size_t)MT * DM * 2;
constexpr size_t O_SLOT = O_AGG + (size_t)2 * 4 * 64 * 1024 * 4;
constexpr size_t O_BIG = al256(O_SLOT + (size_t)4 * 4 * MP * 4);
constexpr int CNT_WORD = 3600;
constexpr size_t O_Z = O_BIG;
constexpr size_t O_OP = O_Z + al256((size_t)MT * NIE * 2);
constexpr size_t O_LSE = O_OP + (size_t)3 * MP * 512 * 2;
constexpr size_t O_UP = O_BIG;
constexpr size_t O_ACT = O_UP + al256((size_t)MT * F2 * 2);
constexpr size_t O_ZO = O_BIG;
constexpr size_t O_AA = O_ZO + al256((size_t)MT * 2048 * 2);
constexpr size_t O_BB = O_AA + (size_t)MP * DM * 4;
constexpr size_t O_BAR = al256(O_ACT + (size_t)MT * DFF * 2);
constexpr size_t BAR_BYTES = 16384;
constexpr size_t WS_NEED = O_BAR + BAR_BYTES;

constexpr size_t OUT_Y_P = 0;
constexpr size_t OUT_Y_S = OUT_Y_P + (size_t)MP * DM;
constexpr size_t OUT_WK_P = OUT_Y_S + (size_t)MS * DM;
constexpr size_t OUT_WV_P = OUT_WK_P + (size_t)4 * 2048 * 512;
constexpr size_t OUT_RC_P = OUT_WV_P + (size_t)4 * 2048 * 512;
constexpr size_t OUT_RH_P = OUT_RC_P + (size_t)4 * 3 * 1024;
constexpr size_t OUT_FC_P = OUT_RH_P + (size_t)4 * 1024;
constexpr size_t OUT_CV_S = OUT_FC_P + (size_t)2 * 4 * 2 * F2;
constexpr size_t OUT_WK_S = OUT_CV_S + (size_t)32 * 512;
constexpr size_t OUT_WV_S = OUT_WK_S + (size_t)32 * 2048 * 512;
constexpr size_t OUT_RC_S = OUT_WV_S + (size_t)32 * 2048 * 512;
constexpr size_t OUT_RH_S = OUT_RC_S + (size_t)32 * 3 * 1024;
constexpr size_t OUT_FC_S = OUT_RH_S + (size_t)32 * 1024;
constexpr size_t OUT_TOTAL = OUT_FC_S + (size_t)2 * 32 * 2 * F2;

enum { I_XP = 0, I_XS, I_CK, I_CV, I_SRC, I_SRH, I_SFC, I_CP, I_CS, I_WADA, I_BADA, I_WINE, I_LNG, I_LNB, I_WSGU, I_BSGU, I_WOUTE,
       I_WINO, I_RCW, I_RCB, I_RWA, I_RBA, I_RWX, I_RBX, I_RLAM, I_WOUTO, I_FUP, I_FCW, I_FCB, I_FDN, I_FING, N_IN };

struct Params { const float* in[N_IN]; float* out; unsigned char* ws; };

DI float bf2f(bf16_t b) { return __uint_as_float(((unsigned)b) << 16); }
DI float bfs2f(short b) { return __uint_as_float(((unsigned)(unsigned short)b) << 16); }
DI unsigned pk2(float lo, float hi) { return pg8::cvt_pk_bf16(lo, hi); }
DI bf16_t f2bf(float f) { return (bf16_t)(pk2(f, 0.f) & 0xffffu); }
DI float wave_sum(float v) {
#pragma unroll
    for (int o = 1; o < 64; o <<= 1) v += __shfl_xor(v, o);
    return v;
}
DI float wave_max(float v) {
#pragma unroll
    for (int o = 1; o < 64; o <<= 1) v = fmaxf(v, __shfl_xor(v, o));
    return v;
}
DI float gelu_tanh(float x) {
    const float u2 = (-2.f * 0.7978845608028654f * 1.4426950408889634f) * (x + 0.044715f * x * x * x);
    return x * __builtin_amdgcn_rcpf(1.f + __builtin_amdgcn_exp2f(u2));
}
DI float sigmoidf(float x) { return 1.f / (1.f + __expf(-x)); }
DI float fexp2(float x) { return __builtin_amdgcn_exp2f(x); }
DI float frcp(float x) { return __builtin_amdgcn_rcpf(x); }
DI float fsigmoid(float x) { return frcp(1.f + fexp2(-1.4426950408889634f * x)); }
DI int crow(int reg, int hf) { return (reg & 3) + 8 * (reg >> 2) + 4 * hf; }
DI int bidx_of(int row) { return row < MP ? (row >> 12) : 4 + (row - MP); }
DI void store_bf16x4(bf16_t* p, f32x4 v) { u32x2 o; o.x = pk2(v.x, v.y); o.y = pk2(v.z, v.w); *(u32x2*)p = o; }
DI bf16x8 pack_step(const f32x16& x, int s) {
    u32x4 p;
    p.x = pk2(x[8 * s + 0], x[8 * s + 1]); p.y = pk2(x[8 * s + 2], x[8 * s + 3]); p.z = pk2(x[8 * s + 4], x[8 * s + 5]); p.w = pk2(x[8 * s + 6], x[8 * s + 7]);
    return __builtin_bit_cast(bf16x8, p);
}
DI s16x4 tr_read(unsigned lds_addr) { s16x4 r; asm volatile("ds_read_b64_tr_b16 %0, %1\n\ts_waitcnt lgkmcnt(0)" : "=&v"(r) : "v"(lds_addr) : "memory"); return r; }

DI void transpose_item(const float* __restrict__ W, int K, int N, bf16_t* WT, int item, LAS float* scr, int lane, bool pair_up = false) {
    const int nblk = N >> 5, kb = item / nblk, nb = item - kb * nblk, k0 = 64 * kb, n0 = 32 * nb;
    int r0 = n0; if (pair_up) { const int half = n0 >= DFF ? 1 : 0, chn = n0 - half * DFF; r0 = 256 * (chn >> 7) + 128 * half + (chn & 127); }
    float tv[32];
#pragma unroll
    for (int i = 0; i < 32; ++i) tv[i] = W[(size_t)(k0 + 2 * i + (lane >> 5)) * N + n0 + (lane & 31)];
#pragma unroll
    for (int i = 0; i < 32; ++i) scr[(2 * i + (lane >> 5)) * 33 + (lane & 31)] = tv[i];
    asm volatile("s_waitcnt lgkmcnt(0)" ::: "memory");
    const int c = lane & 7;
#pragma unroll
    for (int j = 0; j < 4; ++j) { const int n = (lane >> 3) + 8 * j; const LAS float* sp = scr + (8 * c) * 33 + n;
        u32x4 o; o.x = pk2(sp[0 * 33], sp[1 * 33]); o.y = pk2(sp[2 * 33], sp[3 * 33]); o.z = pk2(sp[4 * 33], sp[5 * 33]); o.w = pk2(sp[6 * 33], sp[7 * 33]);
        *(u32x4*)(WT + (size_t)(r0 + n) * K + k0 + 8 * c) = o; }
    asm volatile("s_waitcnt lgkmcnt(0)" ::: "memory");
}

DI void adaln_item(const Params& p, int item, ldsp lds) {
    const int qr = item & 3, l = (item >> 2) / 96, j0 = ((item >> 2) % 96) * 64, tid = threadIdx.x, w = tid >> 6, lane = tid & 63;
    LAS float* s = (LAS float*)lds;
    LAS float* part = (LAS float*)(lds + 9 * 1024 * 4);
    const float* W = p.in[I_WADA] + (size_t)l * 1024 * 6144;
    float* MOD = (float*)(p.ws + O_MOD);
    for (int idx = tid; idx < 9 * 1024; idx += 512) {
        const int r = idx >> 10, k = idx & 1023, rr = qr * 9 + r;
        const float c = rr < 4 ? p.in[I_CP][rr * 1024 + k] : p.in[I_CS][(rr - 4) * 1024 + k];
        s[idx] = c / (1.f + __expf(-c));
    }
    __syncthreads();
    float acc[9];
#pragma unroll
    for (int r = 0; r < 9; ++r) acc[r] = 0.f;
    const int kbase = w * 128;
    for (int k = 0; k < 128; k += 32) {
        float wv[32];
#pragma unroll
        for (int i = 0; i < 32; ++i) wv[i] = W[(size_t)(kbase + k + i) * 6144 + j0 + lane];
#pragma unroll
        for (int i = 0; i < 32; i += 4) {
#pragma unroll
            for (int r = 0; r < 9; ++r) { const f32x4 sv = *(LAS f32x4*)(s + r * 1024 + kbase + k + i); acc[r] += sv.x * wv[i] + sv.y * wv[i + 1] + sv.z * wv[i + 2] + sv.w * wv[i + 3]; }
        }
    }
#pragma unroll
    for (int r = 0; r < 9; ++r) part[(w * 9 + r) * 64 + lane] = acc[r];
    __syncthreads();
    for (int idx = tid; idx < 9 * 64; idx += 512) {
        const int r = idx >> 6, j = idx & 63; float sum = 0.f;
#pragma unroll
        for (int ww = 0; ww < 8; ++ww) sum += part[(ww * 9 + r) * 64 + j];
        MOD[(size_t)(l * 36 + qr * 9 + r) * 6144 + j0 + j] = sum + p.in[I_BADA][l * 6144 + j0 + j];
    }
    __syncthreads();
}

constexpr int P0_ADA = 768;
constexpr int T_INE = 16 * 80, T_OUTE = 16 * 32, T_INO = 16 * 64, T_OUTO = 16 * 32, T_UP = 16 * 176, T_DN = 44 * 32, T_G = 2 * 4;
constexpr int P0_TR = T_INE + T_OUTE + T_INO + T_OUTO + 2 * T_UP + 2 * T_DN + 16 * T_G;
constexpr int P0_TRIL = 16;
constexpr int P0_WITEMS = P0_TR + P0_TRIL;
constexpr int CTR_WORD = 3584;

DI void p0_wave_item(const Params& p, int r, LAS float* scr, int lane) {
    unsigned char* ws = p.ws;
    if (r < T_INE) { transpose_item(p.in[I_WINE], 1024, NIE, (bf16_t*)(ws + O_WT_IN_E), r, scr, lane); return; } r -= T_INE;
    if (r < T_OUTE) { transpose_item(p.in[I_WOUTE], 1024, 1024, (bf16_t*)(ws + O_WT_OUT_E), r, scr, lane); return; } r -= T_OUTE;
    if (r < T_INO) { transpose_item(p.in[I_WINO], 1024, 2048, (bf16_t*)(ws + O_WT_IN_O), r, scr, lane); return; } r -= T_INO;
    if (r < T_OUTO) { transpose_item(p.in[I_WOUTO], 1024, 1024, (bf16_t*)(ws + O_WT_OUT_O), r, scr, lane); return; } r -= T_OUTO;
    if (r < 2 * T_UP) { const int l = r / T_UP; transpose_item(p.in[I_FUP] + (size_t)l * 1024 * F2, 1024, F2, (bf16_t*)(ws + O_WT_UP + l * SZ_WT_UP), r - l * T_UP, scr, lane, true); return; } r -= 2 * T_UP;
    if (r < 2 * T_DN) { const int l = r / T_DN; transpose_item(p.in[I_FDN] + (size_t)l * DFF * 1024, DFF, 1024, (bf16_t*)(ws + O_WT_DN + l * SZ_WT_DN), r - l * T_DN, scr, lane); return; } r -= 2 * T_DN;
    if (r < 16 * T_G) { const int which = r / (8 * T_G), rr = r % (8 * T_G), g = rr / T_G, ti = rr % T_G;
        transpose_item(p.in[which ? I_RWX : I_RWA] + (size_t)g * 128 * 128, 128, 128, (bf16_t*)(ws + O_WT_GA) + (size_t)(g * 256 + which * 128) * 128, ti, scr, lane); return; }
    r -= 16 * T_G;
    {
        const int g = r >> 2, q = r & 3;
        bf16_t* dst = (bf16_t*)(ws + O_WS_TRIL) + (size_t)g * 16384 + q * 4096; const float* src = p.in[I_WSGU] + (size_t)g * 16384 + q * 4096;
        for (int idx = lane; idx < 4096; idx += 64) { const int t = q * 32 + (idx >> 7), sidx = idx & 127; dst[idx] = f2bf(sidx <= t ? src[idx] : 0.f); }
    }
}

DI void phase0(const Params& p, ldsp lds, int rep) {
    for (int it = blockIdx.x; it < P0_ADA; it += gridDim.x) adaln_item(p, it, lds);
#if ADA_TWICE
    for (int it = blockIdx.x; it < P0_ADA; it += gridDim.x) adaln_item(p, it, lds);
#endif
    const int wave = threadIdx.x >> 6, lane = threadIdx.x & 63;
    LAS float* scr = (LAS float*)(lds + wave * 8448);
    for (int it = wave * (int)gridDim.x + (int)blockIdx.x; it < P0_WITEMS; it += 8 * (int)gridDim.x) p0_wave_item(p, it, scr, lane);
#if TR_TWICE
    for (int it = wave * (int)gridDim.x + (int)blockIdx.x; it < P0_WITEMS; it += 8 * (int)gridDim.x) p0_wave_item(p, it, scr, lane);
#endif
}

constexpr int COPY_ITEMS = 2048;
DI void copy_items(const Params& p, int lo, int hi, int first, int stride) {
    constexpr int PER_B = 2047 * 128;
    for (int r = lo + first; r < hi; r += 2 * stride) {
        const int r2 = r + stride; const bool two = r2 < hi;
        const int wb0 = r >> 5, rb0 = r & 31, wb1 = (two ? r2 : r) >> 5, rb1 = (two ? r2 : r) & 31;
        const f32x4* s0 = (const f32x4*)(p.in[(wb0 >> 5) ? I_CV : I_CK] + (size_t)(wb0 & 31) * 2048 * 512 + 512) + rb0 * 8192 + threadIdx.x;
        f32x4* d0 = (f32x4*)(p.out + ((wb0 >> 5) ? OUT_WV_S : OUT_WK_S) + (size_t)(wb0 & 31) * 2048 * 512) + rb0 * 8192 + threadIdx.x;
        const f32x4* s1 = (const f32x4*)(p.in[(wb1 >> 5) ? I_CV : I_CK] + (size_t)(wb1 & 31) * 2048 * 512 + 512) + rb1 * 8192 + threadIdx.x;
        f32x4* d1 = (f32x4*)(p.out + ((wb1 >> 5) ? OUT_WV_S : OUT_WK_S) + (size_t)(wb1 & 31) * 2048 * 512) + rb1 * 8192 + threadIdx.x;
        const int q0 = rb0 * 8192 + (int)threadIdx.x, q1 = rb1 * 8192 + (int)threadIdx.x;
        f32x4 v0[16], v1[16];
#pragma unroll
        for (int i = 0; i < 16; ++i) if (q0 + i * 512 < PER_B) v0[i] = __builtin_nontemporal_load(s0 + i * 512);
        if (two) {
#pragma unroll
            for (int i = 0; i < 16; ++i) if (q1 + i * 512 < PER_B) v1[i] = __builtin_nontemporal_load(s1 + i * 512);
        }
#pragma unroll
        for (int i = 0; i < 16; ++i) if (q0 + i * 512 < PER_B) __builtin_nontemporal_store(v0[i], d0 + i * 512);
        if (two) {
#pragma unroll
            for (int i = 0; i < 16; ++i) if (q1 + i * 512 < PER_B) __builtin_nontemporal_store(v1[i], d1 + i * 512);
        }
    }
}

DI void norm_phase(const float* xp, const float* xs, const float* mod, int sh_off, int sc_off, bf16_t* H) {
    const int lane = threadIdx.x & 63, gw = blockIdx.x * 8 + (threadIdx.x >> 6), ngw = gridDim.x * 8;
    for (int row0 = gw * 4; row0 < MT; row0 += ngw * 4) {
        f32x4 v[4][4];
#pragma unroll
        for (int r = 0; r < 4; ++r) { const int row = row0 + r; const float* src = row < MP ? xp + (size_t)row * DM : xs + (size_t)(row - MP) * DM;
#pragma unroll
            for (int j = 0; j < 4; ++j) v[r][j] = *((const f32x4*)src + lane + 64 * j); }
#pragma unroll
        for (int r = 0; r < 4; ++r) {
            const int row = row0 + r; const float* mrow = mod + (size_t)bidx_of(row) * 6144;
            float ss = 0.f;
#pragma unroll
            for (int j = 0; j < 4; ++j) ss += v[r][j].x * v[r][j].x + v[r][j].y * v[r][j].y + v[r][j].z * v[r][j].z + v[r][j].w * v[r][j].w;
            const float rs = rsqrtf(wave_sum(ss) * (1.f / DM) + 1e-6f);
#pragma unroll
            for (int j = 0; j < 4; ++j) {
                const int col = 4 * (lane + 64 * j);
                const f32x4 sc = *(const f32x4*)(mrow + sc_off + col), sh = *(const f32x4*)(mrow + sh_off + col);
                f32x4 h; h.x = v[r][j].x * rs * (1.f + sc.x) + sh.x; h.y = v[r][j].y * rs * (1.f + sc.y) + sh.y; h.z = v[r][j].z * rs * (1.f + sc.z) + sh.z; h.w = v[r][j].w * rs * (1.f + sc.w) + sh.w;
                store_bf16x4(H + (size_t)row * DM + col, h);
            }
        }
    }
}
DI void final_norm_phase(const float* X, const float* g, float* yp, float* ys) {
    const int lane = threadIdx.x & 63, gw = blockIdx.x * 8 + (threadIdx.x >> 6), ngw = gridDim.x * 8;
    f32x4 gg[4];
#pragma unroll
    for (int j = 0; j < 4; ++j) gg[j] = *((const f32x4*)g + lane + 64 * j);
    for (int row0 = gw * 4; row0 < MT; row0 += ngw * 4) {
        f32x4 v[4][4];
#pragma unroll
        for (int r = 0; r < 4; ++r) {
#pragma unroll
            for (int j = 0; j < 4; ++j) v[r][j] = *((const f32x4*)(X + (size_t)(row0 + r) * DM) + lane + 64 * j); }
#pragma unroll
        for (int r = 0; r < 4; ++r) {
            const int row = row0 + r; float* dst = row < MP ? yp + (size_t)row * DM : ys + (size_t)(row - MP) * DM;
            float ss = 0.f;
#pragma unroll
            for (int j = 0; j < 4; ++j) ss += v[r][j].x * v[r][j].x + v[r][j].y * v[r][j].y + v[r][j].z * v[r][j].z + v[r][j].w * v[r][j].w;
            const float rs = rsqrtf(wave_sum(ss) * (1.f / DM) + 1e-6f);
#pragma unroll
            for (int j = 0; j < 4; ++j) *((f32x4*)dst + lane + 64 * j) = v[r][j] * rs * gg[j];
        }
    }
}

DI void final_norm_samples(const bf16_t* X, const float* g, float* ys) {
    const int lane = threadIdx.x & 63, gw = blockIdx.x * 8 + (threadIdx.x >> 6);
    if (gw < MS) {
        const bf16_t* src = X + (size_t)(MP + gw) * DM; f32x4 v[4]; float ss = 0.f;
#pragma unroll
        for (int j = 0; j < 4; ++j) { const u32x2 raw = *((const u32x2*)src + lane + 64 * j);
            v[j].x = __uint_as_float(raw.x << 16); v[j].y = __uint_as_float(raw.x & 0xffff0000u); v[j].z = __uint_as_float(raw.y << 16); v[j].w = __uint_as_float(raw.y & 0xffff0000u);
            ss += v[j].x * v[j].x + v[j].y * v[j].y + v[j].z * v[j].z + v[j].w * v[j].w; }
        const float rs = rsqrtf(wave_sum(ss) * (1.f / DM) + 1e-6f);
#pragma unroll
        for (int j = 0; j < 4; ++j) *((f32x4*)(ys + (size_t)gw * DM) + lane + 64 * j) = v[j] * rs * *((const f32x4*)g + lane + 64 * j);
    }
}

template <class Q> struct EpiWrap {
    static constexpr bool PERM = false, AFTER_DRAIN = false;
    Q q;
    DI void operator()(const f32x4 (&acc)[2][2][4][2], const pg8::Unit& u, int wr, int wc, int fr, int fq) const {
#pragma unroll
        for (int ai = 0; ai < 2; ++ai)
#pragma unroll
            for (int m = 0; m < 4; ++m) {
                const int row = u.pm * 256 + ai * 128 + wr * 64 + m * 16 + fr;
#pragma unroll
                for (int bj = 0; bj < 2; ++bj)
#pragma unroll
                    for (int n = 0; n < 2; ++n) q.quad(row, u.pn * 256 + bj * 128 + wc * 32 + n * 16 + 4 * fq, acc[ai][bj][m][n]);
            }
    }
};

struct EpiResFused {
    static constexpr bool PERM = false, AFTER_DRAIN = true;
    const float *rp, *rsm; bf16_t* X; const float* g;
    int mode;
    const float *sc, *sh; bf16_t* H; const float* fg; float* Y;
    float* slots; unsigned* cnt;
    DI void fused(f32x4 (&acc)[2][2][4][2], const pg8::Unit& u, int wr, int wc, int fr, int fq, ldsp lds, int wid, int lane) const {
        LAS float* part = (LAS float*)lds; LAS float* rsv = part + 1024;
        const size_t mb = (size_t)(u.pm >> 4) * 6144;
        f32x4 ggv[2][2];
#pragma unroll
        for (int bj = 0; bj < 2; ++bj)
#pragma unroll
            for (int n = 0; n < 2; ++n) ggv[bj][n] = *(const f32x4*)(g + mb + u.pn * 256 + bj * 128 + wc * 32 + n * 16 + 4 * fq);
#pragma unroll
        for (int ai = 0; ai < 2; ++ai)
#pragma unroll
            for (int m = 0; m < 4; ++m) {
                const int rl = ai * 128 + wr * 64 + m * 16 + fr, row = u.pm * 256 + rl;
                float ss = 0.f;
#pragma unroll
                for (int bj = 0; bj < 2; ++bj)
#pragma unroll
                    for (int n = 0; n < 2; ++n) {
                        const int col = u.pn * 256 + bj * 128 + wc * 32 + n * 16 + 4 * fq;
                        f32x4 x;
                        if (rp) x = *(const f32x4*)(rp + (size_t)row * DM + col);
                        else { const u32x2 raw = *(const u32x2*)(X + (size_t)row * DM + col); x.x = __uint_as_float(raw.x << 16); x.y = __uint_as_float(raw.x & 0xffff0000u); x.z = __uint_as_float(raw.y << 16); x.w = __uint_as_float(raw.y & 0xffff0000u); }
                        const f32x4 xn = x + ggv[bj][n] * acc[ai][bj][m][n];
                        acc[ai][bj][m][n] = xn;
                        if (mode == 0) store_bf16x4(X + (size_t)row * DM + col, xn);
                        ss += xn.x * xn.x + xn.y * xn.y + xn.z * xn.z + xn.w * xn.w;
                    }
                ss += __shfl_xor(ss, 16); ss += __shfl_xor(ss, 32);
                if (fq == 0) part[wc * 256 + rl] = ss;
            }
        __syncthreads();
        const int tid = threadIdx.x;
        if (tid < 256) __hip_atomic_store(slots + (size_t)u.pn * MP + u.pm * 256 + tid, (part[tid] + part[256 + tid]) + (part[512 + tid] + part[768 + tid]), __ATOMIC_RELAXED, __HIP_MEMORY_SCOPE_AGENT);
        asm volatile("s_waitcnt vmcnt(0)" ::: "memory");
        __syncthreads();
        if (tid == 0) {
            __hip_atomic_fetch_add(cnt + u.pm, 1u, __ATOMIC_RELAXED, __HIP_MEMORY_SCOPE_AGENT);
            unsigned spins = 0;
            while (__hip_atomic_load(cnt + u.pm, __ATOMIC_RELAXED, __HIP_MEMORY_SCOPE_AGENT) < 4u) { __builtin_amdgcn_s_sleep(1); if (++spins > (1u << 22)) break; }
        }
        __syncthreads();
        if (tid < 256) {
            const float* sp = slots + u.pm * 256 + tid;
            const float t0 = __hip_atomic_load(sp, __ATOMIC_RELAXED, __HIP_MEMORY_SCOPE_AGENT), t1 = __hip_atomic_load(sp + MP, __ATOMIC_RELAXED, __HIP_MEMORY_SCOPE_AGENT);
            const float t2 = __hip_atomic_load(sp + 2 * MP, __ATOMIC_RELAXED, __HIP_MEMORY_SCOPE_AGENT), t3 = __hip_atomic_load(sp + 3 * MP, __ATOMIC_RELAXED, __HIP_MEMORY_SCOPE_AGENT);
            rsv[tid] = rsqrtf(((t0 + t1) + (t2 + t3)) * (1.f / DM) + 1e-6f);
        }
        __syncthreads();
        f32x4 m1[2][2], m0[2][2];
#pragma unroll
        for (int bj = 0; bj < 2; ++bj)
#pragma unroll
            for (int n = 0; n < 2; ++n) {
                const int col = u.pn * 256 + bj * 128 + wc * 32 + n * 16 + 4 * fq;
                if (mode == 0) { m1[bj][n] = *(const f32x4*)(sc + mb + col) + 1.f; m0[bj][n] = *(const f32x4*)(sh + mb + col); }
                else { m1[bj][n] = *(const f32x4*)(fg + col); m0[bj][n] = (f32x4){0.f, 0.f, 0.f, 0.f}; }
            }
#pragma unroll
        for (int ai = 0; ai < 2; ++ai)
#pragma unroll
            for (int m = 0; m < 4; ++m) {
                const int rl = ai * 128 + wr * 64 + m * 16 + fr, row = u.pm * 256 + rl;
                const float r = rsv[rl];
#pragma unroll
                for (int bj = 0; bj < 2; ++bj)
#pragma unroll
                    for (int n = 0; n < 2; ++n) {
                        const int col = u.pn * 256 + bj * 128 + wc * 32 + n * 16 + 4 * fq;
                        const f32x4 xn = acc[ai][bj][m][n];
                        if (mode == 0) store_bf16x4(H + (size_t)row * DM + col, xn * r * m1[bj][n] + m0[bj][n]);
                        else *(f32x4*)(Y + (size_t)row * DM + col) = xn * r * m1[bj][n];
                    }
            }
        __syncthreads();
    }
    DI void quad(int row, int col, f32x4 v) const {
        f32x4 x;
        if (rsm) x = *(const f32x4*)(rsm + (size_t)(row - MP) * DM + col);
        else { const u32x2 raw = *(const u32x2*)(X + (size_t)row * DM + col); x.x = __uint_as_float(raw.x << 16); x.y = __uint_as_float(raw.x & 0xffff0000u); x.z = __uint_as_float(raw.y << 16); x.w = __uint_as_float(raw.y & 0xffff0000u); }
        const f32x4 gg = *(const f32x4*)(g + (size_t)bidx_of(row) * 6144 + col);
        store_bf16x4(X + (size_t)row * DM + col, x + gg * v);
    }
};

struct EpiUpGate {
    static constexpr bool PERM = true, AFTER_DRAIN = false;
    bf16_t* ACT; bf16_t* UPB; const float* cw; const float* cb;
    static DI float ror1(float v) { return __builtin_bit_cast(float, __builtin_amdgcn_update_dpp(0, __builtin_bit_cast(int, v), 0x121, 0xf, 0xf, false)); }
    static DI float ror2(float v) { return __builtin_bit_cast(float, __builtin_amdgcn_update_dpp(0, __builtin_bit_cast(int, v), 0x122, 0xf, 0xf, false)); }
    static DI float shr1(float old, float v) { return __builtin_bit_cast(float, __builtin_amdgcn_update_dpp(__builtin_bit_cast(int, old), __builtin_bit_cast(int, v), 0x111, 0xf, 0xf, false)); }
    static DI float shr2(float old, float v) { return __builtin_bit_cast(float, __builtin_amdgcn_update_dpp(__builtin_bit_cast(int, old), __builtin_bit_cast(int, v), 0x112, 0xf, 0xf, false)); }
    DI void operator()(const f32x4 (&acc)[2][2][4][2], const pg8::Unit& u, int wr, int wc, int fr, int fq) const {
        const int ch0 = 128 * u.pn + 32 * wc + 8 * fq;
        u32x4 pk[2][4]; float ev[2][4];
#pragma unroll
        for (int n = 0; n < 2; ++n) {
#pragma unroll
            for (int c = 0; c < 4; ++c) {
                const int ch = ch0 + 4 * n + c;
                const float wa0 = cw[ch], wa1 = cw[F2 + ch], wa2 = cw[2 * F2 + ch], ba = cb[ch];
                const float wb0 = cw[DFF + ch], wb1 = cw[F2 + DFF + ch], wb2 = cw[2 * F2 + DFF + ch], bb = cb[DFF + ch];
#pragma unroll
                for (int ai = 0; ai < 2; ++ai) {
                    float q1a = 0.f, q2a = 0.f, q1b = 0.f, q2b = 0.f;
#pragma unroll
                    for (int m = 0; m < 4; ++m) {
                        const float va = acc[ai][0][m][n][c], vb = acc[ai][1][m][n][c];
                        const float p1a = shr1(q1a, va), p2a = shr2(q2a, va), p1b = shr1(q1b, vb), p2b = shr2(q2b, vb);
                        if (m < 3) { q1a = ror1(va); q2a = ror2(va); q1b = ror1(vb); q2b = ror2(vb); }
                        const float ya = ba + wa0 * p2a + wa1 * p1a + wa2 * va;
                        const float yb = bb + wb0 * p2b + wb1 * p1b + wb2 * vb;
                        const float act = ya * __builtin_amdgcn_rcpf(1.f + __builtin_amdgcn_exp2f(-1.4426950408889634f * ya)) * yb;
                        if (c == 0 || c == 2) ev[ai][m] = act;
                        else if (n == 0 && c == 1) pk[ai][m].x = pk2(ev[ai][m], act);
                        else if (n == 0 && c == 3) pk[ai][m].y = pk2(ev[ai][m], act);
                        else if (n == 1 && c == 1) pk[ai][m].z = pk2(ev[ai][m], act);
                        else pk[ai][m].w = pk2(ev[ai][m], act);
                    }
                }
            }
        }
#pragma unroll
        for (int ai = 0; ai < 2; ++ai)
#pragma unroll
            for (int m = 0; m < 4; ++m) {
                const int row = u.pm * 256 + ai * 128 + wr * 64 + m * 16 + fr;
                if (!(m == 0 && fr < 2)) *(u32x4*)(ACT + (size_t)row * DFF + ch0) = pk[ai][m];
                if ((m == 3 && fr >= 14) || (m == 0 && fr < 2)) {
                    const int slot = m == 3 ? fr - 14 : 2 + fr;
                    bf16_t* hb = UPB + (size_t)((row >> 6) * 4 + slot) * F2;
                    store_bf16x4(hb + ch0, acc[ai][0][m][0]); store_bf16x4(hb + ch0 + 4, acc[ai][0][m][1]);
                    store_bf16x4(hb + DFF + ch0, acc[ai][1][m][0]); store_bf16x4(hb + DFF + ch0 + 4, acc[ai][1][m][1]);
                }
            }
    }
};
struct QUpS {
    bf16_t* UP;
    DI void quad(int row, int pcol, f32x4 v) const {
        const int within = pcol & 255, col = (within >> 7) * DFF + 128 * (pcol >> 8) + (within & 127);
        store_bf16x4(UP + (size_t)row * F2 + col, v);
    }
};

template <class Q> struct EpiWrapP {
    static constexpr bool PERM = true, AFTER_DRAIN = false;
    Q q;
    DI void operator()(const f32x4 (&acc)[2][2][4][2], const pg8::Unit& u, int wr, int wc, int fr, int fq) const {
#pragma unroll
        for (int ai = 0; ai < 2; ++ai)
#pragma unroll
            for (int m = 0; m < 4; ++m) {
                const int row = u.pm * 256 + ai * 128 + wr * 64 + m * 16 + fr;
#pragma unroll
                for (int bj = 0; bj < 2; ++bj) q.oct(row, u.pn * 256 + bj * 128 + wc * 32 + 8 * fq, acc[ai][bj][m][0], acc[ai][bj][m][1]);
            }
    }
};

template <class Q> DI void sample_tail(const bf16_t* As, const bf16_t* Bt, int N, int K, const Q& q) {
    const int wave = threadIdx.x >> 6, lane = threadIdx.x & 63, nch = K >> 3;
    for (int qd = blockIdx.x; qd < (N >> 2); qd += gridDim.x) {
        float s[4][4];
#pragma unroll
        for (int r = 0; r < 4; ++r)
#pragma unroll
            for (int c = 0; c < 4; ++c) s[r][c] = 0.f;
        for (int ch = lane; ch < nch; ch += 64) {
            bf16x8 a[4], w[4];
#pragma unroll
            for (int r = 0; r < 4; ++r) a[r] = *(const bf16x8*)(As + (size_t)(4 * wave + r) * K + ch * 8);
#pragma unroll
            for (int c = 0; c < 4; ++c) w[c] = *(const bf16x8*)(Bt + (size_t)(4 * qd + c) * K + ch * 8);
#pragma unroll
            for (int j = 0; j < 8; ++j) {
                float af[4], wf[4];
#pragma unroll
                for (int r = 0; r < 4; ++r) af[r] = bfs2f(a[r][j]);
#pragma unroll
                for (int c = 0; c < 4; ++c) wf[c] = bfs2f(w[c][j]);
#pragma unroll
                for (int r = 0; r < 4; ++r)
#pragma unroll
                    for (int c = 0; c < 4; ++c) s[r][c] += af[r] * wf[c];
            }
        }
        const bool b5 = (lane & 32) != 0, b4 = (lane & 16) != 0;
        float k0[2][4], k1[4];
#pragma unroll
        for (int rr = 0; rr < 2; ++rr)
#pragma unroll
            for (int c = 0; c < 4; ++c) { const float keep = b5 ? s[2 + rr][c] : s[rr][c], send = b5 ? s[rr][c] : s[2 + rr][c]; k0[rr][c] = keep + __shfl_xor(send, 32); }
#pragma unroll
        for (int c = 0; c < 4; ++c) { const float keep = b4 ? k0[1][c] : k0[0][c], send = b4 ? k0[0][c] : k0[1][c]; k1[c] = keep + __shfl_xor(send, 16); }
#pragma unroll
        for (int c = 0; c < 4; ++c) {
#pragma unroll
            for (int o = 8; o >= 1; o >>= 1) k1[c] += __shfl_xor(k1[c], o); }
        f32x4 v; v.x = k1[0]; v.y = k1[1]; v.z = k1[2]; v.w = k1[3];
        if ((lane & 15) == 0) q.quad(MP + 4 * wave + (lane >> 4), 4 * qd, v);
    }
}

template <class Q> DI void sample_tail_norm(const bf16_t* Xs  , const float* mod  , int sh_off, int sc_off, const bf16_t* Bt, int N, const Q& q) {
    const int wave = threadIdx.x >> 6, lane = threadIdx.x & 63;
    float af[4][16];
#pragma unroll
    for (int r = 0; r < 4; ++r) {
        const int bs = 4 * wave + r; const bf16_t* xr = Xs + (size_t)bs * DM; const float* mr = mod + (size_t)(4 + bs) * 6144;
        f32x4 xv[4]; float ss = 0.f;
#pragma unroll
        for (int it = 0; it < 2; ++it) { const bf16x8 raw = *(const bf16x8*)(xr + (lane + 64 * it) * 8);
            xv[2 * it].x = bfs2f(raw[0]); xv[2 * it].y = bfs2f(raw[1]); xv[2 * it].z = bfs2f(raw[2]); xv[2 * it].w = bfs2f(raw[3]);
            xv[2 * it + 1].x = bfs2f(raw[4]); xv[2 * it + 1].y = bfs2f(raw[5]); xv[2 * it + 1].z = bfs2f(raw[6]); xv[2 * it + 1].w = bfs2f(raw[7]); }
#pragma unroll
        for (int j = 0; j < 4; ++j) ss += xv[j].x * xv[j].x + xv[j].y * xv[j].y + xv[j].z * xv[j].z + xv[j].w * xv[j].w;
        const float rsx = rsqrtf(wave_sum(ss) * (1.f / DM) + 1e-6f);
#pragma unroll
        for (int it = 0; it < 2; ++it)
#pragma unroll
            for (int hh = 0; hh < 2; ++hh) {
                const int k0 = (lane + 64 * it) * 8 + 4 * hh;
                const f32x4 s1 = *(const f32x4*)(mr + sc_off + k0), s0 = *(const f32x4*)(mr + sh_off + k0), xx = xv[2 * it + hh];
                af[r][8 * it + 4 * hh + 0] = xx.x * rsx * (1.f + s1.x) + s0.x; af[r][8 * it + 4 * hh + 1] = xx.y * rsx * (1.f + s1.y) + s0.y;
                af[r][8 * it + 4 * hh + 2] = xx.z * rsx * (1.f + s1.z) + s0.z; af[r][8 * it + 4 * hh + 3] = xx.w * rsx * (1.f + s1.w) + s0.w;
            }
    }
    for (int qd = blockIdx.x; qd < (N >> 2); qd += gridDim.x) {
        float s[4][4];
#pragma unroll
        for (int r = 0; r < 4; ++r)
#pragma unroll
            for (int c = 0; c < 4; ++c) s[r][c] = 0.f;
#pragma unroll
        for (int it = 0; it < 2; ++it) {
            bf16x8 w[4];
#pragma unroll
            for (int c = 0; c < 4; ++c) w[c] = *(const bf16x8*)(Bt + (size_t)(4 * qd + c) * 1024 + (lane + 64 * it) * 8);
#pragma unroll
            for (int j = 0; j < 8; ++j)
#pragma unroll
                for (int c = 0; c < 4; ++c) { const float wf = bfs2f(w[c][j]);
#pragma unroll
                    for (int r = 0; r < 4; ++r) s[r][c] += af[r][8 * it + j] * wf; }
        }
        const bool b5 = (lane & 32) != 0, b4 = (lane & 16) != 0;
        float k0[2][4], k1[4];
#pragma unroll
        for (int rr = 0; rr < 2; ++rr)
#pragma unroll
            for (int c = 0; c < 4; ++c) { const float keep = b5 ? s[2 + rr][c] : s[rr][c], send = b5 ? s[rr][c] : s[2 + rr][c]; k0[rr][c] = keep + __shfl_xor(send, 32); }
#pragma unroll
        for (int c = 0; c < 4; ++c) { const float keep = b4 ? k0[1][c] : k0[0][c], send = b4 ? k0[0][c] : k0[1][c]; k1[c] = keep + __shfl_xor(send, 16); }
#pragma unroll
        for (int c = 0; c < 4; ++c) {
#pragma unroll
            for (int o = 8; o >= 1; o >>= 1) k1[c] += __shfl_xor(k1[c], o); }
        f32x4 v; v.x = k1[0]; v.y = k1[1]; v.z = k1[2]; v.w = k1[3];
        if ((lane & 15) == 0) q.quad(MP + 4 * wave + (lane >> 4), 4 * qd, v);
    }
}
template <class Q> DI void gemm_all_p_sn(ldsp lds, const bf16_t* A, const bf16_t* Bt, int N, const Q& q, const bf16_t* Xs, const float* mod, int sh_off, int sc_off) {
    pg8::Gemm g{A, Bt, MP, N, 1024};
    pg8::StaticOrder S; S.init(MP, N, (int)gridDim.x, (int)blockIdx.x);
    EpiWrapP<Q> E{q};
    pg8::gemm_phase<EpiWrapP<Q>, pg8::StaticOrder, false>(lds, g, S, E, nullptr);
    sample_tail_norm(Xs, mod, sh_off, sc_off, Bt, N, q);
}
DI void gemm_upgate(ldsp lds, const bf16_t* A, const bf16_t* Bt, const EpiUpGate& E, const QUpS& qs, const bf16_t* Xs, const float* mod, int sh_off, int sc_off) {
    pg8::Gemm g{A, Bt, MP, F2, 1024};
    pg8::StaticOrder S; S.init(MP, F2, (int)gridDim.x, (int)blockIdx.x);
    pg8::gemm_phase<EpiUpGate, pg8::StaticOrder, false>(lds, g, S, E, nullptr);
    sample_tail_norm(Xs, mod, sh_off, sc_off, Bt, F2, qs);
}
DI void gemm_res_fused(ldsp lds, const bf16_t* A, const bf16_t* Bt, int K, const EpiResFused& E) {
    pg8::Gemm g{A, Bt, MP, 1024, K};
    pg8::StaticOrder S; S.init(MP, 1024, (int)gridDim.x, (int)blockIdx.x);
    pg8::gemm_phase<EpiResFused, pg8::StaticOrder, false>(lds, g, S, E, nullptr);
    sample_tail(A + (size_t)MP * K, Bt, 1024, K, E);
}
template <class Q> DI void gemm_all_p(ldsp lds, const bf16_t* A, const bf16_t* Bt, int N, int K, const Q& q) {
    pg8::Gemm g{A, Bt, MP, N, K};
    pg8::StaticOrder S; S.init(MP, N, (int)gridDim.x, (int)blockIdx.x);
    EpiWrapP<Q> E{q};
    pg8::gemm_phase<EpiWrapP<Q>, pg8::StaticOrder, false>(lds, g, S, E, nullptr);
    sample_tail(A + (size_t)MP * K, Bt, N, K, q);
}
template <class Q> DI void gemm_all(ldsp lds, const bf16_t* A, const bf16_t* Bt, int N, int K, const Q& q) {
    pg8::Gemm g{A, Bt, MP, N, K};
    pg8::StaticOrder S; S.init(MP, N, (int)gridDim.x, (int)blockIdx.x);
    EpiWrap<Q> E{q};
    pg8::gemm_phase<EpiWrap<Q>, pg8::StaticOrder, false>(lds, g, S, E, nullptr);
    sample_tail(A + (size_t)MP * K, Bt, N, K, q);
}
DI void copy_share(const Params& p, int lo, int hi) {
    const int half = (int)gridDim.x >> 1;
    if ((int)blockIdx.x >= half) { copy_items(p, lo, hi, (int)blockIdx.x - half, (int)gridDim.x - half);
#if COPY_TWICE
        copy_items(p, lo, hi, (int)blockIdx.x - half, (int)gridDim.x - half);
#endif
    }
}

struct QInE {
    bf16_t* Z; float *wk_p, *wv_p, *wk_s, *wv_s;
    DI void quad(int row, int col, f32x4 v) const {
        if (col < 1024) { v.x = gelu_tanh(v.x); v.y = gelu_tanh(v.y); v.z = gelu_tanh(v.z); v.w = gelu_tanh(v.w); }
        store_bf16x4(Z + (size_t)row * NIE + col, v);
        if (col >= 1536) *(f32x4*)((col < 2048 ? wk_s : wv_s) + ((size_t)(row - MP) * 2048 + 2047) * 512 + ((col - 1536) & 511)) = v;
    }
    DI void oct(int row, int col, f32x4 a, f32x4 b) const {
        if (col < 1024) { a.x = gelu_tanh(a.x); a.y = gelu_tanh(a.y); a.z = gelu_tanh(a.z); a.w = gelu_tanh(a.w); b.x = gelu_tanh(b.x); b.y = gelu_tanh(b.y); b.z = gelu_tanh(b.z); b.w = gelu_tanh(b.w); }
        u32x4 o; o.x = pk2(a.x, a.y); o.y = pk2(a.z, a.w); o.z = pk2(b.x, b.y); o.w = pk2(b.z, b.w);
        *(u32x4*)(Z + (size_t)row * NIE + col) = o;
        if (col >= 1536 && (row & 2048)) {
            float* dst = (col < 2048 ? wk_p : wv_p) + ((size_t)((row >> 12) * 2048 + (row & 2047))) * 512 + ((col - 1536) & 511);
            *(f32x4*)dst = a; *(f32x4*)(dst + 4) = b;
        }
    }
};
struct QRes {
    const float *rp, *rs; float* X; const float* g;
    DI void quad(int row, int col, f32x4 v) const {
        const float* r = row < MP ? rp + (size_t)row * DM : rs + (size_t)(row - MP) * DM;
        const f32x4 x = *(const f32x4*)(r + col), gg = *(const f32x4*)(g + (size_t)bidx_of(row) * 6144 + col);
        *(f32x4*)(X + (size_t)row * DM + col) = x + gg * v;
    }
};
struct QUp {
    bf16_t* UP;
    DI void quad(int row, int col, f32x4 v) const { store_bf16x4(UP + (size_t)row * F2 + col, v); }
    DI void oct(int row, int col, f32x4 a, f32x4 b) const {
        u32x4 o; o.x = pk2(a.x, a.y); o.y = pk2(a.z, a.w); o.z = pk2(b.x, b.y); o.w = pk2(b.z, b.w);
        *(u32x4*)(UP + (size_t)row * F2 + col) = o;
    }
};
struct QInO {
    bf16_t* ZO;
    DI void quad(int row, int col, f32x4 v) const {
        if (col < 1024) { v.x = gelu_tanh(v.x); v.y = gelu_tanh(v.y); v.z = gelu_tanh(v.z); v.w = gelu_tanh(v.w); }
        store_bf16x4(ZO + (size_t)row * 2048 + col, v);
    }
    DI void oct(int row, int col, f32x4 a, f32x4 b) const {
        if (col < 1024) { a.x = gelu_tanh(a.x); a.y = gelu_tanh(a.y); a.z = gelu_tanh(a.z); a.w = gelu_tanh(a.w); b.x = gelu_tanh(b.x); b.y = gelu_tanh(b.y); b.z = gelu_tanh(b.z); b.w = gelu_tanh(b.w); }
        u32x4 o; o.x = pk2(a.x, a.y); o.y = pk2(a.z, a.w); o.z = pk2(b.x, b.y); o.w = pk2(b.z, b.w);
        *(u32x4*)(ZO + (size_t)row * 2048 + col) = o;
    }
};

constexpr float SC_LOG2E = 0.125f * 1.4426950408889634f;
DI void attn_item(const bf16_t* Z, bf16_t* OP, float* LSE, int item, ldsp lds) {
    const int pat = item >> 9, rem = item & 511, b = rem >> 7, hd = (rem >> 4) & 7, blk = rem & 15;
    const int d = pat == 0 ? 1 : (pat == 1 ? 4 : 16);
    const int r = pat == 0 ? 0 : (pat == 1 ? (blk >> 2) : blk), mblk = pat == 0 ? blk : (pat == 1 ? (blk & 3) : 0);
    const int w = threadIdx.x >> 6, lane = threadIdx.x & 63, ql = lane & 31, hf = lane >> 5;
    const int m0 = mblk * 256 + 32 * w;
    const bf16_t* Zb = Z + (size_t)(b * SEQ + r) * NIE;
    const size_t vs = (size_t)d * NIE;
    bf16x8 qf[4];
    { const bf16_t* qrow = Zb + (size_t)(m0 + ql) * vs + 1024 + hd * 64 + 8 * hf;
#pragma unroll
      for (int s = 0; s < 4; ++s) qf[s] = *(const bf16x8*)(qrow + 16 * s); }
    f32x16 o0, o1;
#pragma unroll
    for (int i = 0; i < 16; ++i) { o0[i] = 0.f; o1[i] = 0.f; }
    float mrun = -1e30f, lrun = 0.f;
    ldsp vimg = lds + w * 4608;
    const unsigned vaddr = (unsigned)(size_t)vimg;
    const int i16 = lane & 15, tq = i16 >> 2, tp = i16 & 3, tb = (lane >> 4) & 1;
    const unsigned traddr = vaddr + (4 * hf + tq) * 144 + tb * 32 + 8 * tp;
    const int mq = m0 + ql;
    const int jt_first = m0 >= 128 ? 0 : (128 - m0) >> 5;
    bf16x8 kf[4], kn[4]; u32x4 vt[4], vn[4];
    { const int kt0 = m0 - 128 + 32 * jt_first;
      const bf16_t* krow = Zb + (size_t)(kt0 + ql) * vs + 1536 + hd * 64 + 8 * hf;
#pragma unroll
      for (int s = 0; s < 4; ++s) kn[s] = *(const bf16x8*)(krow + 16 * s);
#pragma unroll
      for (int i = 0; i < 4; ++i) vn[i] = *(const u32x4*)(Zb + (size_t)(kt0 + 8 * i + (lane >> 3)) * vs + 2048 + hd * 64 + (lane & 7) * 8); }
    for (int jt = jt_first; jt < 5; ++jt) {
        const int kt0 = m0 - 128 + 32 * jt;
#pragma unroll
        for (int s = 0; s < 4; ++s) kf[s] = kn[s];
#pragma unroll
        for (int i = 0; i < 4; ++i) vt[i] = vn[i];
        if (jt < 4) {
            const int kt1 = kt0 + 32;
            const bf16_t* krow = Zb + (size_t)(kt1 + ql) * vs + 1536 + hd * 64 + 8 * hf;
#pragma unroll
            for (int s = 0; s < 4; ++s) kn[s] = *(const bf16x8*)(krow + 16 * s);
#pragma unroll
            for (int i = 0; i < 4; ++i) vn[i] = *(const u32x4*)(Zb + (size_t)(kt1 + 8 * i + (lane >> 3)) * vs + 2048 + hd * 64 + (lane & 7) * 8);
        }
        f32x16 st;
#pragma unroll
        for (int i = 0; i < 16; ++i) st[i] = 0.f;
#pragma unroll
        for (int s = 0; s < 4; ++s) st = MFMA32(kf[s], qf[s], st);
        float mx = -1e30f;
        if (jt == 0 || jt == 4) {
#pragma unroll
            for (int i = 0; i < 16; ++i) {
                const int dist = mq - (kt0 + crow(i, hf));
                const float sv = (dist >= 0 && dist <= 128) ? st[i] * SC_LOG2E : -1e30f;
                st[i] = sv; mx = fmaxf(mx, sv);
            }
        } else {
#pragma unroll
            for (int i = 0; i < 16; ++i) { const float sv = st[i] * SC_LOG2E; st[i] = sv; mx = fmaxf(mx, sv); }
        }
        mx = fmaxf(mx, __shfl_xor(mx, 32));
        const float mnew = fmaxf(mrun, mx), alpha = fexp2(mrun - mnew);
        mrun = mnew;
        float psum = 0.f;
#pragma unroll
        for (int i = 0; i < 16; ++i) { const float pv = fexp2(st[i] - mnew); st[i] = pv; psum += pv; }
        lrun = lrun * alpha + psum;
#pragma unroll
        for (int i = 0; i < 16; ++i) { o0[i] *= alpha; o1[i] *= alpha; }
#pragma unroll
        for (int i = 0; i < 4; ++i) *(LAS u32x4*)(vimg + (8 * i + (lane >> 3)) * 144 + (lane & 7) * 16) = vt[i];
        asm volatile("s_waitcnt lgkmcnt(0)" ::: "memory");
        const bf16x8 pf0 = pack_step(st, 0), pf1 = pack_step(st, 1);
        {
            s16x4 r0, r1, r2, r3, r4, r5, r6, r7;
            asm volatile("ds_read_b64_tr_b16 %0, %8\n\t"
                         "ds_read_b64_tr_b16 %1, %8 offset:1152\n\t"
                         "ds_read_b64_tr_b16 %2, %8 offset:2304\n\t"
                         "ds_read_b64_tr_b16 %3, %8 offset:3456\n\t"
                         "ds_read_b64_tr_b16 %4, %8 offset:64\n\t"
                         "ds_read_b64_tr_b16 %5, %8 offset:1216\n\t"
                         "ds_read_b64_tr_b16 %6, %8 offset:2368\n\t"
                         "ds_read_b64_tr_b16 %7, %8 offset:3520\n\t"
                         "s_waitcnt lgkmcnt(0)"
                         : "=&v"(r0), "=&v"(r1), "=&v"(r2), "=&v"(r3), "=&v"(r4), "=&v"(r5), "=&v"(r6), "=&v"(r7) : "v"(traddr) : "memory");
            o0 = MFMA32(__builtin_shufflevector(r0, r1, 0, 1, 2, 3, 4, 5, 6, 7), pf0, o0);
            o0 = MFMA32(__builtin_shufflevector(r2, r3, 0, 1, 2, 3, 4, 5, 6, 7), pf1, o0);
            o1 = MFMA32(__builtin_shufflevector(r4, r5, 0, 1, 2, 3, 4, 5, 6, 7), pf0, o1);
            o1 = MFMA32(__builtin_shufflevector(r6, r7, 0, 1, 2, 3, 4, 5, 6, 7), pf1, o1);
        }
    }
    lrun += __shfl_xor(lrun, 32);
    const float inv = 1.f / lrun;
    const size_t token = (size_t)b * SEQ + r + (size_t)d * mq;
    bf16_t* op = OP + ((size_t)pat * MP + token) * 512 + hd * 64;
#pragma unroll
    for (int g4 = 0; g4 < 4; ++g4) {
        f32x4 a, c;
        a.x = o0[4 * g4] * inv; a.y = o0[4 * g4 + 1] * inv; a.z = o0[4 * g4 + 2] * inv; a.w = o0[4 * g4 + 3] * inv;
        c.x = o1[4 * g4] * inv; c.y = o1[4 * g4 + 1] * inv; c.z = o1[4 * g4 + 2] * inv; c.w = o1[4 * g4 + 3] * inv;
        store_bf16x4(op + 8 * g4 + 4 * hf, a);
        store_bf16x4(op + 32 + 8 * g4 + 4 * hf, c);
    }
    if (hf == 0) LSE[((size_t)pat * MP + token) * 8 + hd] = mrun * 0.6931471805599453f + __logf(lrun);
}

DI void sgu_item(const Params& p, const bf16_t* Z, bf16_t* AO, int item, ldsp lds) {
    const int b = item >> 7, c = (item >> 2) & 31, g = item & 3, tid = threadIdx.x;
    const int row0 = b * SEQ + c * 128;
    LAS float* stat = (LAS float*)(lds + 128 * 272);
    const int w = tid >> 6, lane = tid & 63, ql = lane & 31, hf = lane >> 5, tt = w >> 1, dp = w & 1;
    const bf16_t* WS = (const bf16_t*)(p.ws + O_WS_TRIL) + (size_t)(g * 128 + 32 * tt + ql) * 128 + 8 * hf;
    bf16x8 afr[8];
#pragma unroll
    for (int ks = 0; ks < 8; ++ks) afr[ks] = *(const bf16x8*)(WS + 16 * ks);
    bf16_t u0[16], u1[16]; float bsv[16];
#pragma unroll
    for (int i = 0; i < 16; ++i) {
        const int t = 32 * tt + crow(i, hf); const size_t zr = (size_t)(row0 + t) * NIE + g * 128 + 64 * dp + ql;
        u0[i] = Z[zr]; u1[i] = Z[zr + 32]; bsv[i] = p.in[I_BSGU][g * 128 + t];
    }
    {
        const int row = tid >> 2, part = tid & 3;
        const bf16_t* ptr = Z + (size_t)(row0 + row) * NIE + 512 + part * 128;
        float s = 0.f, ss = 0.f;
#pragma unroll
        for (int i = 0; i < 16; ++i) { const bf16x8 v = *(const bf16x8*)(ptr + 8 * i);
#pragma unroll
            for (int j = 0; j < 8; ++j) { const float f = bfs2f(v[j]); s += f; ss += f * f; } }
        s += __shfl_xor(s, 1); s += __shfl_xor(s, 2); ss += __shfl_xor(ss, 1); ss += __shfl_xor(ss, 2);
        const float mu = s * (1.f / 512.f), var = fmaxf(ss * (1.f / 512.f) - mu * mu, 0.f);
        if (part == 0) { stat[row * 2] = mu; stat[row * 2 + 1] = rsqrtf(var + 1e-6f); }
    }
    __syncthreads();
    {
        const int st = tid >> 2, dch = tid & 3;
        const float mu = stat[st * 2], rstd = stat[st * 2 + 1];
        const float* lg = p.in[I_LNG] + g * 128; const float* lb = p.in[I_LNB] + g * 128;
#pragma unroll
        for (int i = 0; i < 4; ++i) {
            const int d0 = dch * 32 + i * 8;
            const bf16x8 v = *(const bf16x8*)(Z + (size_t)(row0 + st) * NIE + 512 + g * 128 + d0);
            const f32x4 g0 = *(const f32x4*)(lg + d0), g1 = *(const f32x4*)(lg + d0 + 4), h0 = *(const f32x4*)(lb + d0), h1 = *(const f32x4*)(lb + d0 + 4);
            const float gv[8] = {g0.x, g0.y, g0.z, g0.w, g1.x, g1.y, g1.z, g1.w}, hv[8] = {h0.x, h0.y, h0.z, h0.w, h1.x, h1.y, h1.z, h1.w};
#pragma unroll
            for (int j = 0; j < 8; ++j) { const float val = (bfs2f(v[j]) - mu) * rstd * gv[j] + hv[j]; *(LAS bf16_t*)(lds + (d0 + j) * 272 + st * 2) = f2bf(val); }
        }
    }
    __syncthreads();
    f32x16 c0, c1;
#pragma unroll
    for (int i = 0; i < 16; ++i) { c0[i] = 0.f; c1[i] = 0.f; }
#pragma unroll
    for (int ks = 0; ks < 8; ++ks) {
        if (ks >= 2 * tt + 2) break;
        const bf16x8 a = afr[ks];
        const bf16x8 b0 = *(LAS bf16x8*)(lds + (64 * dp + ql) * 272 + (16 * ks + 8 * hf) * 2);
        const bf16x8 b1 = *(LAS bf16x8*)(lds + (64 * dp + 32 + ql) * 272 + (16 * ks + 8 * hf) * 2);
        c0 = MFMA32(a, b0, c0); c1 = MFMA32(a, b1, c1);
    }
#pragma unroll
    for (int i = 0; i < 16; ++i) {
        const int t = 32 * tt + crow(i, hf);
        const size_t ar = (size_t)(row0 + t) * DM + g * 128 + 64 * dp + ql;
        AO[ar] = f2bf(bf2f(u0[i]) * (c0[i] + bsv[i]));
        AO[ar + 32] = f2bf(bf2f(u1[i]) * (c1[i] + bsv[i]));
    }
    __syncthreads();
}

DI void sgu_sample_item(const Params& p, const bf16_t* Z, bf16_t* AO, int row) {
    const int lane = threadIdx.x & 63;
    const bf16_t* zr = Z + (size_t)(MP + row) * NIE;
    const bf16x8 vv = *(const bf16x8*)(zr + 512 + lane * 8), uu = *(const bf16x8*)(zr + lane * 8);
    float vals[8]; float s = 0.f, ss = 0.f;
#pragma unroll
    for (int j = 0; j < 8; ++j) { const float f = bfs2f(vv[j]); vals[j] = f; s += f; ss += f * f; }
    s = wave_sum(s); ss = wave_sum(ss);
    const float mu = s * (1.f / 512.f), rstd = rsqrtf(fmaxf(ss * (1.f / 512.f) - mu * mu, 0.f) + 1e-6f);
    const int g = lane >> 4;
    const float w00 = p.in[I_WSGU][(size_t)g * 16384], b0 = p.in[I_BSGU][g * 128];
    float o[8];
#pragma unroll
    for (int j = 0; j < 8; ++j) {
        const int c = lane * 8 + j;
        const float vl = (vals[j] - mu) * rstd * p.in[I_LNG][c] + p.in[I_LNB][c];
        p.out[OUT_CV_S + (size_t)row * 512 + c] = vl;
        o[j] = bfs2f(uu[j]) * (w00 * vl + b0);
    }
    u32x4 ov; ov.x = pk2(o[0], o[1]); ov.y = pk2(o[2], o[3]); ov.z = pk2(o[4], o[5]); ov.w = pk2(o[6], o[7]);
    *(u32x4*)(AO + (size_t)(MP + row) * DM + lane * 8) = ov;
}

DI void attn_sample_item(const Params& p, const bf16_t* Z, bf16_t* AO, int item, ldsp lds) {
    const int bs = item >> 3, hd = item & 7, tid = threadIdx.x, wave = tid >> 6, lane = tid & 63;
    LAS float* sc = (LAS float*)lds; LAS float* red = sc + 512;
    const float* ck = p.in[I_CK] + (size_t)bs * 2048 * 512 + hd * 64;
    const float* cv = p.in[I_CV] + (size_t)bs * 2048 * 512 + hd * 64;
    const bf16_t* zs = Z + (size_t)(MP + bs) * NIE + hd * 64;
    const int piece = lane & 15, sub = lane >> 4;
    __syncthreads();
    f32x4 qv;
    { const bf16_t* qp = zs + 1024 + piece * 4; qv.x = bf2f(qp[0]); qv.y = bf2f(qp[1]); qv.z = bf2f(qp[2]); qv.w = bf2f(qp[3]); }
#pragma unroll
    for (int e0 = wave * 4; e0 < 388; e0 += 32) {
        const int e = e0 + sub, ec = e < 387 ? e : 386;
        const int pat = ec / 129, j = ec - pat * 129, d = pat == 0 ? 1 : (pat == 1 ? 4 : 16);
        f32x4 kk;
        if (j > 0) kk = *(const f32x4*)(ck + (size_t)(2048 - j * d) * 512 + piece * 4);
        else { const bf16_t* kp = zs + 1536 + piece * 4; kk.x = bf2f(kp[0]); kk.y = bf2f(kp[1]); kk.z = bf2f(kp[2]); kk.w = bf2f(kp[3]); }
        float dot = kk.x * qv.x + kk.y * qv.y + kk.z * qv.z + kk.w * qv.w;
        dot += __shfl_xor(dot, 1); dot += __shfl_xor(dot, 2); dot += __shfl_xor(dot, 4); dot += __shfl_xor(dot, 8);
        if (piece == 0 && e < 387) sc[e] = dot * 0.125f;
    }
    __syncthreads();
    float mx = -1e30f;
    for (int i = lane; i < 387; i += 64) mx = fmaxf(mx, sc[i]);
    mx = wave_max(mx);
    float sum = 0.f;
    for (int i = lane; i < 387; i += 64) sum += __expf(sc[i] - mx);
    sum = wave_sum(sum);
    float acc = 0.f;
    {
        float vv[49];
#pragma unroll
        for (int k = 0; k < 49; ++k) {
            const int i = wave + 8 * k, ic = i < 387 ? i : 386;
            const int pat = ic / 129, j = ic - pat * 129, d = pat == 0 ? 1 : (pat == 1 ? 4 : 16);
            vv[k] = j > 0 ? cv[(size_t)(2048 - j * d) * 512 + lane] : bf2f(zs[2048 + lane]);
        }
#pragma unroll
        for (int k = 0; k < 49; ++k) { const int i = wave + 8 * k; if (i < 387) acc += __expf(sc[i] - mx) * vv[k]; }
    }
    red[wave * 64 + lane] = acc;
    __syncthreads();
    if (tid < 64) { float t = 0.f;
#pragma unroll
        for (int ww = 0; ww < 8; ++ww) t += red[ww * 64 + tid];
        AO[(size_t)(MP + bs) * DM + 512 + hd * 64 + tid] = f2bf(t / sum); }
    __syncthreads();
}

constexpr int P3_ATT = 1536, P3_SGU = 512, P3_SATT = 256;
DI void phase3(const Params& p, ldsp lds) {
    const bf16_t* Z = (const bf16_t*)(p.ws + O_Z); bf16_t* AO = (bf16_t*)(p.ws + O_AO);
    bf16_t* OP = (bf16_t*)(p.ws + O_OP); float* LSE = (float*)(p.ws + O_LSE);
    const int x = (int)blockIdx.x & 7, li = (int)blockIdx.x >> 3;
    for (int j = 0; j < 2; ++j) { const int P = (j * 8 + x) * 8 + (li >> 2); sgu_item(p, Z, AO, P * 4 + (li & 3), lds);
#if P3_TWICE == 1
        sgu_item(p, Z, AO, P * 4 + (li & 3), lds);
#endif
    }
    for (int j = 0; j < 6; ++j) { const int G = (j * 8 + x) * 2 + (li >> 4); attn_item(Z, OP, LSE, G * 16 + (li & 15), lds);
#if P3_TWICE == 2
        attn_item(Z, OP, LSE, G * 16 + (li & 15), lds);
#endif
    }
    attn_sample_item(p, Z, AO, (int)blockIdx.x, lds);
    if (blockIdx.x >= 252) sgu_sample_item(p, Z, AO, ((int)blockIdx.x - 252) * 8 + ((int)threadIdx.x >> 6));
}

DI void phase4(const Params& p) {
    const bf16_t* OP = (const bf16_t*)(p.ws + O_OP); const float* LSE = (const float*)(p.ws + O_LSE); bf16_t* AO = (bf16_t*)(p.ws + O_AO);
    const size_t nthr = (size_t)gridDim.x * 512;
#pragma unroll 4
    for (size_t idx = (size_t)blockIdx.x * 512 + threadIdx.x; idx < (size_t)MP * 64; idx += nthr) {
        const size_t token = idx >> 6; const int c8 = (int)(idx & 63), head = c8 >> 3;
        const float l0 = LSE[token * 8 + head], l1 = LSE[((size_t)MP + token) * 8 + head], l2 = LSE[((size_t)2 * MP + token) * 8 + head];
        const float mx = fmaxf(l0, fmaxf(l1, l2));
        float w0 = __expf(l0 - mx), w1 = __expf(l1 - mx), w2 = __expf(l2 - mx);
        const float inv = 1.f / (w0 + w1 + w2); w0 *= inv; w1 *= inv; w2 *= inv;
        const bf16x8 a = *(const bf16x8*)(OP + token * 512 + c8 * 8), b = *(const bf16x8*)(OP + ((size_t)MP + token) * 512 + c8 * 8), c = *(const bf16x8*)(OP + ((size_t)2 * MP + token) * 512 + c8 * 8);
        float o[8];
#pragma unroll
        for (int j = 0; j < 8; ++j) o[j] = w0 * bfs2f(a[j]) + w1 * bfs2f(b[j]) + w2 * bfs2f(c[j]);
        u32x4 ov; ov.x = pk2(o[0], o[1]); ov.y = pk2(o[2], o[3]); ov.z = pk2(o[4], o[5]); ov.w = pk2(o[6], o[7]);
        *(u32x4*)(AO + token * DM + 512 + c8 * 8) = ov;
    }
}

DI void convgate_phase(const Params& p, int l) {
    const bf16_t* UP = (const bf16_t*)(p.ws + O_UP); bf16_t* ACT = (bf16_t*)(p.ws + O_ACT);
    const bf16_t* UPB = (const bf16_t*)(p.ws + O_UP);
    const float* cw = p.in[I_FCW] + (size_t)l * 3 * F2; const float* cb = p.in[I_FCB] + (size_t)l * F2;
    const size_t nthr = (size_t)gridDim.x * 512, gtid = (size_t)blockIdx.x * 512 + threadIdx.x;
    constexpr int NCH = DFF / 8;
    for (size_t u = gtid; u < (size_t)256 * 2 * NCH; u += nthr) {
        const int gi = (int)(u / NCH), ch = (int)(u - (size_t)gi * NCH), c0 = ch * 8, G = gi >> 1, which = gi & 1, row = 64 * G + which;
        const bool first = (row & 4095) < 2 && which == 0 ? true : false;
        const bool seq0 = ((64 * G) & 4095) == 0;
        const bf16_t* prev = UPB + (size_t)((G > 0 ? G - 1 : 0) * 4) * F2; const bf16_t* cur = UPB + (size_t)(G * 4) * F2;
        const bf16_t* r2 = which == 0 ? prev + 0 * F2 : prev + 1 * F2;
        const bf16_t* r1 = which == 0 ? prev + 1 * F2 : cur + 2 * F2;
        const bf16_t* r0 = which == 0 ? cur + 2 * F2 : cur + 3 * F2;
        const bool z2 = seq0, z1 = seq0 && which == 0;
        (void)first;
        const bf16x8 a2 = *(const bf16x8*)(r2 + c0), a1 = *(const bf16x8*)(r1 + c0), a0 = *(const bf16x8*)(r0 + c0);
        const bf16x8 b2 = *(const bf16x8*)(r2 + DFF + c0), b1 = *(const bf16x8*)(r1 + DFF + c0), b0 = *(const bf16x8*)(r0 + DFF + c0);
        float o[8];
#pragma unroll
        for (int j = 0; j < 8; ++j) {
            const float x2a = z2 ? 0.f : bfs2f(a2[j]), x1a = z1 ? 0.f : bfs2f(a1[j]), x2b = z2 ? 0.f : bfs2f(b2[j]), x1b = z1 ? 0.f : bfs2f(b1[j]);
            const float av = cb[c0 + j] + cw[c0 + j] * x2a + cw[F2 + c0 + j] * x1a + cw[2 * F2 + c0 + j] * bfs2f(a0[j]);
            const float bv = cb[DFF + c0 + j] + cw[DFF + c0 + j] * x2b + cw[F2 + DFF + c0 + j] * x1b + cw[2 * F2 + DFF + c0 + j] * bfs2f(b0[j]);
            o[j] = av / (1.f + __expf(-av)) * bv;
        }
        u32x4 ov; ov.x = pk2(o[0], o[1]); ov.y = pk2(o[2], o[3]); ov.z = pk2(o[4], o[5]); ov.w = pk2(o[6], o[7]);
        *(u32x4*)(ACT + (size_t)row * DFF + c0) = ov;
    }
    const float* st = p.in[I_SFC] + (size_t)l * 32 * 2 * F2; float* sto = p.out + OUT_FC_S + (size_t)l * 32 * 2 * F2;
    for (size_t u = gtid; u < (size_t)MS * DFF; u += nthr) {
        const int bs = (int)(u / DFF), c = (int)(u - (size_t)bs * DFF);
        const float* s0 = st + (size_t)(bs * 2) * F2; const float* s1 = s0 + F2;
        const bf16_t* ur = UP + (size_t)(MP + bs) * F2;
        const float av = cb[c] + cw[c] * s0[c] + cw[F2 + c] * s1[c] + cw[2 * F2 + c] * bf2f(ur[c]);
        const float bv = cb[DFF + c] + cw[DFF + c] * s0[DFF + c] + cw[F2 + DFF + c] * s1[DFF + c] + cw[2 * F2 + DFF + c] * bf2f(ur[DFF + c]);
        ACT[(size_t)(MP + bs) * DFF + c] = f2bf(av / (1.f + __expf(-av)) * bv);
        sto[(size_t)(bs * 2) * F2 + c] = s1[c]; sto[(size_t)(bs * 2) * F2 + DFF + c] = s1[DFF + c];
        sto[(size_t)(bs * 2 + 1) * F2 + c] = bf2f(ur[c]); sto[(size_t)(bs * 2 + 1) * F2 + DFF + c] = bf2f(ur[DFF + c]);
    }
    float* stp = p.out + OUT_FC_P + (size_t)l * 4 * 2 * F2;
    for (size_t u = gtid; u < (size_t)4 * 2 * F2; u += nthr) {
        const int bi = (int)(u / F2), c = (int)(u - (size_t)bi * F2), b = bi >> 1, i = bi & 1;
        stp[u] = bf2f(UPB[(size_t)((((b + 1) * SEQ - 1) >> 6) * 4 + i) * F2 + c]);
    }
}

DI void rglru_gate_item(const Params& p, int item, ldsp lds) {
    const int mt = item >> 3, g = item & 7, tid = threadIdx.x;
    const bf16_t* ZO = (const bf16_t*)(p.ws + O_ZO);
    {
        const int chunk = tid & 15, rg = tid >> 4, c0 = g * 128 + chunk * 8;
        float cw[4][8], cb[8];
#pragma unroll
        for (int k = 0; k < 4; ++k) { const f32x4 t0 = *(const f32x4*)(p.in[I_RCW] + k * 1024 + c0), t1 = *(const f32x4*)(p.in[I_RCW] + k * 1024 + c0 + 4);
            cw[k][0] = t0.x; cw[k][1] = t0.y; cw[k][2] = t0.z; cw[k][3] = t0.w; cw[k][4] = t1.x; cw[k][5] = t1.y; cw[k][6] = t1.z; cw[k][7] = t1.w; }
        { const f32x4 t0 = *(const f32x4*)(p.in[I_RCB] + c0), t1 = *(const f32x4*)(p.in[I_RCB] + c0 + 4);
          cb[0] = t0.x; cb[1] = t0.y; cb[2] = t0.z; cb[3] = t0.w; cb[4] = t1.x; cb[5] = t1.y; cb[6] = t1.z; cb[7] = t1.w; }
        if (mt < 64) {
            const int row0 = mt * 256 + rg * 8, t0 = row0 & 4095;
            float p3[8], p2[8], p1[8];
            if (t0 == 0) {
#pragma unroll
                for (int j = 0; j < 8; ++j) p3[j] = p2[j] = p1[j] = 0.f;
            } else {
                const bf16x8 v3 = *(const bf16x8*)(ZO + (size_t)(row0 - 3) * 2048 + 1024 + c0), v2 = *(const bf16x8*)(ZO + (size_t)(row0 - 2) * 2048 + 1024 + c0), v1 = *(const bf16x8*)(ZO + (size_t)(row0 - 1) * 2048 + 1024 + c0);
#pragma unroll
                for (int j = 0; j < 8; ++j) { p3[j] = bfs2f(v3[j]); p2[j] = bfs2f(v2[j]); p1[j] = bfs2f(v1[j]); }
            }
#pragma unroll
            for (int i = 0; i < 8; ++i) {
                const bf16x8 vc = *(const bf16x8*)(ZO + (size_t)(row0 + i) * 2048 + 1024 + c0);
                float o[8];
#pragma unroll
                for (int j = 0; j < 8; ++j) { const float cur = bfs2f(vc[j]); o[j] = cb[j] + cw[0][j] * p3[j] + cw[1][j] * p2[j] + cw[2][j] * p1[j] + cw[3][j] * cur; p3[j] = p2[j]; p2[j] = p1[j]; p1[j] = cur; }
                u32x4 ov; ov.x = pk2(o[0], o[1]); ov.y = pk2(o[2], o[3]); ov.z = pk2(o[4], o[5]); ov.w = pk2(o[6], o[7]);
                *(LAS u32x4*)(lds + (rg * 8 + i) * 272 + chunk * 16) = ov;
            }
        } else {
#pragma unroll
            for (int i = 0; i < 8; ++i) {
                const int rt = rg * 8 + i;
                u32x4 ov; ov.x = ov.y = ov.z = ov.w = 0u;
                if (rt < MS) {
                    const float* st = p.in[I_SRC] + (size_t)rt * 3 * 1024 + c0;
                    const bf16x8 vc = *(const bf16x8*)(ZO + (size_t)(MP + rt) * 2048 + 1024 + c0);
                    float o[8];
#pragma unroll
                    for (int j = 0; j < 8; ++j) o[j] = cb[j] + cw[0][j] * st[j] + cw[1][j] * st[1024 + j] + cw[2][j] * st[2048 + j] + cw[3][j] * bfs2f(vc[j]);
                    ov.x = pk2(o[0], o[1]); ov.y = pk2(o[2], o[3]); ov.z = pk2(o[4], o[5]); ov.w = pk2(o[6], o[7]);
                    float* so = p.out + OUT_RC_S + (size_t)rt * 3 * 1024 + c0;
#pragma unroll
                    for (int j = 0; j < 8; ++j) { so[j] = st[1024 + j]; so[1024 + j] = st[2048 + j]; so[2048 + j] = bfs2f(vc[j]); }
                }
                *(LAS u32x4*)(lds + rt * 272 + chunk * 16) = ov;
            }
        }
    }
    __syncthreads();
    const int w = tid >> 6, lane = tid & 63, ql = lane & 31, hf = lane >> 5;
    bf16x8 af[8];
#pragma unroll
    for (int ks = 0; ks < 8; ++ks) af[ks] = *(LAS bf16x8*)(lds + (32 * w + ql) * 272 + (16 * ks + 8 * hf) * 2);
    const bf16_t* WG = (const bf16_t*)(p.ws + O_WT_GA) + (size_t)(g * 256 + ql) * 128 + 8 * hf;
    unsigned* HP = (unsigned*)(p.ws + O_AA); float* AGP = (float*)(p.ws + O_BB); float* AGH = AGP + 512 * 1024; bf16_t* Y = (bf16_t*)(p.ws + O_AO);
    for (int n = 0; n < 4; ++n) {
        f32x16 ar, ai;
#pragma unroll
        for (int i = 0; i < 16; ++i) { ar[i] = 0.f; ai[i] = 0.f; }
#pragma unroll
        for (int ks = 0; ks < 8; ++ks) {
            const bf16x8 br = *(const bf16x8*)(WG + (size_t)(32 * n) * 128 + 16 * ks), bi = *(const bf16x8*)(WG + (size_t)(32 * (n + 4)) * 128 + 16 * ks);
            ar = MFMA32(af[ks], br, ar); ai = MFMA32(af[ks], bi, ai);
        }
        const int o = 32 * n + ql, col = g * 128 + o;
        const float ba = p.in[I_RBA][col], bx = p.in[I_RBX][col], lam = p.in[I_RLAM][col];
        const float sp8 = 8.f * 1.4426950408889634f * log1pf(__expf(-lam));
        float av[16], bv[16];
#pragma unroll
        for (int i = 0; i < 16; ++i) {
            const int rt = 32 * w + crow(i, hf);
            const float r = fsigmoid(ar[i] + ba), ig = fsigmoid(ai[i] + bx);
            const float la2 = -(r * sp8), a = fexp2(la2);
            const float em = fmaxf(1.f - a * a, 0.f);
            const float xcv = bf2f(*(LAS bf16_t*)(lds + rt * 272 + o * 2));
            av[i] = a; bv[i] = __builtin_amdgcn_sqrtf(em) * (ig * xcv);
        }
        if (mt < 64) {
            float gP[4], gH[4];
#pragma unroll
            for (int q = 0; q < 4; ++q) { float h = 0.f, P = 1.f;
#pragma unroll
                for (int j = 0; j < 4; ++j) { const int i = 4 * q + j; h = av[i] * h + bv[i]; P *= av[i]; bv[i] = h; av[i] = P; }
                gP[q] = P; gH[q] = h; }
            float Hc = 0.f, Pc = 1.f;
#pragma unroll
            for (int q = 0; q < 4; ++q) {
                const float oP = __shfl_xor(gP[q], 32), oH = __shfl_xor(gH[q], 32);
                const float P0 = hf ? oP : gP[q], H0 = hf ? oH : gH[q], P1 = hf ? gP[q] : oP, H1 = hf ? gH[q] : oH;
                const float mid = P0 * Hc + H0;
                const float inH = hf ? mid : Hc, inP = hf ? P0 * Pc : Pc;
#pragma unroll
                for (int j = 0; j < 4; ++j) { const int i = 4 * q + j; bv[i] += av[i] * inH; av[i] *= inP; }
                Hc = P1 * mid + H1; Pc = P1 * P0 * Pc;
            }
#pragma unroll
            for (int i = 0; i < 16; ++i) HP[(size_t)(mt * 256 + 32 * w + crow(i, hf)) * DM + col] = pk2(bv[i], av[i]);
            if (hf == 0) { LAS float* ag = (LAS float*)(lds + 256 * 272) + (w * 128 + o) * 2; ag[0] = Pc; ag[1] = Hc; }
        } else {
#pragma unroll
            for (int i = 0; i < 16; ++i) {
                const int rt = 32 * w + crow(i, hf);
                if (rt < MS) {
                    const float h = av[i] * p.in[I_SRH][(size_t)rt * 1024 + col] + bv[i];
                    p.out[OUT_RH_S + (size_t)rt * 1024 + col] = h;
                    Y[(size_t)(MP + rt) * DM + col] = f2bf(bf2f(ZO[(size_t)(MP + rt) * 2048 + col]) * h);
                }
            }
        }
    }
    __syncthreads();
    if (mt < 64 && tid < 128) {
        const LAS float* ag = (const LAS float*)(lds + 256 * 272);
        float cP = 1.f, cH = 0.f; const int col = g * 128 + tid;
#pragma unroll
        for (int ww = 0; ww < 8; ++ww) {
            AGP[(size_t)(mt * 8 + ww) * 1024 + col] = cP; AGH[(size_t)(mt * 8 + ww) * 1024 + col] = cH;
            const float P = ag[(ww * 128 + tid) * 2], Hh = ag[(ww * 128 + tid) * 2 + 1];
            cH = P * cH + Hh; cP *= P;
        }
        float* TP = AGP + 2 * 512 * 1024; TP[(size_t)mt * 1024 + col] = cP; TP[(size_t)(64 + mt) * 1024 + col] = cH;
    }
    __syncthreads();
}

DI void rglru_sample_item(const Params& p, int g, ldsp lds) {
    const int tid = threadIdx.x;
    const bf16_t* ZO = (const bf16_t*)(p.ws + O_ZO);
    if (tid < 512) {
        const int chunk = tid & 15, rt = tid >> 4, c0 = g * 128 + chunk * 8;
        const float* st = p.in[I_SRC] + (size_t)rt * 3 * 1024 + c0;
        const bf16x8 vc = *(const bf16x8*)(ZO + (size_t)(MP + rt) * 2048 + 1024 + c0);
        float o[8];
#pragma unroll
        for (int j = 0; j < 8; ++j) o[j] = p.in[I_RCB][c0 + j] + p.in[I_RCW][c0 + j] * st[j] + p.in[I_RCW][1024 + c0 + j] * st[1024 + j] + p.in[I_RCW][2048 + c0 + j] * st[2048 + j] + p.in[I_RCW][3072 + c0 + j] * bfs2f(vc[j]);
        u32x4 ov; ov.x = pk2(o[0], o[1]); ov.y = pk2(o[2], o[3]); ov.z = pk2(o[4], o[5]); ov.w = pk2(o[6], o[7]);
        *(LAS u32x4*)(lds + rt * 272 + chunk * 16) = ov;
        float* so = p.out + OUT_RC_S + (size_t)rt * 3 * 1024 + c0;
#pragma unroll
        for (int j = 0; j < 8; ++j) { so[j] = st[1024 + j]; so[1024 + j] = st[2048 + j]; so[2048 + j] = bfs2f(vc[j]); }
    }
    __syncthreads();
    const int n = tid >> 6, lane = tid & 63, ql = lane & 31, hf = lane >> 5;
    if (n < 4) {
        const bf16_t* WG = (const bf16_t*)(p.ws + O_WT_GA) + (size_t)(g * 256 + ql) * 128 + 8 * hf;
        f32x16 ar, ai;
#pragma unroll
        for (int i = 0; i < 16; ++i) { ar[i] = 0.f; ai[i] = 0.f; }
#pragma unroll
        for (int ks = 0; ks < 8; ++ks) {
            const bf16x8 af = *(LAS bf16x8*)(lds + ql * 272 + (16 * ks + 8 * hf) * 2);
            const bf16x8 br = *(const bf16x8*)(WG + (size_t)(32 * n) * 128 + 16 * ks), bi = *(const bf16x8*)(WG + (size_t)(32 * (n + 4)) * 128 + 16 * ks);
            ar = MFMA32(af, br, ar); ai = MFMA32(af, bi, ai);
        }
        const int o = 32 * n + ql, col = g * 128 + o;
        const float ba = p.in[I_RBA][col], bx = p.in[I_RBX][col], lam = p.in[I_RLAM][col];
        const float sp8 = 8.f * 1.4426950408889634f * log1pf(__expf(-lam));
        bf16_t* Y = (bf16_t*)(p.ws + O_AO);
#pragma unroll
        for (int i = 0; i < 16; ++i) {
            const int rt = crow(i, hf);
            const float r = fsigmoid(ar[i] + ba), ig = fsigmoid(ai[i] + bx);
            const float la2 = -(r * sp8), a = fexp2(la2), y = la2 * (2.f * 0.6931471805599453f);
            const float em = y > -0.1f ? -y * (1.f + y * (0.5f + y * (0.16666667f + y * (0.041666668f + y * 0.0083333333f)))) : 1.f - a * a;
            const float xcv = bf2f(*(LAS bf16_t*)(lds + rt * 272 + o * 2));
            const float bv = __builtin_amdgcn_sqrtf(em) * (ig * xcv);
            const float h = a * p.in[I_SRH][(size_t)rt * 1024 + col] + bv;
            p.out[OUT_RH_S + (size_t)rt * 1024 + col] = h;
            Y[(size_t)(MP + rt) * DM + col] = f2bf(bf2f(ZO[(size_t)(MP + rt) * 2048 + col]) * h);
        }
    }
    __syncthreads();
}

DI void scan_apply(const Params& p, ldsp lds) {
    if (blockIdx.x < 8) rglru_sample_item(p, (int)blockIdx.x, lds);
    const unsigned* HP = (const unsigned*)(p.ws + O_AA); const float* AGP = (const float*)(p.ws + O_BB); const float* AGH = AGP + 512 * 1024;
    const bf16_t* ZO = (const bf16_t*)(p.ws + O_ZO); bf16_t* Y = (bf16_t*)(p.ws + O_AO);
    for (size_t u = (size_t)blockIdx.x * 512 + threadIdx.x; u < (size_t)4 * 3 * 1024; u += (size_t)gridDim.x * 512) {
        const int bi = (int)(u >> 10), c = (int)(u & 1023), b = bi / 3, i = bi - 3 * b;
        p.out[OUT_RC_P + u] = bf2f(ZO[(size_t)(b * SEQ + 4093 + i) * 2048 + 1024 + c]);
    }
    const float* TP = AGP + 2 * 512 * 1024; const float* TH = TP + 64 * 1024;
    for (int chunk = blockIdx.x; chunk < 512; chunk += gridDim.x) {
        const int b = chunk >> 7, mt = chunk >> 3, c4 = (threadIdx.x & 255) * 4, rh = threadIdx.x >> 8;
        f32x4 T = {0.f, 0.f, 0.f, 0.f};
#pragma unroll 4
        for (int j = b * 16; j < mt; ++j) T = *(const f32x4*)(TP + (size_t)j * 1024 + c4) * T + *(const f32x4*)(TH + (size_t)j * 1024 + c4);
        const f32x4 h0 = *(const f32x4*)(AGH + (size_t)chunk * 1024 + c4) + *(const f32x4*)(AGP + (size_t)chunk * 1024 + c4) * T;
        const size_t row0 = (size_t)chunk * 32 + rh * 16;
        u32x4 wv[16]; u32x2 gt[16];
#pragma unroll
        for (int t = 0; t < 16; ++t) { wv[t] = *(const u32x4*)(HP + (row0 + t) * DM + c4); gt[t] = *(const u32x2*)(ZO + (row0 + t) * 2048 + c4); }
#pragma unroll
        for (int t = 0; t < 16; ++t) {
            const float y0 = __uint_as_float(gt[t].x << 16) * (__uint_as_float(wv[t].x << 16) + __uint_as_float(wv[t].x & 0xffff0000u) * h0.x);
            const float y1 = __uint_as_float(gt[t].x & 0xffff0000u) * (__uint_as_float(wv[t].y << 16) + __uint_as_float(wv[t].y & 0xffff0000u) * h0.y);
            const float y2 = __uint_as_float(gt[t].y << 16) * (__uint_as_float(wv[t].z << 16) + __uint_as_float(wv[t].z & 0xffff0000u) * h0.z);
            const float y3 = __uint_as_float(gt[t].y & 0xffff0000u) * (__uint_as_float(wv[t].w << 16) + __uint_as_float(wv[t].w & 0xffff0000u) * h0.w);
            u32x2 o; o.x = pk2(y0, y1); o.y = pk2(y2, y3);
            *(u32x2*)(Y + (row0 + t) * DM + c4) = o;
        }
        if ((chunk & 127) == 127 && rh == 0) *(f32x4*)(p.out + OUT_RH_P + (size_t)b * 1024 + c4) = *(const f32x4*)(TP + (size_t)mt * 1024 + c4) * T + *(const f32x4*)(TH + (size_t)mt * 1024 + c4);
    }
}

DI void run_phase(const Params& p, int ph, ldsp lds, int rep = 0) {
    unsigned char* ws = p.ws;
    float* MOD = (float*)(ws + O_MOD); bf16_t* X = (bf16_t*)(ws + O_X); bf16_t* H = (bf16_t*)(ws + O_H); bf16_t* AO = (bf16_t*)(ws + O_AO);
    float* SLOT = (float*)(ws + O_SLOT); unsigned* CNT = (unsigned*)(ws + O_BAR) + CNT_WORD;
    const float* MOD1 = MOD + 36 * 6144; const bf16_t* Xs = X + (size_t)MP * DM;
    if (gridDim.x != 256) return;
    switch (ph) {
    case 0: phase0(p, lds, rep); break;
    case 1: norm_phase(p.in[I_XP], p.in[I_XS], MOD, 0, 1024, H); break;
    case 2: { QInE q{(bf16_t*)(ws + O_Z), p.out + OUT_WK_P, p.out + OUT_WV_P, p.out + OUT_WK_S, p.out + OUT_WV_S};
              gemm_all_p(lds, H, (const bf16_t*)(ws + O_WT_IN_E), NIE, 1024, q); copy_share(p, 0, 600); } break;
    case 3: phase3(p, lds); break;
    case 4: phase4(p); break;
    case 5: { EpiResFused e{p.in[I_XP], p.in[I_XS], X, MOD + 2048, 0, MOD + 4096, MOD + 3072, H, nullptr, nullptr, SLOT, CNT};
              gemm_res_fused(lds, AO, (const bf16_t*)(ws + O_WT_OUT_E), 1024, e); } break;
    case 7: { EpiUpGate e{(bf16_t*)(ws + O_ACT), (bf16_t*)(ws + O_UP), p.in[I_FCW], p.in[I_FCB]}; QUpS qs{(bf16_t*)(ws + O_UP)};
              gemm_upgate(lds, H, (const bf16_t*)(ws + O_WT_UP), e, qs, Xs, MOD, 3072, 4096); copy_share(p, 600, 1324); } break;
    case 8: convgate_phase(p, 0); break;
    case 9: { EpiResFused e{nullptr, nullptr, X, MOD + 5120, 0, MOD1 + 1024, MOD1 + 0, H, nullptr, nullptr, SLOT + (size_t)4 * MP, CNT + 64};
              gemm_res_fused(lds, (const bf16_t*)(ws + O_ACT), (const bf16_t*)(ws + O_WT_DN), DFF, e); } break;
    case 11: { QInO q{(bf16_t*)(ws + O_ZO)}; gemm_all_p_sn(lds, H, (const bf16_t*)(ws + O_WT_IN_O), 2048, q, Xs, MOD1, 0, 1024); } break;
    case 12: for (int it = blockIdx.x; it < 64 * 8; it += gridDim.x) rglru_gate_item(p, it, lds); break;
    case 13: scan_apply(p, lds); break;
    case 15: { EpiResFused e{nullptr, nullptr, X, MOD1 + 2048, 0, MOD1 + 4096, MOD1 + 3072, H, nullptr, nullptr, SLOT + (size_t)8 * MP, CNT + 128};
               gemm_res_fused(lds, AO, (const bf16_t*)(ws + O_WT_OUT_O), 1024, e); } break;
    case 17: { EpiUpGate e{(bf16_t*)(ws + O_ACT), (bf16_t*)(ws + O_UP), p.in[I_FCW] + (size_t)3 * F2, p.in[I_FCB] + F2}; QUpS qs{(bf16_t*)(ws + O_UP)};
               gemm_upgate(lds, H, (const bf16_t*)(ws + O_WT_UP + SZ_WT_UP), e, qs, Xs, MOD1, 3072, 4096); copy_share(p, 1324, COPY_ITEMS); } break;
    case 18: convgate_phase(p, 1); break;
    case 19: { EpiResFused e{nullptr, nullptr, X, MOD1 + 5120, 1, nullptr, nullptr, nullptr, p.in[I_FING], p.out + OUT_Y_P, SLOT + (size_t)12 * MP, CNT + 192};
               gemm_res_fused(lds, (const bf16_t*)(ws + O_ACT), (const bf16_t*)(ws + O_WT_DN + SZ_WT_DN), DFF, e); } break;
    case 20: final_norm_samples(X, p.in[I_FING], p.out + OUT_Y_S); break;
    default: break;
    }
}

__global__ void __launch_bounds__(512, 2) fwd_mega(Params p, int ph_lo, int ph_hi) {
    extern __shared__ __attribute__((aligned(16))) unsigned char shm[];
    ldsp lds = (ldsp)shm;
    cg::grid_group grid = cg::this_grid();
    const bool fused = (ph_hi - ph_lo) > 1;
    volatile LAS unsigned* st = (volatile LAS unsigned*)(lds + 131072);
    if (threadIdx.x == 0) { st[0] = 0u; st[1] = 0u; st[2] = 0u; st[3] = 0u; }
    __syncthreads();
    XcdBarrier xb; xb.bar = (unsigned*)(p.ws + O_BAR); xb.x = 0; xb.st = st;
    if (fused) xb = xcd_barrier_post((unsigned*)(p.ws + O_BAR), st);
    if (ph_hi > 1000) grid.sync();
#define SEAM() xcd_barrier(xb)
#define PHASE(k) if (ph_lo <= (k) && (k) < ph_hi) { run_phase(p, (k), lds); if ((DOUBLE_MASK >> (k)) & 1) { SEAM(); run_phase(p, (k), lds, 1); } if ((k) + 1 < ph_hi) SEAM(); }
    PHASE(0) PHASE(1) PHASE(2) PHASE(3) PHASE(4) PHASE(5) PHASE(7) PHASE(8) PHASE(9)
    PHASE(11) PHASE(12) PHASE(13) PHASE(15) PHASE(17) PHASE(18) PHASE(19) PHASE(20)
#undef SEAM
#undef PHASE
}

extern "C" void kernel_launch(void* const* d_in, const int* in_sizes, int n_in, void* d_out, int out_size, void* d_ws, size_t ws_size, hipStream_t stream) {
    static int grid = 0;
    if (grid == 0) {
        if (n_in != N_IN || (size_t)out_size != OUT_TOTAL || ws_size < WS_NEED) { fprintf(stderr, "kernel_launch: unexpected shapes: n_in %d out %d ws %zu (need %zu)\n", n_in, out_size, ws_size, (size_t)WS_NEED); grid = -1; return; }
        int dev = 0, cus = 0, per_cu = 0;
        hipGetDevice(&dev); hipDeviceGetAttribute(&cus, hipDeviceAttributeMultiprocessorCount, dev);
        if (hipFuncSetAttribute((const void*)fwd_mega, hipFuncAttributeMaxDynamicSharedMemorySize, LDS_BYTES) != hipSuccess) { fprintf(stderr, "kernel_launch: hipFuncSetAttribute failed\n"); grid = -1; return; }
        if (hipOccupancyMaxActiveBlocksPerMultiprocessor(&per_cu, (const void*)fwd_mega, 512, LDS_BYTES) != hipSuccess || per_cu < 1) { fprintf(stderr, "kernel_launch: occupancy query says %d\n", per_cu); per_cu = 1; }
        (void)hipGetLastError();
        grid = cus;
        if (grid > 256) grid = 256;
    }
    if (grid < 0) return;
    Params p{};
    for (int i = 0; i < N_IN; ++i) p.in[i] = (const float*)d_in[i];
    p.out = (float*)d_out; p.ws = (unsigned char*)d_ws;
    if (hipMemsetAsync((unsigned char*)d_ws + O_BAR, 0, BAR_BYTES, stream) != hipSuccess) { fprintf(stderr, "kernel_launch: memset of barrier words failed\n"); return; }
#if MULTI_LAUNCH
    for (int ph = 0; ph < NPH; ++ph) { int lo = ph, hi = ph + 1; hipLaunchKernelGGL(fwd_mega, dim3(grid), dim3(512), LDS_BYTES, stream, p, lo, hi); }
#else
    int lo = 0, hi = NPH;
    void* args[] = {&p, &lo, &hi};
    hipError_t e = hipLaunchCooperativeKernel((const void*)fwd_mega, dim3(grid), dim3(512), args, LDS_BYTES, stream);
    if (e != hipSuccess) fprintf(stderr, "kernel_launch: cooperative launch failed: %s (grid %d)\n", hipGetErrorString(e), grid);
#endif
}
```

```cpp
#include <hip/hip_runtime.h>
#include <hip/hip_cooperative_groups.h>
#include <cstdio>
#include <cstdint>
namespace cg = cooperative_groups;
namespace pg8 {
#define PG8_LAS __attribute__((address_space(3)))
typedef unsigned short bf16_t;
typedef short bf16x8 __attribute__((ext_vector_type(8)));
typedef float f32x4 __attribute__((ext_vector_type(4)));
typedef unsigned u32x4 __attribute__((ext_vector_type(4)));
constexpr int BM = 256, BK = 64, HALF = 128, HTB = HALF * BK * 2  , STAGE_BYTES = 8 * HTB, NXCD = 8, WGM = 8;

__host__ __device__ __forceinline__ int lds_byte(int r, int c) { const int st = (r >> 4) * 2 + (c >> 5), rr = r & 15, cc = c & 31, ob = rr * 64 + cc * 2; return st * 1024 + (ob ^ (((ob >> 9) & 1) << 5)); }
__host__ __device__ __forceinline__ void stage_rc(int b, int& R, int& C) { const int st = b / 1024, sb = b % 1024, swz = sb ^ (((sb >> 9) & 1) << 5); R = (st >> 1) * 16 + swz / 64; C = (st & 1) * 32 + (swz % 64) / 2; }
__host__ __device__ __forceinline__ int perm32(int rho) { const int n = rho >> 4, i = rho & 15; return 8 * (i >> 2) + 4 * n + (i & 3); }

struct Unit { int pm, pn; };
struct Gemm { const bf16_t* A; const bf16_t* Bt; int M, N, K; };

struct StaticOrder {
    int nM, nN, nwg, G, c;
    __host__ __device__ void init(int M, int N, int G_, int c_) { nM = M / BM; nN = N / BM; nwg = nM * nN; G = G_; c = c_; }
    __host__ __device__ bool next(int i, Unit& u) const {
        const long L = (long)i * G + c; if (L >= nwg) return false;
        int wgid = (int)L; { const int q = nwg / NXCD, r = nwg % NXCD, xcd = wgid % NXCD, off = wgid / NXCD; wgid = (xcd < r ? xcd * (q + 1) : r * (q + 1) + (xcd - r) * q) + off; }
        const int nig = WGM * nN, gid = wgid / nig, fm = gid * WGM, gsz = (nM - fm) < WGM ? (nM - fm) : WGM;
        u.pm = fm + ((wgid % nig) % gsz); u.pn = (wgid % nig) / gsz; return true;
    }
    __device__ __forceinline__ void a_ready(const Unit&) const {}
    __device__ __forceinline__ void done(const Unit&) const {}
};
__device__ __forceinline__ unsigned cvt_pk_bf16(float lo, float hi) { unsigned r; asm volatile("v_cvt_pk_bf16_f32 %0, %1, %2" : "=v"(r) : "v"(lo), "v"(hi)); return r; }
template <class Epi, class Sched, bool STAMP = false>
__device__ __forceinline__ void gemm_phase(PG8_LAS unsigned char* lds, const Gemm g, const Sched& S, const Epi& E, unsigned long long* stamps) {
    const int tid = threadIdx.x, wid = __builtin_amdgcn_readfirstlane(tid >> 6), lane = tid & 63, wr = wid >> 2, wc = wid & 3, fr = lane & 15, fq = lane >> 4;
    const int K = g.K, nt = K / BK;
    int ts_lo = 0, ts_hi = 0, nts = 0; const unsigned long long rt_entry = STAMP ? (unsigned long long)wall_clock64() : 0ull;
#define PG8_STAMP() do { if (STAMP && wid == 0 && nts < 64) { const unsigned long long _c = (unsigned long long)clock64(); \
        ts_lo = (lane == nts) ? (int)(unsigned)_c : ts_lo; ts_hi = (lane == nts) ? (int)(unsigned)(_c >> 32) : ts_hi; ++nts; } } while (0)
    PG8_STAMP();
    unsigned voffA[2], voffB[2];
#pragma unroll
    for (int i = 0; i < 2; ++i) { int R, C; stage_rc(tid * 16 + i * 8192, R, C); const int Rb = Epi::PERM ? ((R & ~31) + perm32(R & 31)) : R;
        voffA[i] = (unsigned)(R * K + C) * 2u; voffB[i] = (unsigned)(Rb * K + C) * 2u; }
    const size_t kstep = (size_t)(BK * 2);
    const size_t hstep = (size_t)HALF * K * 2;
    const size_t tstep = 2 * hstep;
    const unsigned ldsw = (unsigned)wid * 1024u;
    const int aoff = lds_byte(wr * 64 + fr, fq * 8), boff = lds_byte(wc * 32 + fr, fq * 8);
#define PG8_SA(b, h) (((b) * 2 + (h)) * HTB)
#define PG8_SB(b, h) ((4 + (b) * 2 + (h)) * HTB)
#define PG8_STAGE(bufoff, gbase, voff) do { _Pragma("unroll") for (int _i = 0; _i < 2; ++_i) \
        __builtin_amdgcn_global_load_lds((const unsigned*)((const char*)(gbase) + (voff)[_i]), (PG8_LAS unsigned*)(lds + (bufoff) + ldsw + _i * 8192), 16, 0, 0); } while (0)
#define PG8_LDA(dst, b, h) do { _Pragma("unroll") for (int m = 0; m < 4; ++m) _Pragma("unroll") for (int k = 0; k < 2; ++k) dst[m][k] = *(const PG8_LAS bf16x8*)(lds + PG8_SA(b, h) + aoff + m * 2048 + k * 1024); } while (0)
#define PG8_LDB(dst, b, h) do { _Pragma("unroll") for (int n = 0; n < 2; ++n) _Pragma("unroll") for (int k = 0; k < 2; ++k) dst[n][k] = *(const PG8_LAS bf16x8*)(lds + PG8_SB(b, h) + boff + n * 2048 + k * 1024); } while (0)
#define PG8_MMA(ai, bj, At, Bt) do { __builtin_amdgcn_s_setprio(1); _Pragma("unroll") for (int m = 0; m < 4; ++m) _Pragma("unroll") for (int n = 0; n < 2; ++n) _Pragma("unroll") for (int k = 0; k < 2; ++k) \
        acc[ai][bj][m][n] = __builtin_amdgcn_mfma_f32_16x16x32_bf16(Bt[n][k], At[m][k], acc[ai][bj][m][n], 0, 0, 0); __builtin_amdgcn_s_setprio(0); } while (0)
#define PG8_WAIT_V(n) asm volatile("s_waitcnt vmcnt(" #n ")" ::: "memory")
#define PG8_WAIT_L(n) asm volatile("s_waitcnt lgkmcnt(" #n ")" ::: "memory")
#define PG8_BAR __builtin_amdgcn_s_barrier()
#define PG8_SCHED __builtin_amdgcn_sched_barrier(0)
    Unit cur, nxt; int ui = 0;
    if (!S.next(0, cur)) return;
    f32x4 acc[2][2][4][2];
#pragma unroll
    for (int a = 0; a < 2; ++a)
#pragma unroll
        for (int b = 0; b < 2; ++b)
#pragma unroll
            for (int m = 0; m < 4; ++m)
#pragma unroll
                for (int n = 0; n < 2; ++n) acc[a][b][m][n] = (f32x4){0.f, 0.f, 0.f, 0.f};
    bf16x8 At[4][2], B0[2][2], B1[2][2];
    const char* cA = (const char*)g.A + (size_t)cur.pm * tstep; const char* cB = (const char*)g.Bt + (size_t)cur.pn * tstep;
    S.a_ready(cur);
    PG8_STAGE(PG8_SB(0, 0), cB, voffB); PG8_STAGE(PG8_SA(0, 0), cA, voffA); PG8_STAGE(PG8_SB(0, 1), cB + hstep, voffB); PG8_STAGE(PG8_SA(0, 1), cA + hstep, voffA);
    if (wr == 1) PG8_BAR;
    PG8_WAIT_V(4); PG8_BAR;
    PG8_STAGE(PG8_SB(1, 0), cB + kstep, voffB); PG8_STAGE(PG8_SA(1, 0), cA + kstep, voffA); PG8_STAGE(PG8_SB(1, 1), cB + hstep + kstep, voffB);
    PG8_WAIT_V(6); PG8_BAR;
    PG8_STAMP();
    for (;;) {
        const bool has_next = S.next(ui + 1, nxt);
        const char* nA = has_next ? (const char*)g.A + (size_t)nxt.pm * tstep : cA; const char* nB = has_next ? (const char*)g.Bt + (size_t)nxt.pn * tstep : cB;
        for (int t = 0; t < nt; t += 2) {
            const bool last = (t == nt - 2);
            const char* a1 = cA + (size_t)(t + 1) * kstep;
            const char* a2 = last ? nA : cA + (size_t)(t + 2) * kstep; const char* b2 = last ? nB : cB + (size_t)(t + 2) * kstep;
            const char* a3 = a2 + kstep; const char* b3 = b2 + kstep;
            if (last && has_next) S.a_ready(nxt);
            PG8_LDB(B0, 0, 0); PG8_SCHED; PG8_LDA(At, 0, 0); PG8_STAGE(PG8_SA(1, 1), a1 + hstep, voffA);
            PG8_WAIT_L(8); PG8_BAR; PG8_WAIT_L(0); PG8_MMA(0, 0, At, B0); PG8_BAR; PG8_SCHED;
            PG8_LDB(B1, 0, 1); PG8_STAGE(PG8_SB(0, 0), b2, voffB);
            PG8_BAR; PG8_WAIT_L(0); PG8_MMA(0, 1, At, B1); PG8_BAR;
            PG8_LDA(At, 0, 1); PG8_STAGE(PG8_SA(0, 0), a2, voffA);
            PG8_BAR; PG8_WAIT_L(0); PG8_MMA(1, 0, At, B0); PG8_BAR; PG8_SCHED;
            PG8_STAGE(PG8_SB(0, 1), b2 + hstep, voffB);
            PG8_WAIT_V(6); PG8_BAR; PG8_MMA(1, 1, At, B1); PG8_BAR;
            PG8_LDB(B0, 1, 0); PG8_SCHED; PG8_LDA(At, 1, 0); PG8_STAGE(PG8_SA(0, 1), a2 + hstep, voffA);
            PG8_WAIT_L(8); PG8_BAR; PG8_WAIT_L(0); PG8_MMA(0, 0, At, B0); PG8_BAR; PG8_SCHED;
            PG8_LDB(B1, 1, 1); PG8_STAGE(PG8_SB(1, 0), b3, voffB);
            PG8_BAR; PG8_WAIT_L(0); PG8_MMA(0, 1, At, B1); PG8_BAR;
            PG8_LDA(At, 1, 1); PG8_STAGE(PG8_SA(1, 0), a3, voffA);
            PG8_BAR; PG8_WAIT_L(0); PG8_MMA(1, 0, At, B0); PG8_BAR; PG8_SCHED;
            PG8_STAGE(PG8_SB(1, 1), b3 + hstep, voffB);
            PG8_WAIT_V(6); PG8_BAR; PG8_MMA(1, 1, At, B1); PG8_BAR;
        }
        PG8_STAMP();
        if constexpr (!Epi::AFTER_DRAIN) { E(acc, cur, wr, wc, fr, fq); S.done(cur); }
        PG8_STAMP();
        if (!has_next) break;
#pragma unroll
        for (int a = 0; a < 2; ++a)
#pragma unroll
            for (int b = 0; b < 2; ++b)
#pragma unroll
                for (int m = 0; m < 4; ++m)
#pragma unroll
                    for (int n = 0; n < 2; ++n) acc[a][b][m][n] = (f32x4){0.f, 0.f, 0.f, 0.f};
        cur = nxt; cA = nA; cB = nB; ++ui;
    }
    PG8_WAIT_V(0);
    if (wr == 0) PG8_BAR;
    PG8_BAR;
    if constexpr (Epi::AFTER_DRAIN) { E.fused(acc, cur, wr, wc, fr, fq, lds, wid, lane); S.done(cur); }
    PG8_STAMP();
    if (STAMP && wid == 0) { stamps[lane] = lane < nts ? (((unsigned long long)(unsigned)ts_hi << 32) | (unsigned)ts_lo) : 0ull;
        if (lane == 62) stamps[62] = rt_entry; if (lane == 63) stamps[63] = (unsigned long long)wall_clock64(); }
#undef PG8_STAMP
#undef PG8_SA
#undef PG8_SB
#undef PG8_STAGE
#undef PG8_LDA
#undef PG8_LDB
#undef PG8_MMA
#undef PG8_WAIT_V
#undef PG8_WAIT_L
#undef PG8_BAR
#undef PG8_SCHED
}
}
#define LAS __attribute__((address_space(3)))

#define XB_TMO      128
#define XB_XCNT(j)  (256  + 64 * (j))
#define XB_XSUB(j)  (1280 + 64 * (j))
#define XB_XGEN(j)  (2304 + 64 * (j))
#define XB_TOP      3328
#define XB_TOPGEN   3392
#define XCD_BAR_WORDS 3456
#define XB_SPIN_CAP (1u << 18)

__device__ __forceinline__ unsigned xb_ld(unsigned* p)              { return __hip_atomic_load(p, __ATOMIC_RELAXED, __HIP_MEMORY_SCOPE_AGENT); }
__device__ __forceinline__ unsigned xb_add(unsigned* p, unsigned v) { return __hip_atomic_fetch_add(p, v, __ATOMIC_RELAXED, __HIP_MEMORY_SCOPE_AGENT); }
__device__ __forceinline__ unsigned xb_xcc_id() { return (unsigned)__builtin_amdgcn_s_getreg((3 << 11) | 20) & 0xFu; }
#define XB_SPIN(cond, bar) do { unsigned _sp = 0; while (cond) { __builtin_amdgcn_s_sleep(1); \
    if ((++_sp & 255u) == 0u) { if (xb_ld(&(bar)[XB_TMO])) break; if (_sp > XB_SPIN_CAP) { atomicAdd(&(bar)[XB_TMO], 1u); break; } } } } while (0)

struct XcdBarrier {
    unsigned* bar; unsigned x;
    volatile LAS unsigned* st;
};

__device__ __forceinline__ XcdBarrier xcd_barrier_post(unsigned* bar, volatile LAS unsigned* st) {
    XcdBarrier b; b.bar = bar; b.x = xb_xcc_id(); b.st = st;
    if (threadIdx.x == 0) (void)xb_add(&bar[XB_XCNT(b.x)], 1u);
    return b;
}
__device__ __forceinline__ void xcd_barrier_complete(unsigned* bar, unsigned x, unsigned& nloc, unsigned& nx) {
    const unsigned G = gridDim.x * gridDim.y * gridDim.z;
    unsigned sum, cnt, mine, sp = 0u;
    for (;;) {
        sum = 0u; cnt = 0u; mine = 0u;
#pragma unroll
        for (unsigned j = 0; j < 16; ++j) { const unsigned c = xb_ld(&bar[XB_XCNT(j)]); sum += c; cnt += (c > 0u) ? 1u : 0u; mine = (j == x) ? c : mine; }
        if (sum == G) break;
        __builtin_amdgcn_s_sleep(1);
        if ((++sp & 255u) == 0u) { if (xb_ld(&bar[XB_TMO])) break; if (sp > XB_SPIN_CAP) { atomicAdd(&bar[XB_TMO], 1u); break; } }
    }
    nloc = mine > 0u ? mine : 1u; nx = cnt > 0u ? cnt : 1u;
}

__device__ __forceinline__ void xcd_barrier(const XcdBarrier& b) {
    asm volatile("s_waitcnt vmcnt(0)" ::: "memory");
    __syncthreads();
    if (threadIdx.x == 0) {
        unsigned* bar = b.bar;
        __builtin_amdgcn_s_waitcnt(0);
        unsigned nloc = b.st[0], nx = b.st[1];
        if (nloc == 0u) { xcd_barrier_complete(bar, b.x, nloc, nx); b.st[0] = nloc; b.st[1] = nx; }
        const unsigned old = xb_add(&bar[XB_XSUB(b.x)], 1u);
        const unsigned gen = old / nloc;
        if (old + 1u == (gen + 1u) * nloc) {
            __builtin_amdgcn_fence(__ATOMIC_RELEASE, "agent");
            asm volatile("s_waitcnt vmcnt(0)" ::: "memory");
            const unsigned og = xb_add(&bar[XB_TOP], 1u);
            const unsigned tg = og / nx;
            if (og + 1u == (tg + 1u) * nx) xb_add(&bar[XB_TOPGEN], 1u);
            else XB_SPIN(xb_ld(&bar[XB_TOPGEN]) == tg, bar);
            __builtin_amdgcn_fence(__ATOMIC_ACQUIRE, "agent");
            xb_add(&bar[XB_XGEN(b.x)], 1u);
            asm volatile("s_waitcnt vmcnt(0)" ::: "memory");
        } else {
            XB_SPIN(xb_ld(&bar[XB_XGEN(b.x)]) == gen, bar);
            __builtin_amdgcn_fence(__ATOMIC_ACQUIRE, "agent");
            asm volatile("s_waitcnt vmcnt(0)" ::: "memory");
        }
    }
    __syncthreads();
}
using pg8::bf16_t; using pg8::bf16x8; using pg8::f32x4; using pg8::u32x4;
typedef float f32x16 __attribute__((ext_vector_type(16)));
typedef short s16x4 __attribute__((ext_vector_type(4)));
typedef unsigned u32x2 __attribute__((ext_vector_type(2)));
#define DI __device__ __forceinline__
typedef LAS unsigned char* ldsp;
#define MFMA32(a, b, c) __builtin_amdgcn_mfma_f32_32x32x16_bf16((a), (b), (c), 0, 0, 0)

#ifndef DOUBLE_MASK
#define DOUBLE_MASK 0
#endif
#ifndef COPY_TWICE
#define COPY_TWICE 0
#endif
#ifndef ADA_TWICE
#define ADA_TWICE 0
#endif
#ifndef TR_TWICE
#define TR_TWICE 0
#endif
#ifndef P3_TWICE
#define P3_TWICE 0
#endif
#ifndef MULTI_LAUNCH
#define MULTI_LAUNCH 0
#endif

constexpr int DM = 1024, MP = 16384, MS = 32, MT = MP + MS, SEQ = 4096;
constexpr int NIE = 2560, DFF = 2816, F2 = 5632;
constexpr int NPH = 21;
constexpr int LDS_BYTES = 131072 + 256;

constexpr size_t al256(size_t x) { return (x + 255) & ~(size_t)255; }
constexpr size_t O_WT_IN_E = 0;
constexpr size_t O_WT_OUT_E = O_WT_IN_E + al256((size_t)NIE * DM * 2);
constexpr size_t O_WT_IN_O = O_WT_OUT_E + al256((size_t)DM * DM * 2);
constexpr size_t O_WT_OUT_O = O_WT_IN_O + al256((size_t)2048 * DM * 2);
constexpr size_t O_WT_UP = O_WT_OUT_O + al256((size_t)DM * DM * 2);
constexpr size_t SZ_WT_UP = (size_t)F2 * DM * 2;
constexpr size_t O_WT_DN = O_WT_UP + 2 * SZ_WT_UP;
constexpr size_t SZ_WT_DN = (size_t)DM * DFF * 2;
constexpr size_t O_WT_GA = O_WT_DN + 2 * SZ_WT_DN;
constexpr size_t O_WS_TRIL = O_WT_GA + (size_t)8 * 256 * 128 * 2;
constexpr size_t O_MOD = O_WS_TRIL + (size_t)4 * 128 * 128 * 2;
constexpr size_t O_X = O_MOD + al256((size_t)2 * 36 * 6144 * 4);
constexpr size_t O_H = O_X + (size_t)MT * DM * 4;
constexpr size_t O_AO = O_H + (size_t)MT * DM * 2;
constexpr size_t O_AGG = O_AO + (size_t)MT * DM * 2;
constexpr size_t O_SLOT = O_AGG + (size_t)2 * 4 * 64 * 1024 * 4;
constexpr size_t O_BIG = al256(O_SLOT + (size_t)4 * 4 * MP * 4);
constexpr int CNT_WORD = 3600;
constexpr size_t O_Z = O_BIG;
constexpr size_t O_OP = O_Z + al256((size_t)MT * NIE * 2);
constexpr size_t O_LSE = O_OP + (size_t)3 * MP * 512 * 2;
constexpr size_t O_UP = O_BIG;
constexpr size_t O_ACT = O_UP + al256((size_t)MT * F2 * 2);
constexpr size_t O_ZO = O_BIG;
constexpr size_t O_AA = O_ZO + al256((size_t)MT * 2048 * 2);
constexpr size_t O_BB = O_AA + (size_t)MP * DM * 4;
constexpr size_t O_BAR = al256(O_ACT + (size_t)MT * DFF * 2);
constexpr size_t BAR_BYTES = 16384;
constexpr size_t WS_NEED = O_BAR + BAR_BYTES;

constexpr size_t OUT_Y_P = 0;
constexpr size_t OUT_Y_S = OUT_Y_P + (size_t)MP * DM;
constexpr size_t OUT_WK_P = OUT_Y_S + (size_t)MS * DM;
constexpr size_t OUT_WV_P = OUT_WK_P + (size_t)4 * 2048 * 512;
constexpr size_t OUT_RC_P = OUT_WV_P + (size_t)4 * 2048 * 512;
constexpr size_t OUT_RH_P = OUT_RC_P + (size_t)4 * 3 * 1024;
constexpr size_t OUT_FC_P = OUT_RH_P + (size_t)4 * 1024;
constexpr size_t OUT_CV_S = OUT_FC_P + (size_t)2 * 4 * 2 * F2;
constexpr size_t OUT_WK_S = OUT_CV_S + (size_t)32 * 512;
constexpr size_t OUT_WV_S = OUT_WK_S + (size_t)32 * 2048 * 512;
constexpr size_t OUT_RC_S = OUT_WV_S + (size_t)32 * 2048 * 512;
constexpr size_t OUT_RH_S = OUT_RC_S + (size_t)32 * 3 * 1024;
constexpr size_t OUT_FC_S = OUT_RH_S + (size_t)32 * 1024;
constexpr size_t OUT_TOTAL = OUT_FC_S + (size_t)2 * 32 * 2 * F2;

enum { I_XP = 0, I_XS, I_CK, I_CV, I_SRC, I_SRH, I_SFC, I_CP, I_CS, I_WADA, I_BADA, I_WINE, I_LNG, I_LNB, I_WSGU, I_BSGU, I_WOUTE,
       I_WINO, I_RCW, I_RCB, I_RWA, I_RBA, I_RWX, I_RBX, I_RLAM, I_WOUTO, I_FUP, I_FCW, I_FCB, I_FDN, I_FING, N_IN };

struct Params { const float* in[N_IN]; float* out; unsigned char* ws; };

DI float bf2f(bf16_t b) { return __uint_as_float(((unsigned)b) << 16); }
DI float bfs2f(short b) { return __uint_as_float(((unsigned)(unsigned short)b) << 16); }
DI unsigned pk2(float lo, float hi) { return pg8::cvt_pk_bf16(lo, hi); }
DI bf16_t f2bf(float f) { return (bf16_t)(pk2(f, 0.f) & 0xffffu); }
DI float wave_sum(float v) {
#pragma unroll
    for (int o = 1; o < 64; o <<= 1) v += __shfl_xor(v, o);
    return v;
}
DI float wave_max(float v) {
#pragma unroll
    for (int o = 1; o < 64; o <<= 1) v = fmaxf(v, __shfl_xor(v, o));
    return v;
}
DI float gelu_tanh(float x) {
    const float u2 = (-2.f * 0.7978845608028654f * 1.4426950408889634f) * (x + 0.044715f * x * x * x);
    return x * __builtin_amdgcn_rcpf(1.f + __builtin_amdgcn_exp2f(u2));
}
DI float sigmoidf(float x) { return 1.f / (1.f + __expf(-x)); }
DI float fexp2(float x) { return __builtin_amdgcn_exp2f(x); }
DI float frcp(float x) { return __builtin_amdgcn_rcpf(x); }
DI float fsigmoid(float x) { return frcp(1.f + fexp2(-1.4426950408889634f * x)); }
DI int crow(int reg, int hf) { return (reg & 3) + 8 * (reg >> 2) + 4 * hf; }
DI int bidx_of(int row) { return row < MP ? (row >> 12) : 4 + (row - MP); }
DI void store_bf16x4(bf16_t* p, f32x4 v) { u32x2 o; o.x = pk2(v.x, v.y); o.y = pk2(v.z, v.w); *(u32x2*)p = o; }
DI bf16x8 pack_step(const f32x16& x, int s) {
    u32x4 p;
    p.x = pk2(x[8 * s + 0], x[8 * s + 1]); p.y = pk2(x[8 * s + 2], x[8 * s + 3]); p.z = pk2(x[8 * s + 4], x[8 * s + 5]); p.w = pk2(x[8 * s + 6], x[8 * s + 7]);
    return __builtin_bit_cast(bf16x8, p);
}
DI s16x4 tr_read(unsigned lds_addr) { s16x4 r; asm volatile("ds_read_b64_tr_b16 %0, %1\n\ts_waitcnt lgkmcnt(0)" : "=&v"(r) : "v"(lds_addr) : "memory"); return r; }

DI void transpose_item(const float* __restrict__ W, int K, int N, bf16_t* WT, int item, LAS float* scr, int lane, bool pair_up = false) {
    const int nblk = N >> 5, kb = item / nblk, nb = item - kb * nblk, k0 = 64 * kb, n0 = 32 * nb;
    int r0 = n0; if (pair_up) { const int half = n0 >= DFF ? 1 : 0, chn = n0 - half * DFF; r0 = 256 * (chn >> 7) + 128 * half + (chn & 127); }
    float tv[32];
#pragma unroll
    for (int i = 0; i < 32; ++i) tv[i] = W[(size_t)(k0 + 2 * i + (lane >> 5)) * N + n0 + (lane & 31)];
#pragma unroll
    for (int i = 0; i < 32; ++i) scr[(2 * i + (lane >> 5)) * 33 + (lane & 31)] = tv[i];
    asm volatile("s_waitcnt lgkmcnt(0)" ::: "memory");
    const int c = lane & 7;
#pragma unroll
    for (int j = 0; j < 4; ++j) { const int n = (lane >> 3) + 8 * j; const LAS float* sp = scr + (8 * c) * 33 + n;
        u32x4 o; o.x = pk2(sp[0 * 33], sp[1 * 33]); o.y = pk2(sp[2 * 33], sp[3 * 33]); o.z = pk2(sp[4 * 33], sp[5 * 33]); o.w = pk2(sp[6 * 33], sp[7 * 33]);
        *(u32x4*)(WT + (size_t)(r0 + n) * K + k0 + 8 * c) = o; }
    asm volatile("s_waitcnt lgkmcnt(0)" ::: "memory");
}

DI void adaln_item(const Params& p, int item, ldsp lds) {
    const int qr = item & 3, l = (item >> 2) / 96, j0 = ((item >> 2) % 96) * 64, tid = threadIdx.x, w = tid >> 6, lane = tid & 63;
    LAS float* s = (LAS float*)lds;
    LAS float* part = (LAS float*)(lds + 9 * 1024 * 4);
    const float* W = p.in[I_WADA] + (size_t)l * 1024 * 6144;
    float* MOD = (float*)(p.ws + O_MOD);
    for (int idx = tid; idx < 9 * 1024; idx += 512) {
        const int r = idx >> 10, k = idx & 1023, rr = qr * 9 + r;
        const float c = rr < 4 ? p.in[I_CP][rr * 1024 + k] : p.in[I_CS][(rr - 4) * 1024 + k];
        s[idx] = c / (1.f + __expf(-c));
    }
    __syncthreads();
    float acc[9];
#pragma unroll
    for (int r = 0; r < 9; ++r) acc[r] = 0.f;
    const int kbase = w * 128;
    for (int k = 0; k < 128; k += 32) {
        float wv[32];
#pragma unroll
        for (int i = 0; i < 32; ++i) wv[i] = W[(size_t)(kbase + k + i) * 6144 + j0 + lane];
#pragma unroll
        for (int i = 0; i < 32; i += 4) {
#pragma unroll
            for (int r = 0; r < 9; ++r) { const f32x4 sv = *(LAS f32x4*)(s + r * 1024 + kbase + k + i); acc[r] += sv.x * wv[i] + sv.y * wv[i + 1] + sv.z * wv[i + 2] + sv.w * wv[i + 3]; }
        }
    }
#pragma unroll
    for (int r = 0; r < 9; ++r) part[(w * 9 + r) * 64 + lane] = acc[r];
    __syncthreads();
    for (int idx = tid; idx < 9 * 64; idx += 512) {
        const int r = idx >> 6, j = idx & 63; float sum = 0.f;
#pragma unroll
        for (int ww = 0; ww < 8; ++ww) sum += part[(ww * 9 + r) * 64 + j];
        MOD[(size_t)(l * 36 + qr * 9 + r) * 6144 + j0 + j] = sum + p.in[I_BADA][l * 6144 + j0 + j];
    }
    __syncthreads();
}

constexpr int P0_ADA = 768;
constexpr int T_INE = 16 * 80, T_OUTE = 16 * 32, T_INO = 16 * 64, T_OUTO = 16 * 32, T_UP = 16 * 176, T_DN = 44 * 32, T_G = 2 * 4;
constexpr int P0_TR = T_INE + T_OUTE + T_INO + T_OUTO + 2 * T_UP + 2 * T_DN + 16 * T_G;
constexpr int P0_TRIL = 16;
constexpr int P0_WITEMS = P0_TR + P0_TRIL;
constexpr int CTR_WORD = 3584;

DI void p0_wave_item(const Params& p, int r, LAS float* scr, int lane) {
    unsigned char* ws = p.ws;
    if (r < T_INE) { transpose_item(p.in[I_WINE], 1024, NIE, (bf16_t*)(ws + O_WT_IN_E), r, scr, lane); return; } r -= T_INE;
    if (r < T_OUTE) { transpose_item(p.in[I_WOUTE], 1024, 1024, (bf16_t*)(ws + O_WT_OUT_E), r, scr, lane); return; } r -= T_OUTE;
    if (r < T_INO) { transpose_item(p.in[I_WINO], 1024, 2048, (bf16_t*)(ws + O_WT_IN_O), r, scr, lane); return; } r -= T_INO;
    if (r < T_OUTO) { transpose_item(p.in[I_WOUTO], 1024, 1024, (bf16_t*)(ws + O_WT_OUT_O), r, scr, lane); return; } r -= T_OUTO;
    if (r < 2 * T_UP) { const int l = r / T_UP; transpose_item(p.in[I_FUP] + (size_t)l * 1024 * F2, 1024, F2, (bf16_t*)(ws + O_WT_UP + l * SZ_WT_UP), r - l * T_UP, scr, lane, true); return; } r -= 2 * T_UP;
    if (r < 2 * T_DN) { const int l = r / T_DN; transpose_item(p.in[I_FDN] + (size_t)l * DFF * 1024, DFF, 1024, (bf16_t*)(ws + O_WT_DN + l * SZ_WT_DN), r - l * T_DN, scr, lane); return; } r -= 2 * T_DN;
    if (r < 16 * T_G) { const int which = r / (8 * T_G), rr = r % (8 * T_G), g = rr / T_G, ti = rr % T_G;
        transpose_item(p.in[which ? I_RWX : I_RWA] + (size_t)g * 128 * 128, 128, 128, (bf16_t*)(ws + O_WT_GA) + (size_t)(g * 256 + which * 128) * 128, ti, scr, lane); return; }
    r -= 16 * T_G;
    {
        const int g = r >> 2, q = r & 3;
        bf16_t* dst = (bf16_t*)(ws + O_WS_TRIL) + (size_t)g * 16384 + q * 4096; const float* src = p.in[I_WSGU] + (size_t)g * 16384 + q * 4096;
        for (int idx = lane; idx < 4096; idx += 64) { const int t = q * 32 + (idx >> 7), sidx = idx & 127; dst[idx] = f2bf(sidx <= t ? src[idx] : 0.f); }
    }
}

DI void phase0(const Params& p, ldsp lds, int rep) {
    for (int it = blockIdx.x; it < P0_ADA; it += gridDim.x) adaln_item(p, it, lds);
#if ADA_TWICE
    for (int it = blockIdx.x; it < P0_ADA; it += gridDim.x) adaln_item(p, it, lds);
#endif
    const int wave = threadIdx.x >> 6, lane = threadIdx.x & 63;
    LAS float* scr = (LAS float*)(lds + wave * 8448);
    for (int it = wave * (int)gridDim.x + (int)blockIdx.x; it < P0_WITEMS; it += 8 * (int)gridDim.x) p0_wave_item(p, it, scr, lane);
#if TR_TWICE
    for (int it = wave * (int)gridDim.x + (int)blockIdx.x; it < P0_WITEMS; it += 8 * (int)gridDim.x) p0_wave_item(p, it, scr, lane);
#endif
}

constexpr int COPY_ITEMS = 2048;
DI void copy_items(const Params& p, int lo, int hi, int first, int stride) {
    constexpr int PER_B = 2047 * 128;
    for (int r = lo + first; r < hi; r += 2 * stride) {
        const int r2 = r + stride; const bool two = r2 < hi;
        const int wb0 = r >> 5, rb0 = r & 31, wb1 = (two ? r2 : r) >> 5, rb1 = (two ? r2 : r) & 31;
        const f32x4* s0 = (const f32x4*)(p.in[(wb0 >> 5) ? I_CV : I_CK] + (size_t)(wb0 & 31) * 2048 * 512 + 512) + rb0 * 8192 + threadIdx.x;
        f32x4* d0 = (f32x4*)(p.out + ((wb0 >> 5) ? OUT_WV_S : OUT_WK_S) + (size_t)(wb0 & 31) * 2048 * 512) + rb0 * 8192 + threadIdx.x;
        const f32x4* s1 = (const f32x4*)(p.in[(wb1 >> 5) ? I_CV : I_CK] + (size_t)(wb1 & 31) * 2048 * 512 + 512) + rb1 * 8192 + threadIdx.x;
        f32x4* d1 = (f32x4*)(p.out + ((wb1 >> 5) ? OUT_WV_S : OUT_WK_S) + (size_t)(wb1 & 31) * 2048 * 512) + rb1 * 8192 + threadIdx.x;
        const int q0 = rb0 * 8192 + (int)threadIdx.x, q1 = rb1 * 8192 + (int)threadIdx.x;
        f32x4 v0[16], v1[16];
#pragma unroll
        for (int i = 0; i < 16; ++i) if (q0 + i * 512 < PER_B) v0[i] = __builtin_nontemporal_load(s0 + i * 512);
        if (two) {
#pragma unroll
            for (int i = 0; i < 16; ++i) if (q1 + i * 512 < PER_B) v1[i] = __builtin_nontemporal_load(s1 + i * 512);
        }
#pragma unroll
        for (int i = 0; i < 16; ++i) if (q0 + i * 512 < PER_B) __builtin_nontemporal_store(v0[i], d0 + i * 512);
        if (two) {
#pragma unroll
            for (int i = 0; i < 16; ++i) if (q1 + i * 512 < PER_B) __builtin_nontemporal_store(v1[i], d1 + i * 512);
        }
    }
}

DI void norm_phase(const float* xp, const float* xs, const float* mod, int sh_off, int sc_off, bf16_t* H) {
    const int lane = threadIdx.x & 63, gw = blockIdx.x * 8 + (threadIdx.x >> 6), ngw = gridDim.x * 8;
    for (int row0 = gw * 4; row0 < MT; row0 += ngw * 4) {
        f32x4 v[4][4];
#pragma unroll
        for (int r = 0; r < 4; ++r) { const int row = row0 + r; const float* src = row < MP ? xp + (size_t)row * DM : xs + (size_t)(row - MP) * DM;
#pragma unroll
            for (int j = 0; j < 4; ++j) v[r][j] = *((const f32x4*)src + lane + 64 * j); }
        const bool shared = row0 < MP;
        f32x4 scv[4], shv[4];
        if (shared) { const float* mrow = mod + (size_t)(row0 >> 12) * 6144;
#pragma unroll
            for (int j = 0; j < 4; ++j) { scv[j] = *(const f32x4*)(mrow + sc_off + 4 * (lane + 64 * j)); shv[j] = *(const f32x4*)(mrow + sh_off + 4 * (lane + 64 * j)); } }
#pragma unroll
        for (int r = 0; r < 4; ++r) {
            const int row = row0 + r; const float* mrow = mod + (size_t)bidx_of(row) * 6144;
            float ss = 0.f;
#pragma unroll
            for (int j = 0; j < 4; ++j) ss += v[r][j].x * v[r][j].x + v[r][j].y * v[r][j].y + v[r][j].z * v[r][j].z + v[r][j].w * v[r][j].w;
            const float rs = rsqrtf(wave_sum(ss) * (1.f / DM) + 1e-6f);
#pragma unroll
            for (int j = 0; j < 4; ++j) {
                const int col = 4 * (lane + 64 * j);
                f32x4 sc, sh;
                if (shared) { sc = scv[j]; sh = shv[j]; } else { sc = *(const f32x4*)(mrow + sc_off + col); sh = *(const f32x4*)(mrow + sh_off + col); }
                f32x4 h; h.x = v[r][j].x * rs * (1.f + sc.x) + sh.x; h.y = v[r][j].y * rs * (1.f + sc.y) + sh.y; h.z = v[r][j].z * rs * (1.f + sc.z) + sh.z; h.w = v[r][j].w * rs * (1.f + sc.w) + sh.w;
                store_bf16x4(H + (size_t)row * DM + col, h);
            }
        }
    }
}
DI void final_norm_phase(const float* X, const float* g, float* yp, float* ys) {
    const int lane = threadIdx.x & 63, gw = blockIdx.x * 8 + (threadIdx.x >> 6), ngw = gridDim.x * 8;
    f32x4 gg[4];
#pragma unroll
    for (int j = 0; j < 4; ++j) gg[j] = *((const f32x4*)g + lane + 64 * j);
    for (int row0 = gw * 4; row0 < MT; row0 += ngw * 4) {
        f32x4 v[4][4];
#pragma unroll
        for (int r = 0; r < 4; ++r) {
#pragma unroll
            for (int j = 0; j < 4; ++j) v[r][j] = *((const f32x4*)(X + (size_t)(row0 + r) * DM) + lane + 64 * j); }
#pragma unroll
        for (int r = 0; r < 4; ++r) {
            const int row = row0 + r; float* dst = row < MP ? yp + (size_t)row * DM : ys + (size_t)(row - MP) * DM;
            float ss = 0.f;
#pragma unroll
            for (int j = 0; j < 4; ++j) ss += v[r][j].x * v[r][j].x + v[r][j].y * v[r][j].y + v[r][j].z * v[r][j].z + v[r][j].w * v[r][j].w;
            const float rs = rsqrtf(wave_sum(ss) * (1.f / DM) + 1e-6f);
#pragma unroll
            for (int j = 0; j < 4; ++j) *((f32x4*)dst + lane + 64 * j) = v[r][j] * rs * gg[j];
        }
    }
}

DI void final_norm_samples(const bf16_t* X, const float* g, float* ys) {
    const int lane = threadIdx.x & 63, gw = blockIdx.x * 8 + (threadIdx.x >> 6);
    if (gw < MS) {
        const bf16_t* src = X + (size_t)(MP + gw) * DM; f32x4 v[4]; float ss = 0.f;
#pragma unroll
        for (int j = 0; j < 4; ++j) { const u32x2 raw = *((const u32x2*)src + lane + 64 * j);
            v[j].x = __uint_as_float(raw.x << 16); v[j].y = __uint_as_float(raw.x & 0xffff0000u); v[j].z = __uint_as_float(raw.y << 16); v[j].w = __uint_as_float(raw.y & 0xffff0000u);
            ss += v[j].x * v[j].x + v[j].y * v[j].y + v[j].z * v[j].z + v[j].w * v[j].w; }
        const float rs = rsqrtf(wave_sum(ss) * (1.f / DM) + 1e-6f);
#pragma unroll
        for (int j = 0; j < 4; ++j) *((f32x4*)(ys + (size_t)gw * DM) + lane + 64 * j) = v[j] * rs * *((const f32x4*)g + lane + 64 * j);
    }
}

template <class Q> struct EpiWrap {
    static constexpr bool PERM = false, AFTER_DRAIN = false;
    Q q;
    DI void operator()(const f32x4 (&acc)[2][2][4][2], const pg8::Unit& u, int wr, int wc, int fr, int fq) const {
#pragma unroll
        for (int ai = 0; ai < 2; ++ai)
#pragma unroll
            for (int m = 0; m < 4; ++m) {
                const int row = u.pm * 256 + ai * 128 + wr * 64 + m * 16 + fr;
#pragma unroll
                for (int bj = 0; bj < 2; ++bj)
#pragma unroll
                    for (int n = 0; n < 2; ++n) q.quad(row, u.pn * 256 + bj * 128 + wc * 32 + n * 16 + 4 * fq, acc[ai][bj][m][n]);
            }
    }
};

struct EpiResFused {
    static constexpr bool PERM = false, AFTER_DRAIN = true;
    const float *rp, *rsm; bf16_t* X; const float* g;
    int mode;
    const float *sc, *sh; bf16_t* H; const float* fg; float* Y;
    float* slots; unsigned* cnt;
    DI void fused(f32x4 (&acc)[2][2][4][2], const pg8::Unit& u, int wr, int wc, int fr, int fq, ldsp lds, int wid, int lane) const {
        LAS float* part = (LAS float*)lds; LAS float* rsv = part + 1024;
        const size_t mb = (size_t)(u.pm >> 4) * 6144;
        f32x4 ggv[2][2];
#pragma unroll
        for (int bj = 0; bj < 2; ++bj)
#pragma unroll
            for (int n = 0; n < 2; ++n) ggv[bj][n] = *(const f32x4*)(g + mb + u.pn * 256 + bj * 128 + wc * 32 + n * 16 + 4 * fq);
#pragma unroll
        for (int ai = 0; ai < 2; ++ai)
#pragma unroll
            for (int m = 0; m < 4; ++m) {
                const int rl = ai * 128 + wr * 64 + m * 16 + fr, row = u.pm * 256 + rl;
                float ss = 0.f;
#pragma unroll
                for (int bj = 0; bj < 2; ++bj)
#pragma unroll
                    for (int n = 0; n < 2; ++n) {
                        const int col = u.pn * 256 + bj * 128 + wc * 32 + n * 16 + 4 * fq;
                        f32x4 x;
                        if (rp) x = *(const f32x4*)(rp + (size_t)row * DM + col);
                        else { const u32x2 raw = *(const u32x2*)(X + (size_t)row * DM + col); x.x = __uint_as_float(raw.x << 16); x.y = __uint_as_float(raw.x & 0xffff0000u); x.z = __uint_as_float(raw.y << 16); x.w = __uint_as_float(raw.y & 0xffff0000u); }
                        const f32x4 xn = x + ggv[bj][n] * acc[ai][bj][m][n];
                        acc[ai][bj][m][n] = xn;
                        if (mode == 0) store_bf16x4(X + (size_t)row * DM + col, xn);
                        ss += xn.x * xn.x + xn.y * xn.y + xn.z * xn.z + xn.w * xn.w;
                    }
                ss += __shfl_xor(ss, 16); ss += __shfl_xor(ss, 32);
                if (fq == 0) part[wc * 256 + rl] = ss;
            }
        __syncthreads();
        const int tid = threadIdx.x;
        if (tid < 256) __hip_atomic_store(slots + (size_t)u.pn * MP + u.pm * 256 + tid, (part[tid] + part[256 + tid]) + (part[512 + tid] + part[768 + tid]), __ATOMIC_RELAXED, __HIP_MEMORY_SCOPE_AGENT);
        asm volatile("s_waitcnt vmcnt(0)" ::: "memory");
        __syncthreads();
        if (tid == 0) {
            __hip_atomic_fetch_add(cnt + u.pm, 1u, __ATOMIC_RELAXED, __HIP_MEMORY_SCOPE_AGENT);
            unsigned spins = 0;
            while (__hip_atomic_load(cnt + u.pm, __ATOMIC_RELAXED, __HIP_MEMORY_SCOPE_AGENT) < 4u) { __builtin_amdgcn_s_sleep(1); if (++spins > (1u << 22)) break; }
        }
        __syncthreads();
        if (tid < 256) {
            const float* sp = slots + u.pm * 256 + tid;
            const float t0 = __hip_atomic_load(sp, __ATOMIC_RELAXED, __HIP_MEMORY_SCOPE_AGENT), t1 = __hip_atomic_load(sp + MP, __ATOMIC_RELAXED, __HIP_MEMORY_SCOPE_AGENT);
            const float t2 = __hip_atomic_load(sp + 2 * MP, __ATOMIC_RELAXED, __HIP_MEMORY_SCOPE_AGENT), t3 = __hip_atomic_load(sp + 3 * MP, __ATOMIC_RELAXED, __HIP_MEMORY_SCOPE_AGENT);
            rsv[tid] = rsqrtf(((t0 + t1) + (t2 + t3)) * (1.f / DM) + 1e-6f);
        }
        __syncthreads();
        f32x4 m1[2][2], m0[2][2];
#pragma unroll
        for (int bj = 0; bj < 2; ++bj)
#pragma unroll
            for (int n = 0; n < 2; ++n) {
                const int col = u.pn * 256 + bj * 128 + wc * 32 + n * 16 + 4 * fq;
                if (mode == 0) { m1[bj][n] = *(const f32x4*)(sc + mb + col) + 1.f; m0[bj][n] = *(const f32x4*)(sh + mb + col); }
                else { m1[bj][n] = *(const f32x4*)(fg + col); m0[bj][n] = (f32x4){0.f, 0.f, 0.f, 0.f}; }
            }
#pragma unroll
        for (int ai = 0; ai < 2; ++ai)
#pragma unroll
            for (int m = 0; m < 4; ++m) {
                const int rl = ai * 128 + wr * 64 + m * 16 + fr, row = u.pm * 256 + rl;
                const float r = rsv[rl];
#pragma unroll
                for (int bj = 0; bj < 2; ++bj)
#pragma unroll
                    for (int n = 0; n < 2; ++n) {
                        const int col = u.pn * 256 + bj * 128 + wc * 32 + n * 16 + 4 * fq;
                        const f32x4 xn = acc[ai][bj][m][n];
                        if (mode == 0) store_bf16x4(H + (size_t)row * DM + col, xn * r * m1[bj][n] + m0[bj][n]);
                        else *(f32x4*)(Y + (size_t)row * DM + col) = xn * r * m1[bj][n];
                    }
            }
        __syncthreads();
    }
    DI void quad(int row, int col, f32x4 v) const {
        f32x4 x;
        if (rsm) x = *(const f32x4*)(rsm + (size_t)(row - MP) * DM + col);
        else { const u32x2 raw = *(const u32x2*)(X + (size_t)row * DM + col); x.x = __uint_as_float(raw.x << 16); x.y = __uint_as_float(raw.x & 0xffff0000u); x.z = __uint_as_float(raw.y << 16); x.w = __uint_as_float(raw.y & 0xffff0000u); }
        const f32x4 gg = *(const f32x4*)(g + (size_t)bidx_of(row) * 6144 + col);
        store_bf16x4(X + (size_t)row * DM + col, x + gg * v);
    }
};

struct EpiUpGate {
    static constexpr bool PERM = true, AFTER_DRAIN = false;
    bf16_t* ACT; bf16_t* UPB; const float* cw; const float* cb;
    static DI float ror1(float v) { return __builtin_bit_cast(float, __builtin_amdgcn_update_dpp(0, __builtin_bit_cast(int, v), 0x121, 0xf, 0xf, false)); }
    static DI float ror2(float v) { return __builtin_bit_cast(float, __builtin_amdgcn_update_dpp(0, __builtin_bit_cast(int, v), 0x122, 0xf, 0xf, false)); }
    static DI float shr1(float old, float v) { return __builtin_bit_cast(float, __builtin_amdgcn_update_dpp(__builtin_bit_cast(int, old), __builtin_bit_cast(int, v), 0x111, 0xf, 0xf, false)); }
    static DI float shr2(float old, float v) { return __builtin_bit_cast(float, __builtin_amdgcn_update_dpp(__builtin_bit_cast(int, old), __builtin_bit_cast(int, v), 0x112, 0xf, 0xf, false)); }
    DI void operator()(const f32x4 (&acc)[2][2][4][2], const pg8::Unit& u, int wr, int wc, int fr, int fq) const {
        const int ch0 = 128 * u.pn + 32 * wc + 8 * fq;
        u32x4 pk[2][4]; float ev[2][4];
#pragma unroll
        for (int n = 0; n < 2; ++n) {
#pragma unroll
            for (int c = 0; c < 4; ++c) {
                const int ch = ch0 + 4 * n + c;
                const float wa0 = cw[ch], wa1 = cw[F2 + ch], wa2 = cw[2 * F2 + ch], ba = cb[ch];
                const float wb0 = cw[DFF + ch], wb1 = cw[F2 + DFF + ch], wb2 = cw[2 * F2 + DFF + ch], bb = cb[DFF + ch];
#pragma unroll
                for (int ai = 0; ai < 2; ++ai) {
                    float q1a = 0.f, q2a = 0.f, q1b = 0.f, q2b = 0.f;
#pragma unroll
                    for (int m = 0; m < 4; ++m) {
                        const float va = acc[ai][0][m][n][c], vb = acc[ai][1][m][n][c];
                        const float p1a = shr1(q1a, va), p2a = shr2(q2a, va), p1b = shr1(q1b, vb), p2b = shr2(q2b, vb);
                        if (m < 3) { q1a = ror1(va); q2a = ror2(va); q1b = ror1(vb); q2b = ror2(vb); }
                        const float ya = ba + wa0 * p2a + wa1 * p1a + wa2 * va;
                        const float yb = bb + wb0 * p2b + wb1 * p1b + wb2 * vb;
                        const float act = ya * __builtin_amdgcn_rcpf(1.f + __builtin_amdgcn_exp2f(-1.4426950408889634f * ya)) * yb;
                        if (c == 0 || c == 2) ev[ai][m] = act;
                        else if (n == 0 && c == 1) pk[ai][m].x = pk2(ev[ai][m], act);
                        else if (n == 0 && c == 3) pk[ai][m].y = pk2(ev[ai][m], act);
                        else if (n == 1 && c == 1) pk[ai][m].z = pk2(ev[ai][m], act);
                        else pk[ai][m].w = pk2(ev[ai][m], act);
                    }
                }
            }
        }
#pragma unroll
        for (int ai = 0; ai < 2; ++ai)
#pragma unroll
            for (int m = 0; m < 4; ++m) {
                const int row = u.pm * 256 + ai * 128 + wr * 64 + m * 16 + fr;
                if (!(m == 0 && fr < 2)) *(u32x4*)(ACT + (size_t)row * DFF + ch0) = pk[ai][m];
                if ((m == 3 && fr >= 14) || (m == 0 && fr < 2)) {
                    const int slot = m == 3 ? fr - 14 : 2 + fr;
                    bf16_t* hb = UPB + (size_t)((row >> 6) * 4 + slot) * F2;
                    store_bf16x4(hb + ch0, acc[ai][0][m][0]); store_bf16x4(hb + ch0 + 4, acc[ai][0][m][1]);
                    store_bf16x4(hb + DFF + ch0, acc[ai][1][m][0]); store_bf16x4(hb + DFF + ch0 + 4, acc[ai][1][m][1]);
                }
            }
    }
};
struct QUpS {
    bf16_t* UP;
    DI void quad(int row, int pcol, f32x4 v) const {
        const int within = pcol & 255, col = (within >> 7) * DFF + 128 * (pcol >> 8) + (within & 127);
        store_bf16x4(UP + (size_t)row * F2 + col, v);
    }
};

template <class Q> struct EpiWrapP {
    static constexpr bool PERM = true, AFTER_DRAIN = false;
    Q q;
    DI void operator()(const f32x4 (&acc)[2][2][4][2], const pg8::Unit& u, int wr, int wc, int fr, int fq) const {
#pragma unroll
        for (int ai = 0; ai < 2; ++ai)
#pragma unroll
            for (int m = 0; m < 4; ++m) {
                const int row = u.pm * 256 + ai * 128 + wr * 64 + m * 16 + fr;
#pragma unroll
                for (int bj = 0; bj < 2; ++bj) q.oct(row, u.pn * 256 + bj * 128 + wc * 32 + 8 * fq, acc[ai][bj][m][0], acc[ai][bj][m][1]);
            }
    }
};

template <class Q> DI void sample_tail(const bf16_t* As, const bf16_t* Bt, int N, int K, const Q& q) {
    const int wave = threadIdx.x >> 6, lane = threadIdx.x & 63, nch = K >> 3;
    for (int qd = blockIdx.x; qd < (N >> 2); qd += gridDim.x) {
        float s[4][4];
#pragma unroll
        for (int r = 0; r < 4; ++r)
#pragma unroll
            for (int c = 0; c < 4; ++c) s[r][c] = 0.f;
        for (int ch = lane; ch < nch; ch += 64) {
            bf16x8 a[4], w[4];
#pragma unroll
            for (int r = 0; r < 4; ++r) a[r] = *(const bf16x8*)(As + (size_t)(4 * wave + r) * K + ch * 8);
#pragma unroll
            for (int c = 0; c < 4; ++c) w[c] = *(const bf16x8*)(Bt + (size_t)(4 * qd + c) * K + ch * 8);
#pragma unroll
            for (int j = 0; j < 8; ++j) {
                float af[4], wf[4];
#pragma unroll
                for (int r = 0; r < 4; ++r) af[r] = bfs2f(a[r][j]);
#pragma unroll
                for (int c = 0; c < 4; ++c) wf[c] = bfs2f(w[c][j]);
#pragma unroll
                for (int r = 0; r < 4; ++r)
#pragma unroll
                    for (int c = 0; c < 4; ++c) s[r][c] += af[r] * wf[c];
            }
        }
        const bool b5 = (lane & 32) != 0, b4 = (lane & 16) != 0;
        float k0[2][4], k1[4];
#pragma unroll
        for (int rr = 0; rr < 2; ++rr)
#pragma unroll
            for (int c = 0; c < 4; ++c) { const float keep = b5 ? s[2 + rr][c] : s[rr][c], send = b5 ? s[rr][c] : s[2 + rr][c]; k0[rr][c] = keep + __shfl_xor(send, 32); }
#pragma unroll
        for (int c = 0; c < 4; ++c) { const float keep = b4 ? k0[1][c] : k0[0][c], send = b4 ? k0[0][c] : k0[1][c]; k1[c] = keep + __shfl_xor(send, 16); }
#pragma unroll
        for (int c = 0; c < 4; ++c) {
#pragma unroll
            for (int o = 8; o >= 1; o >>= 1) k1[c] += __shfl_xor(k1[c], o); }
        f32x4 v; v.x = k1[0]; v.y = k1[1]; v.z = k1[2]; v.w = k1[3];
        if ((lane & 15) == 0) q.quad(MP + 4 * wave + (lane >> 4), 4 * qd, v);
    }
}

template <class Q> DI void sample_tail_norm(const bf16_t* Xs  , const float* mod  , int sh_off, int sc_off, const bf16_t* Bt, int N, const Q& q) {
    const int wave = threadIdx.x >> 6, lane = threadIdx.x & 63;
    float af[4][16];
#pragma unroll
    for (int r = 0; r < 4; ++r) {
        const int bs = 4 * wave + r; const bf16_t* xr = Xs + (size_t)bs * DM; const float* mr = mod + (size_t)(4 + bs) * 6144;
        f32x4 xv[4]; float ss = 0.f;
#pragma unroll
        for (int it = 0; it < 2; ++it) { const bf16x8 raw = *(const bf16x8*)(xr + (lane + 64 * it) * 8);
            xv[2 * it].x = bfs2f(raw[0]); xv[2 * it].y = bfs2f(raw[1]); xv[2 * it].z = bfs2f(raw[2]); xv[2 * it].w = bfs2f(raw[3]);
            xv[2 * it + 1].x = bfs2f(raw[4]); xv[2 * it + 1].y = bfs2f(raw[5]); xv[2 * it + 1].z = bfs2f(raw[6]); xv[2 * it + 1].w = bfs2f(raw[7]); }
#pragma unroll
        for (int j = 0; j < 4; ++j) ss += xv[j].x * xv[j].x + xv[j].y * xv[j].y + xv[j].z * xv[j].z + xv[j].w * xv[j].w;
        const float rsx = rsqrtf(wave_sum(ss) * (1.f / DM) + 1e-6f);
#pragma unroll
        for (int it = 0; it < 2; ++it)
#pragma unroll
            for (int hh = 0; hh < 2; ++hh) {
                const int k0 = (lane + 64 * it) * 8 + 4 * hh;
                const f32x4 s1 = *(const f32x4*)(mr + sc_off + k0), s0 = *(const f32x4*)(mr + sh_off + k0), xx = xv[2 * it + hh];
                af[r][8 * it + 4 * hh + 0] = xx.x * rsx * (1.f + s1.x) + s0.x; af[r][8 * it + 4 * hh + 1] = xx.y * rsx * (1.f + s1.y) + s0.y;
                af[r][8 * it + 4 * hh + 2] = xx.z * rsx * (1.f + s1.z) + s0.z; af[r][8 * it + 4 * hh + 3] = xx.w * rsx * (1.f + s1.w) + s0.w;
            }
    }
    for (int qd = blockIdx.x; qd < (N >> 2); qd += gridDim.x) {
        float s[4][4];
#pragma unroll
        for (int r = 0; r < 4; ++r)
#pragma unroll
            for (int c = 0; c < 4; ++c) s[r][c] = 0.f;
#pragma unroll
        for (int it = 0; it < 2; ++it) {
            bf16x8 w[4];
#pragma unroll
            for (int c = 0; c < 4; ++c) w[c] = *(const bf16x8*)(Bt + (size_t)(4 * qd + c) * 1024 + (lane + 64 * it) * 8);
#pragma unroll
            for (int j = 0; j < 8; ++j)
#pragma unroll
                for (int c = 0; c < 4; ++c) { const float wf = bfs2f(w[c][j]);
#pragma unroll
                    for (int r = 0; r < 4; ++r) s[r][c] += af[r][8 * it + j] * wf; }
        }
        const bool b5 = (lane & 32) != 0, b4 = (lane & 16) != 0;
        float k0[2][4], k1[4];
#pragma unroll
        for (int rr = 0; rr < 2; ++rr)
#pragma unroll
            for (int c = 0; c < 4; ++c) { const float keep = b5 ? s[2 + rr][c] : s[rr][c], send = b5 ? s[rr][c] : s[2 + rr][c]; k0[rr][c] = keep + __shfl_xor(send, 32); }
#pragma unroll
        for (int c = 0; c < 4; ++c) { const float keep = b4 ? k0[1][c] : k0[0][c], send = b4 ? k0[0][c] : k0[1][c]; k1[c] = keep + __shfl_xor(send, 16); }
#pragma unroll
        for (int c = 0; c < 4; ++c) {
#pragma unroll
            for (int o = 8; o >= 1; o >>= 1) k1[c] += __shfl_xor(k1[c], o); }
        f32x4 v; v.x = k1[0]; v.y = k1[1]; v.z = k1[2]; v.w = k1[3];
        if ((lane & 15) == 0) q.quad(MP + 4 * wave + (lane >> 4), 4 * qd, v);
    }
}
template <class Q> DI void gemm_all_p_sn(ldsp lds, const bf16_t* A, const bf16_t* Bt, int N, const Q& q, const bf16_t* Xs, const float* mod, int sh_off, int sc_off) {
    pg8::Gemm g{A, Bt, MP, N, 1024};
    pg8::StaticOrder S; S.init(MP, N, (int)gridDim.x, (int)blockIdx.x);
    EpiWrapP<Q> E{q};
    pg8::gemm_phase<EpiWrapP<Q>, pg8::StaticOrder, false>(lds, g, S, E, nullptr);
    sample_tail_norm(Xs, mod, sh_off, sc_off, Bt, N, q);
}
DI void gemm_upgate(ldsp lds, const bf16_t* A, const bf16_t* Bt, const EpiUpGate& E, const QUpS& qs, const bf16_t* Xs, const float* mod, int sh_off, int sc_off) {
    pg8::Gemm g{A, Bt, MP, F2, 1024};
    pg8::StaticOrder S; S.init(MP, F2, (int)gridDim.x, (int)blockIdx.x);
    pg8::gemm_phase<EpiUpGate, pg8::StaticOrder, false>(lds, g, S, E, nullptr);
    sample_tail_norm(Xs, mod, sh_off, sc_off, Bt, F2, qs);
}
DI void gemm_res_fused(ldsp lds, const bf16_t* A, const bf16_t* Bt, int K, const EpiResFused& E) {
    pg8::Gemm g{A, Bt, MP, 1024, K};
    pg8::StaticOrder S; S.init(MP, 1024, (int)gridDim.x, (int)blockIdx.x);
    pg8::gemm_phase<EpiResFused, pg8::StaticOrder, false>(lds, g, S, E, nullptr);
    sample_tail(A + (size_t)MP * K, Bt, 1024, K, E);
}
template <class Q> DI void gemm_all_p(ldsp lds, const bf16_t* A, const bf16_t* Bt, int N, int K, const Q& q) {
    pg8::Gemm g{A, Bt, MP, N, K};
    pg8::StaticOrder S; S.init(MP, N, (int)gridDim.x, (int)blockIdx.x);
    EpiWrapP<Q> E{q};
    pg8::gemm_phase<EpiWrapP<Q>, pg8::StaticOrder, false>(lds, g, S, E, nullptr);
    sample_tail(A + (size_t)MP * K, Bt, N, K, q);
}
template <class Q> DI void gemm_all(ldsp lds, const bf16_t* A, const bf16_t* Bt, int N, int K, const Q& q) {
    pg8::Gemm g{A, Bt, MP, N, K};
    pg8::StaticOrder S; S.init(MP, N, (int)gridDim.x, (int)blockIdx.x);
    EpiWrap<Q> E{q};
    pg8::gemm_phase<EpiWrap<Q>, pg8::StaticOrder, false>(lds, g, S, E, nullptr);
    sample_tail(A + (size_t)MP * K, Bt, N, K, q);
}
DI void copy_share(const Params& p, int lo, int hi) {
    const int half = (int)gridDim.x >> 1;
    if ((int)blockIdx.x >= half) { copy_items(p, lo, hi, (int)blockIdx.x - half, (int)gridDim.x - half);
#if COPY_TWICE
        copy_items(p, lo, hi, (int)blockIdx.x - half, (int)gridDim.x - half);
#endif
    }
}

struct QInE {
    bf16_t* Z; float *wk_p, *wv_p, *wk_s, *wv_s;
    DI void quad(int row, int col, f32x4 v) const {
        if (col < 1024) { v.x = gelu_tanh(v.x); v.y = gelu_tanh(v.y); v.z = gelu_tanh(v.z); v.w = gelu_tanh(v.w); }
        store_bf16x4(Z + (size_t)row * NIE + col, v);
        if (col >= 1536) *(f32x4*)((col < 2048 ? wk_s : wv_s) + ((size_t)(row - MP) * 2048 + 2047) * 512 + ((col - 1536) & 511)) = v;
    }
    DI void oct(int row, int col, f32x4 a, f32x4 b) const {
        if (col < 1024) { a.x = gelu_tanh(a.x); a.y = gelu_tanh(a.y); a.z = gelu_tanh(a.z); a.w = gelu_tanh(a.w); b.x = gelu_tanh(b.x); b.y = gelu_tanh(b.y); b.z = gelu_tanh(b.z); b.w = gelu_tanh(b.w); }
        u32x4 o; o.x = pk2(a.x, a.y); o.y = pk2(a.z, a.w); o.z = pk2(b.x, b.y); o.w = pk2(b.z, b.w);
        *(u32x4*)(Z + (size_t)row * NIE + col) = o;
        if (col >= 1536 && (row & 2048)) {
            float* dst = (col < 2048 ? wk_p : wv_p) + ((size_t)((row >> 12) * 2048 + (row & 2047))) * 512 + ((col - 1536) & 511);
            *(f32x4*)dst = a; *(f32x4*)(dst + 4) = b;
        }
    }
};
struct QRes {
    const float *rp, *rs; float* X; const float* g;
    DI void quad(int row, int col, f32x4 v) const {
        const float* r = row < MP ? rp + (size_t)row * DM : rs + (size_t)(row - MP) * DM;
        const f32x4 x = *(const f32x4*)(r + col), gg = *(const f32x4*)(g + (size_t)bidx_of(row) * 6144 + col);
        *(f32x4*)(X + (size_t)row * DM + col) = x + gg * v;
    }
};
struct QUp {
    bf16_t* UP;
    DI void quad(int row, int col, f32x4 v) const { store_bf16x4(UP + (size_t)row * F2 + col, v); }
    DI void oct(int row, int col, f32x4 a, f32x4 b) const {
        u32x4 o; o.x = pk2(a.x, a.y); o.y = pk2(a.z, a.w); o.z = pk2(b.x, b.y); o.w = pk2(b.z, b.w);
        *(u32x4*)(UP + (size_t)row * F2 + col) = o;
    }
};
struct QInO {
    bf16_t* ZO;
    DI void quad(int row, int col, f32x4 v) const {
        if (col < 1024) { v.x = gelu_tanh(v.x); v.y = gelu_tanh(v.y); v.z = gelu_tanh(v.z); v.w = gelu_tanh(v.w); }
        store_bf16x4(ZO + (size_t)row * 2048 + col, v);
    }
    DI void oct(int row, int col, f32x4 a, f32x4 b) const {
        if (col < 1024) { a.x = gelu_tanh(a.x); a.y = gelu_tanh(a.y); a.z = gelu_tanh(a.z); a.w = gelu_tanh(a.w); b.x = gelu_tanh(b.x); b.y = gelu_tanh(b.y); b.z = gelu_tanh(b.z); b.w = gelu_tanh(b.w); }
        u32x4 o; o.x = pk2(a.x, a.y); o.y = pk2(a.z, a.w); o.z = pk2(b.x, b.y); o.w = pk2(b.z, b.w);
        *(u32x4*)(ZO + (size_t)row * 2048 + col) = o;
    }
};

constexpr float SC_LOG2E = 0.125f * 1.4426950408889634f;
DI void attn_item(const bf16_t* Z, bf16_t* OP, float* LSE, int item, ldsp lds) {
    const int pat = item >> 9, rem = item & 511, b = rem >> 7, hd = (rem >> 4) & 7, blk = rem & 15;
    const int d = pat == 0 ? 1 : (pat == 1 ? 4 : 16);
    const int r = pat == 0 ? 0 : (pat == 1 ? (blk >> 2) : blk), mblk = pat == 0 ? blk : (pat == 1 ? (blk & 3) : 0);
    const int w = threadIdx.x >> 6, lane = threadIdx.x & 63, ql = lane & 31, hf = lane >> 5;
    const int m0 = mblk * 256 + 32 * w;
    const bf16_t* Zb = Z + (size_t)(b * SEQ + r) * NIE;
    const size_t vs = (size_t)d * NIE;
    bf16x8 qf[4];
    { const bf16_t* qrow = Zb + (size_t)(m0 + ql) * vs + 1024 + hd * 64 + 8 * hf;
#pragma unroll
      for (int s = 0; s < 4; ++s) qf[s] = *(const bf16x8*)(qrow + 16 * s); }
    f32x16 o0, o1;
#pragma unroll
    for (int i = 0; i < 16; ++i) { o0[i] = 0.f; o1[i] = 0.f; }
    float mrun = -1e30f, lrun = 0.f;
    ldsp vimg = lds + w * 4608;
    const unsigned vaddr = (unsigned)(size_t)vimg;
    const int i16 = lane & 15, tq = i16 >> 2, tp = i16 & 3, tb = (lane >> 4) & 1;
    const unsigned traddr = vaddr + (4 * hf + tq) * 144 + tb * 32 + 8 * tp;
    const int mq = m0 + ql;
    const int jt_first = m0 >= 128 ? 0 : (128 - m0) >> 5;
    bf16x8 kf[4], kn[4]; u32x4 vt[4], vn[4];
    { const int kt0 = m0 - 128 + 32 * jt_first;
      const bf16_t* krow = Zb + (size_t)(kt0 + ql) * vs + 1536 + hd * 64 + 8 * hf;
#pragma unroll
      for (int s = 0; s < 4; ++s) kn[s] = *(const bf16x8*)(krow + 16 * s);
#pragma unroll
      for (int i = 0; i < 4; ++i) vn[i] = *(const u32x4*)(Zb + (size_t)(kt0 + 8 * i + (lane >> 3)) * vs + 2048 + hd * 64 + (lane & 7) * 8); }
    for (int jt = jt_first; jt < 5; ++jt) {
        const int kt0 = m0 - 128 + 32 * jt;
#pragma unroll
        for (int s = 0; s < 4; ++s) kf[s] = kn[s];
#pragma unroll
        for (int i = 0; i < 4; ++i) vt[i] = vn[i];
        if (jt < 4) {
            const int kt1 = kt0 + 32;
            const bf16_t* krow = Zb + (size_t)(kt1 + ql) * vs + 1536 + hd * 64 + 8 * hf;
#pragma unroll
            for (int s = 0; s < 4; ++s) kn[s] = *(const bf16x8*)(krow + 16 * s);
#pragma unroll
            for (int i = 0; i < 4; ++i) vn[i] = *(const u32x4*)(Zb + (size_t)(kt1 + 8 * i + (lane >> 3)) * vs + 2048 + hd * 64 + (lane & 7) * 8);
        }
        f32x16 st;
#pragma unroll
        for (int i = 0; i < 16; ++i) st[i] = 0.f;
#pragma unroll
        for (int s = 0; s < 4; ++s) st = MFMA32(kf[s], qf[s], st);
        float mx = -1e30f;
        if (jt == 0 || jt == 4) {
#pragma unroll
            for (int i = 0; i < 16; ++i) {
                const int dist = mq - (kt0 + crow(i, hf));
                const float sv = (dist >= 0 && dist <= 128) ? st[i] * SC_LOG2E : -1e30f;
                st[i] = sv; mx = fmaxf(mx, sv);
            }
        } else {
#pragma unroll
            for (int i = 0; i < 16; ++i) { const float sv = st[i] * SC_LOG2E; st[i] = sv; mx = fmaxf(mx, sv); }
        }
        mx = fmaxf(mx, __shfl_xor(mx, 32));
        const float mnew = fmaxf(mrun, mx), alpha = fexp2(mrun - mnew);
        mrun = mnew;
        float psum = 0.f;
#pragma unroll
        for (int i = 0; i < 16; ++i) { const float pv = fexp2(st[i] - mnew); st[i] = pv; psum += pv; }
        lrun = lrun * alpha + psum;
#pragma unroll
        for (int i = 0; i < 16; ++i) { o0[i] *= alpha; o1[i] *= alpha; }
#pragma unroll
        for (int i = 0; i < 4; ++i) *(LAS u32x4*)(vimg + (8 * i + (lane >> 3)) * 144 + (lane & 7) * 16) = vt[i];
        asm volatile("s_waitcnt lgkmcnt(0)" ::: "memory");
        const bf16x8 pf0 = pack_step(st, 0), pf1 = pack_step(st, 1);
        {
            s16x4 r0, r1, r2, r3, r4, r5, r6, r7;
            asm volatile("ds_read_b64_tr_b16 %0, %8\n\t"
                         "ds_read_b64_tr_b16 %1, %8 offset:1152\n\t"
                         "ds_read_b64_tr_b16 %2, %8 offset:2304\n\t"
                         "ds_read_b64_tr_b16 %3, %8 offset:3456\n\t"
                         "ds_read_b64_tr_b16 %4, %8 offset:64\n\t"
                         "ds_read_b64_tr_b16 %5, %8 offset:1216\n\t"
                         "ds_read_b64_tr_b16 %6, %8 offset:2368\n\t"
                         "ds_read_b64_tr_b16 %7, %8 offset:3520\n\t"
                         "s_waitcnt lgkmcnt(0)"
                         : "=&v"(r0), "=&v"(r1), "=&v"(r2), "=&v"(r3), "=&v"(r4), "=&v"(r5), "=&v"(r6), "=&v"(r7) : "v"(traddr) : "memory");
            o0 = MFMA32(__builtin_shufflevector(r0, r1, 0, 1, 2, 3, 4, 5, 6, 7), pf0, o0);
            o0 = MFMA32(__builtin_shufflevector(r2, r3, 0, 1, 2, 3, 4, 5, 6, 7), pf1, o0);
            o1 = MFMA32(__builtin_shufflevector(r4, r5, 0, 1, 2, 3, 4, 5, 6, 7), pf0, o1);
            o1 = MFMA32(__builtin_shufflevector(r6, r7, 0, 1, 2, 3, 4, 5, 6, 7), pf1, o1);
        }
    }
    lrun += __shfl_xor(lrun, 32);
    const float inv = 1.f / lrun;
    const size_t token = (size_t)b * SEQ + r + (size_t)d * mq;
    bf16_t* op = OP + ((size_t)pat * MP + token) * 512 + hd * 64;
#pragma unroll
    for (int g4 = 0; g4 < 4; ++g4) {
        f32x4 a, c;
        a.x = o0[4 * g4] * inv; a.y = o0[4 * g4 + 1] * inv; a.z = o0[4 * g4 + 2] * inv; a.w = o0[4 * g4 + 3] * inv;
        c.x = o1[4 * g4] * inv; c.y = o1[4 * g4 + 1] * inv; c.z = o1[4 * g4 + 2] * inv; c.w = o1[4 * g4 + 3] * inv;
        store_bf16x4(op + 8 * g4 + 4 * hf, a);
        store_bf16x4(op + 32 + 8 * g4 + 4 * hf, c);
    }
    if (hf == 0) LSE[((size_t)pat * MP + token) * 8 + hd] = mrun * 0.6931471805599453f + __logf(lrun);
}

DI void sgu_item(const Params& p, const bf16_t* Z, bf16_t* AO, int item, ldsp lds) {
    const int b = item >> 7, c = (item >> 2) & 31, g = item & 3, tid = threadIdx.x;
    const int row0 = b * SEQ + c * 128;
    LAS float* stat = (LAS float*)(lds + 128 * 272);
    const int w = tid >> 6, lane = tid & 63, ql = lane & 31, hf = lane >> 5, tt = w >> 1, dp = w & 1;
    const bf16_t* WS = (const bf16_t*)(p.ws + O_WS_TRIL) + (size_t)(g * 128 + 32 * tt + ql) * 128 + 8 * hf;
    bf16x8 afr[8];
#pragma unroll
    for (int ks = 0; ks < 8; ++ks) afr[ks] = *(const bf16x8*)(WS + 16 * ks);
    bf16_t u0[16], u1[16]; float bsv[16];
#pragma unroll
    for (int i = 0; i < 16; ++i) {
        const int t = 32 * tt + crow(i, hf); const size_t zr = (size_t)(row0 + t) * NIE + g * 128 + 64 * dp + ql;
        u0[i] = Z[zr]; u1[i] = Z[zr + 32]; bsv[i] = p.in[I_BSGU][g * 128 + t];
    }
    {
        const int row = tid >> 2, part = tid & 3;
        const bf16_t* ptr = Z + (size_t)(row0 + row) * NIE + 512 + part * 128;
        float s = 0.f, ss = 0.f;
#pragma unroll
        for (int i = 0; i < 16; ++i) { const bf16x8 v = *(const bf16x8*)(ptr + 8 * i);
#pragma unroll
            for (int j = 0; j < 8; ++j) { const float f = bfs2f(v[j]); s += f; ss += f * f; } }
        s += __shfl_xor(s, 1); s += __shfl_xor(s, 2); ss += __shfl_xor(ss, 1); ss += __shfl_xor(ss, 2);
        const float mu = s * (1.f / 512.f), var = fmaxf(ss * (1.f / 512.f) - mu * mu, 0.f);
        if (part == 0) { stat[row * 2] = mu; stat[row * 2 + 1] = rsqrtf(var + 1e-6f); }
    }
    __syncthreads();
    {
        const int st = tid >> 2, dch = tid & 3;
        const float mu = stat[st * 2], rstd = stat[st * 2 + 1];
        const float* lg = p.in[I_LNG] + g * 128; const float* lb = p.in[I_LNB] + g * 128;
#pragma unroll
        for (int i = 0; i < 4; ++i) {
            const int d0 = dch * 32 + i * 8;
            const bf16x8 v = *(const bf16x8*)(Z + (size_t)(row0 + st) * NIE + 512 + g * 128 + d0);
            const f32x4 g0 = *(const f32x4*)(lg + d0), g1 = *(const f32x4*)(lg + d0 + 4), h0 = *(const f32x4*)(lb + d0), h1 = *(const f32x4*)(lb + d0 + 4);
            const float gv[8] = {g0.x, g0.y, g0.z, g0.w, g1.x, g1.y, g1.z, g1.w}, hv[8] = {h0.x, h0.y, h0.z, h0.w, h1.x, h1.y, h1.z, h1.w};
#pragma unroll
            for (int j = 0; j < 8; ++j) { const float val = (bfs2f(v[j]) - mu) * rstd * gv[j] + hv[j]; *(LAS bf16_t*)(lds + (d0 + j) * 272 + st * 2) = f2bf(val); }
        }
    }
    __syncthreads();
    f32x16 c0, c1;
#pragma unroll
    for (int i = 0; i < 16; ++i) { c0[i] = 0.f; c1[i] = 0.f; }
#pragma unroll
    for (int ks = 0; ks < 8; ++ks) {
        if (ks >= 2 * tt + 2) break;
        const bf16x8 a = afr[ks];
        const bf16x8 b0 = *(LAS bf16x8*)(lds + (64 * dp + ql) * 272 + (16 * ks + 8 * hf) * 2);
        const bf16x8 b1 = *(LAS bf16x8*)(lds + (64 * dp + 32 + ql) * 272 + (16 * ks + 8 * hf) * 2);
        c0 = MFMA32(a, b0, c0); c1 = MFMA32(a, b1, c1);
    }
#pragma unroll
    for (int i = 0; i < 16; ++i) {
        const int t = 32 * tt + crow(i, hf);
        const size_t ar = (size_t)(row0 + t) * DM + g * 128 + 64 * dp + ql;
        AO[ar] = f2bf(bf2f(u0[i]) * (c0[i] + bsv[i]));
        AO[ar + 32] = f2bf(bf2f(u1[i]) * (c1[i] + bsv[i]));
    }
    __syncthreads();
}

DI void sgu_sample_item(const Params& p, const bf16_t* Z, bf16_t* AO, int row) {
    const int lane = threadIdx.x & 63;
    const bf16_t* zr = Z + (size_t)(MP + row) * NIE;
    const bf16x8 vv = *(const bf16x8*)(zr + 512 + lane * 8), uu = *(const bf16x8*)(zr + lane * 8);
    float vals[8]; float s = 0.f, ss = 0.f;
#pragma unroll
    for (int j = 0; j < 8; ++j) { const float f = bfs2f(vv[j]); vals[j] = f; s += f; ss += f * f; }
    s = wave_sum(s); ss = wave_sum(ss);
    const float mu = s * (1.f / 512.f), rstd = rsqrtf(fmaxf(ss * (1.f / 512.f) - mu * mu, 0.f) + 1e-6f);
    const int g = lane >> 4;
    const float w00 = p.in[I_WSGU][(size_t)g * 16384], b0 = p.in[I_BSGU][g * 128];
    float o[8];
#pragma unroll
    for (int j = 0; j < 8; ++j) {
        const int c = lane * 8 + j;
        const float vl = (vals[j] - mu) * rstd * p.in[I_LNG][c] + p.in[I_LNB][c];
        p.out[OUT_CV_S + (size_t)row * 512 + c] = vl;
        o[j] = bfs2f(uu[j]) * (w00 * vl + b0);
    }
    u32x4 ov; ov.x = pk2(o[0], o[1]); ov.y = pk2(o[2], o[3]); ov.z = pk2(o[4], o[5]); ov.w = pk2(o[6], o[7]);
    *(u32x4*)(AO + (size_t)(MP + row) * DM + lane * 8) = ov;
}

DI void attn_sample_item(const Params& p, const bf16_t* Z, bf16_t* AO, int item, ldsp lds) {
    const int bs = item >> 3, hd = item & 7, tid = threadIdx.x, wave = tid >> 6, lane = tid & 63;
    LAS float* sc = (LAS float*)lds; LAS float* red = sc + 512;
    const float* ck = p.in[I_CK] + (size_t)bs * 2048 * 512 + hd * 64;
    const float* cv = p.in[I_CV] + (size_t)bs * 2048 * 512 + hd * 64;
    const bf16_t* zs = Z + (size_t)(MP + bs) * NIE + hd * 64;
    const int piece = lane & 15, sub = lane >> 4;
    __syncthreads();
    f32x4 qv;
    { const bf16_t* qp = zs + 1024 + piece * 4; qv.x = bf2f(qp[0]); qv.y = bf2f(qp[1]); qv.z = bf2f(qp[2]); qv.w = bf2f(qp[3]); }
#pragma unroll
    for (int e0 = wave * 4; e0 < 388; e0 += 32) {
        const int e = e0 + sub, ec = e < 387 ? e : 386;
        const int pat = ec / 129, j = ec - pat * 129, d = pat == 0 ? 1 : (pat == 1 ? 4 : 16);
        f32x4 kk;
        if (j > 0) kk = *(const f32x4*)(ck + (size_t)(2048 - j * d) * 512 + piece * 4);
        else { const bf16_t* kp = zs + 1536 + piece * 4; kk.x = bf2f(kp[0]); kk.y = bf2f(kp[1]); kk.z = bf2f(kp[2]); kk.w = bf2f(kp[3]); }
        float dot = kk.x * qv.x + kk.y * qv.y + kk.z * qv.z + kk.w * qv.w;
        dot += __shfl_xor(dot, 1); dot += __shfl_xor(dot, 2); dot += __shfl_xor(dot, 4); dot += __shfl_xor(dot, 8);
        if (piece == 0 && e < 387) sc[e] = dot * 0.125f;
    }
    __syncthreads();
    float mx = -1e30f;
    for (int i = lane; i < 387; i += 64) mx = fmaxf(mx, sc[i]);
    mx = wave_max(mx);
    float sum = 0.f;
    for (int i = lane; i < 387; i += 64) sum += __expf(sc[i] - mx);
    sum = wave_sum(sum);
    float acc = 0.f;
    {
        float vv[49];
#pragma unroll
        for (int k = 0; k < 49; ++k) {
            const int i = wave + 8 * k, ic = i < 387 ? i : 386;
            const int pat = ic / 129, j = ic - pat * 129, d = pat == 0 ? 1 : (pat == 1 ? 4 : 16);
            vv[k] = j > 0 ? cv[(size_t)(2048 - j * d) * 512 + lane] : bf2f(zs[2048 + lane]);
        }
#pragma unroll
        for (int k = 0; k < 49; ++k) { const int i = wave + 8 * k; if (i < 387) acc += __expf(sc[i] - mx) * vv[k]; }
    }
    red[wave * 64 + lane] = acc;
    __syncthreads();
    if (tid < 64) { float t = 0.f;
#pragma unroll
        for (int ww = 0; ww < 8; ++ww) t += red[ww * 64 + tid];
        AO[(size_t)(MP + bs) * DM + 512 + hd * 64 + tid] = f2bf(t / sum); }
    __syncthreads();
}

constexpr int P3_ATT = 1536, P3_SGU = 512, P3_SATT = 256;
DI void phase3(const Params& p, ldsp lds) {
    const bf16_t* Z = (const bf16_t*)(p.ws + O_Z); bf16_t* AO = (bf16_t*)(p.ws + O_AO);
    bf16_t* OP = (bf16_t*)(p.ws + O_OP); float* LSE = (float*)(p.ws + O_LSE);
    const int x = (int)blockIdx.x & 7, li = (int)blockIdx.x >> 3;
    for (int j = 0; j < 2; ++j) { const int P = (j * 8 + x) * 8 + (li >> 2); sgu_item(p, Z, AO, P * 4 + (li & 3), lds);
#if P3_TWICE == 1
        sgu_item(p, Z, AO, P * 4 + (li & 3), lds);
#endif
    }
    for (int j = 0; j < 6; ++j) { const int G = (j * 8 + x) * 2 + (li >> 4); attn_item(Z, OP, LSE, G * 16 + (li & 15), lds);
#if P3_TWICE == 2
        attn_item(Z, OP, LSE, G * 16 + (li & 15), lds);
#endif
    }
    attn_sample_item(p, Z, AO, (int)blockIdx.x, lds);
    if (blockIdx.x >= 252) sgu_sample_item(p, Z, AO, ((int)blockIdx.x - 252) * 8 + ((int)threadIdx.x >> 6));
}

DI void phase4(const Params& p) {
    const bf16_t* OP = (const bf16_t*)(p.ws + O_OP); const float* LSE = (const float*)(p.ws + O_LSE); bf16_t* AO = (bf16_t*)(p.ws + O_AO);
    const size_t nthr = (size_t)gridDim.x * 512;
#pragma unroll 4
    for (size_t idx = (size_t)blockIdx.x * 512 + threadIdx.x; idx < (size_t)MP * 64; idx += nthr) {
        const size_t token = idx >> 6; const int c8 = (int)(idx & 63), head = c8 >> 3;
        const float l0 = LSE[token * 8 + head], l1 = LSE[((size_t)MP + token) * 8 + head], l2 = LSE[((size_t)2 * MP + token) * 8 + head];
        const float mx = fmaxf(l0, fmaxf(l1, l2));
        float w0 = __expf(l0 - mx), w1 = __expf(l1 - mx), w2 = __expf(l2 - mx);
        const float inv = 1.f / (w0 + w1 + w2); w0 *= inv; w1 *= inv; w2 *= inv;
        const bf16x8 a = *(const bf16x8*)(OP + token * 512 + c8 * 8), b = *(const bf16x8*)(OP + ((size_t)MP + token) * 512 + c8 * 8), c = *(const bf16x8*)(OP + ((size_t)2 * MP + token) * 512 + c8 * 8);
        float o[8];
#pragma unroll
        for (int j = 0; j < 8; ++j) o[j] = w0 * bfs2f(a[j]) + w1 * bfs2f(b[j]) + w2 * bfs2f(c[j]);
        u32x4 ov; ov.x = pk2(o[0], o[1]); ov.y = pk2(o[2], o[3]); ov.z = pk2(o[4], o[5]); ov.w = pk2(o[6], o[7]);
        *(u32x4*)(AO + token * DM + 512 + c8 * 8) = ov;
    }
}

DI void convgate_phase(const Params& p, int l) {
    const bf16_t* UP = (const bf16_t*)(p.ws + O_UP); bf16_t* ACT = (bf16_t*)(p.ws + O_ACT);
    const bf16_t* UPB = (const bf16_t*)(p.ws + O_UP);
    const float* cw = p.in[I_FCW] + (size_t)l * 3 * F2; const float* cb = p.in[I_FCB] + (size_t)l * F2;
    const size_t nthr = (size_t)gridDim.x * 512, gtid = (size_t)blockIdx.x * 512 + threadIdx.x;
    constexpr int NCH = DFF / 8;
    for (size_t u = gtid; u < (size_t)256 * 2 * NCH; u += nthr) {
        const int gi = (int)(u / NCH), ch = (int)(u - (size_t)gi * NCH), c0 = ch * 8, G = gi >> 1, which = gi & 1, row = 64 * G + which;
        const bool first = (row & 4095) < 2 && which == 0 ? true : false;
        const bool seq0 = ((64 * G) & 4095) == 0;
        const bf16_t* prev = UPB + (size_t)((G > 0 ? G - 1 : 0) * 4) * F2; const bf16_t* cur = UPB + (size_t)(G * 4) * F2;
        const bf16_t* r2 = which == 0 ? prev + 0 * F2 : prev + 1 * F2;
        const bf16_t* r1 = which == 0 ? prev + 1 * F2 : cur + 2 * F2;
        const bf16_t* r0 = which == 0 ? cur + 2 * F2 : cur + 3 * F2;
        const bool z2 = seq0, z1 = seq0 && which == 0;
        (void)first;
        const bf16x8 a2 = *(const bf16x8*)(r2 + c0), a1 = *(const bf16x8*)(r1 + c0), a0 = *(const bf16x8*)(r0 + c0);
        const bf16x8 b2 = *(const bf16x8*)(r2 + DFF + c0), b1 = *(const bf16x8*)(r1 + DFF + c0), b0 = *(const bf16x8*)(r0 + DFF + c0);
        float o[8];
#pragma unroll
        for (int j = 0; j < 8; ++j) {
            const float x2a = z2 ? 0.f : bfs2f(a2[j]), x1a = z1 ? 0.f : bfs2f(a1[j]), x2b = z2 ? 0.f : bfs2f(b2[j]), x1b = z1 ? 0.f : bfs2f(b1[j]);
            const float av = cb[c0 + j] + cw[c0 + j] * x2a + cw[F2 + c0 + j] * x1a + cw[2 * F2 + c0 + j] * bfs2f(a0[j]);
            const float bv = cb[DFF + c0 + j] + cw[DFF + c0 + j] * x2b + cw[F2 + DFF + c0 + j] * x1b + cw[2 * F2 + DFF + c0 + j] * bfs2f(b0[j]);
            o[j] = av / (1.f + __expf(-av)) * bv;
        }
        u32x4 ov; ov.x = pk2(o[0], o[1]); ov.y = pk2(o[2], o[3]); ov.z = pk2(o[4], o[5]); ov.w = pk2(o[6], o[7]);
        *(u32x4*)(ACT + (size_t)row * DFF + c0) = ov;
    }
    const float* st = p.in[I_SFC] + (size_t)l * 32 * 2 * F2; float* sto = p.out + OUT_FC_S + (size_t)l * 32 * 2 * F2;
    for (size_t u = gtid; u < (size_t)MS * DFF; u += nthr) {
        const int bs = (int)(u / DFF), c = (int)(u - (size_t)bs * DFF);
        const float* s0 = st + (size_t)(bs * 2) * F2; const float* s1 = s0 + F2;
        const bf16_t* ur = UP + (size_t)(MP + bs) * F2;
        const float av = cb[c] + cw[c] * s0[c] + cw[F2 + c] * s1[c] + cw[2 * F2 + c] * bf2f(ur[c]);
        const float bv = cb[DFF + c] + cw[DFF + c] * s0[DFF + c] + cw[F2 + DFF + c] * s1[DFF + c] + cw[2 * F2 + DFF + c] * bf2f(ur[DFF + c]);
        ACT[(size_t)(MP + bs) * DFF + c] = f2bf(av / (1.f + __expf(-av)) * bv);
        sto[(size_t)(bs * 2) * F2 + c] = s1[c]; sto[(size_t)(bs * 2) * F2 + DFF + c] = s1[DFF + c];
        sto[(size_t)(bs * 2 + 1) * F2 + c] = bf2f(ur[c]); sto[(size_t)(bs * 2 + 1) * F2 + DFF + c] = bf2f(ur[DFF + c]);
    }
    float* stp = p.out + OUT_FC_P + (size_t)l * 4 * 2 * F2;
    for (size_t u = gtid; u < (size_t)4 * 2 * F2; u += nthr) {
        const int bi = (int)(u / F2), c = (int)(u - (size_t)bi * F2), b = bi >> 1, i = bi & 1;
        stp[u] = bf2f(UPB[(size_t)((((b + 1) * SEQ - 1) >> 6) * 4 + i) * F2 + c]);
    }
}

DI void rglru_gate_item(const Params& p, int item, ldsp lds) {
    const int mt = item >> 3, g = item & 7, tid = threadIdx.x;
    const bf16_t* ZO = (const bf16_t*)(p.ws + O_ZO);
    {
        const int chunk = tid & 15, rg = tid >> 4, c0 = g * 128 + chunk * 8;
        float cw[4][8], cb[8];
#pragma unroll
        for (int k = 0; k < 4; ++k) { const f32x4 t0 = *(const f32x4*)(p.in[I_RCW] + k * 1024 + c0), t1 = *(const f32x4*)(p.in[I_RCW] + k * 1024 + c0 + 4);
            cw[k][0] = t0.x; cw[k][1] = t0.y; cw[k][2] = t0.z; cw[k][3] = t0.w; cw[k][4] = t1.x; cw[k][5] = t1.y; cw[k][6] = t1.z; cw[k][7] = t1.w; }
        { const f32x4 t0 = *(const f32x4*)(p.in[I_RCB] + c0), t1 = *(const f32x4*)(p.in[I_RCB] + c0 + 4);
          cb[0] = t0.x; cb[1] = t0.y; cb[2] = t0.z; cb[3] = t0.w; cb[4] = t1.x; cb[5] = t1.y; cb[6] = t1.z; cb[7] = t1.w; }
        if (mt < 64) {
            const int row0 = mt * 256 + rg * 8, t0 = row0 & 4095;
            float p3[8], p2[8], p1[8];
            if (t0 == 0) {
#pragma unroll
                for (int j = 0; j < 8; ++j) p3[j] = p2[j] = p1[j] = 0.f;
            } else {
                const bf16x8 v3 = *(const bf16x8*)(ZO + (size_t)(row0 - 3) * 2048 + 1024 + c0), v2 = *(const bf16x8*)(ZO + (size_t)(row0 - 2) * 2048 + 1024 + c0), v1 = *(const bf16x8*)(ZO + (size_t)(row0 - 1) * 2048 + 1024 + c0);
#pragma unroll
                for (int j = 0; j < 8; ++j) { p3[j] = bfs2f(v3[j]); p2[j] = bfs2f(v2[j]); p1[j] = bfs2f(v1[j]); }
            }
#pragma unroll
            for (int i = 0; i < 8; ++i) {
                const bf16x8 vc = *(const bf16x8*)(ZO + (size_t)(row0 + i) * 2048 + 1024 + c0);
                float o[8];
#pragma unroll
                for (int j = 0; j < 8; ++j) { const float cur = bfs2f(vc[j]); o[j] = cb[j] + cw[0][j] * p3[j] + cw[1][j] * p2[j] + cw[2][j] * p1[j] + cw[3][j] * cur; p3[j] = p2[j]; p2[j] = p1[j]; p1[j] = cur; }
                u32x4 ov; ov.x = pk2(o[0], o[1]); ov.y = pk2(o[2], o[3]); ov.z = pk2(o[4], o[5]); ov.w = pk2(o[6], o[7]);
                *(LAS u32x4*)(lds + (rg * 8 + i) * 272 + chunk * 16) = ov;
            }
        } else {
#pragma unroll
            for (int i = 0; i < 8; ++i) {
                const int rt = rg * 8 + i;
                u32x4 ov; ov.x = ov.y = ov.z = ov.w = 0u;
                if (rt < MS) {
                    const float* st = p.in[I_SRC] + (size_t)rt * 3 * 1024 + c0;
                    const bf16x8 vc = *(const bf16x8*)(ZO + (size_t)(MP + rt) * 2048 + 1024 + c0);
                    float o[8];
#pragma unroll
                    for (int j = 0; j < 8; ++j) o[j] = cb[j] + cw[0][j] * st[j] + cw[1][j] * st[1024 + j] + cw[2][j] * st[2048 + j] + cw[3][j] * bfs2f(vc[j]);
                    ov.x = pk2(o[0], o[1]); ov.y = pk2(o[2], o[3]); ov.z = pk2(o[4], o[5]); ov.w = pk2(o[6], o[7]);
                    float* so = p.out + OUT_RC_S + (size_t)rt * 3 * 1024 + c0;
#pragma unroll
                    for (int j = 0; j < 8; ++j) { so[j] = st[1024 + j]; so[1024 + j] = st[2048 + j]; so[2048 + j] = bfs2f(vc[j]); }
                }
                *(LAS u32x4*)(lds + rt * 272 + chunk * 16) = ov;
            }
        }
    }
    __syncthreads();
    const int w = tid >> 6, lane = tid & 63, ql = lane & 31, hf = lane >> 5;
    bf16x8 af[8];
#pragma unroll
    for (int ks = 0; ks < 8; ++ks) af[ks] = *(LAS bf16x8*)(lds + (32 * w + ql) * 272 + (16 * ks + 8 * hf) * 2);
    const bf16_t* WG = (const bf16_t*)(p.ws + O_WT_GA) + (size_t)(g * 256 + ql) * 128 + 8 * hf;
    unsigned* HP = (unsigned*)(p.ws + O_AA); float* AGP = (float*)(p.ws + O_BB); float* AGH = AGP + 512 * 1024; bf16_t* Y = (bf16_t*)(p.ws + O_AO);
    for (int n = 0; n < 4; ++n) {
        f32x16 ar, ai;
#pragma unroll
        for (int i = 0; i < 16; ++i) { ar[i] = 0.f; ai[i] = 0.f; }
#pragma unroll
        for (int ks = 0; ks < 8; ++ks) {
            const bf16x8 br = *(const bf16x8*)(WG + (size_t)(32 * n) * 128 + 16 * ks), bi = *(const bf16x8*)(WG + (size_t)(32 * (n + 4)) * 128 + 16 * ks);
            ar = MFMA32(af[ks], br, ar); ai = MFMA32(af[ks], bi, ai);
        }
        const int o = 32 * n + ql, col = g * 128 + o;
        const float ba = p.in[I_RBA][col], bx = p.in[I_RBX][col], lam = p.in[I_RLAM][col];
        const float sp8 = 8.f * 1.4426950408889634f * log1pf(__expf(-lam));
        float av[16], bv[16];
#pragma unroll
        for (int i = 0; i < 16; ++i) {
            const int rt = 32 * w + crow(i, hf);
            const float r = fsigmoid(ar[i] + ba), ig = fsigmoid(ai[i] + bx);
            const float la2 = -(r * sp8), a = fexp2(la2);
            const float em = fmaxf(1.f - a * a, 0.f);
            const float xcv = bf2f(*(LAS bf16_t*)(lds + rt * 272 + o * 2));
            av[i] = a; bv[i] = __builtin_amdgcn_sqrtf(em) * (ig * xcv);
        }
        if (mt < 64) {
            float gP[4], gH[4];
#pragma unroll
            for (int q = 0; q < 4; ++q) { float h = 0.f, P = 1.f;
#pragma unroll
                for (int j = 0; j < 4; ++j) { const int i = 4 * q + j; h = av[i] * h + bv[i]; P *= av[i]; bv[i] = h; av[i] = P; }
                gP[q] = P; gH[q] = h; }
            float Hc = 0.f, Pc = 1.f;
#pragma unroll
            for (int q = 0; q < 4; ++q) {
                const float oP = __shfl_xor(gP[q], 32), oH = __shfl_xor(gH[q], 32);
                const float P0 = hf ? oP : gP[q], H0 = hf ? oH : gH[q], P1 = hf ? gP[q] : oP, H1 = hf ? gH[q] : oH;
                const float mid = P0 * Hc + H0;
                const float inH = hf ? mid : Hc, inP = hf ? P0 * Pc : Pc;
#pragma unroll
                for (int j = 0; j < 4; ++j) { const int i = 4 * q + j; bv[i] += av[i] * inH; av[i] *= inP; }
                Hc = P1 * mid + H1; Pc = P1 * P0 * Pc;
            }
#pragma unroll
            for (int i = 0; i < 16; ++i) HP[(size_t)(mt * 256 + 32 * w + crow(i, hf)) * DM + col] = pk2(bv[i], av[i]);
            if (hf == 0) { LAS float* ag = (LAS float*)(lds + 256 * 272) + (w * 128 + o) * 2; ag[0] = Pc; ag[1] = Hc; }
        } else {
#pragma unroll
            for (int i = 0; i < 16; ++i) {
                const int rt = 32 * w + crow(i, hf);
                if (rt < MS) {
                    const float h = av[i] * p.in[I_SRH][(size_t)rt * 1024 + col] + bv[i];
                    p.out[OUT_RH_S + (size_t)rt * 1024 + col] = h;
                    Y[(size_t)(MP + rt) * DM + col] = f2bf(bf2f(ZO[(size_t)(MP + rt) * 2048 + col]) * h);
                }
            }
        }
    }
    __syncthreads();
    if (mt < 64 && tid < 128) {
        const LAS float* ag = (const LAS float*)(lds + 256 * 272);
        float cP = 1.f, cH = 0.f; const int col = g * 128 + tid;
#pragma unroll
        for (int ww = 0; ww < 8; ++ww) {
            AGP[(size_t)(mt * 8 + ww) * 1024 + col] = cP; AGH[(size_t)(mt * 8 + ww) * 1024 + col] = cH;
            const float P = ag[(ww * 128 + tid) * 2], Hh = ag[(ww * 128 + tid) * 2 + 1];
            cH = P * cH + Hh; cP *= P;
        }
        float* TP = AGP + 2 * 512 * 1024; TP[(size_t)mt * 1024 + col] = cP; TP[(size_t)(64 + mt) * 1024 + col] = cH;
    }
    __syncthreads();
}

DI void rglru_sample_item(const Params& p, int g, ldsp lds) {
    const int tid = threadIdx.x;
    const bf16_t* ZO = (const bf16_t*)(p.ws + O_ZO);
    if (tid < 512) {
        const int chunk = tid & 15, rt = tid >> 4, c0 = g * 128 + chunk * 8;
        const float* st = p.in[I_SRC] + (size_t)rt * 3 * 1024 + c0;
        const bf16x8 vc = *(const bf16x8*)(ZO + (size_t)(MP + rt) * 2048 + 1024 + c0);
        float o[8];
#pragma unroll
        for (int j = 0; j < 8; ++j) o[j] = p.in[I_RCB][c0 + j] + p.in[I_RCW][c0 + j] * st[j] + p.in[I_RCW][1024 + c0 + j] * st[1024 + j] + p.in[I_RCW][2048 + c0 + j] * st[2048 + j] + p.in[I_RCW][3072 + c0 + j] * bfs2f(vc[j]);
        u32x4 ov; ov.x = pk2(o[0], o[1]); ov.y = pk2(o[2], o[3]); ov.z = pk2(o[4], o[5]); ov.w = pk2(o[6], o[7]);
        *(LAS u32x4*)(lds + rt * 272 + chunk * 16) = ov;
        float* so = p.out + OUT_RC_S + (size_t)rt * 3 * 1024 + c0;
#pragma unroll
        for (int j = 0; j < 8; ++j) { so[j] = st[1024 + j]; so[1024 + j] = st[2048 + j]; so[2048 + j] = bfs2f(vc[j]); }
    }
    __syncthreads();
    const int n = tid >> 6, lane = tid & 63, ql = lane & 31, hf = lane >> 5;
    if (n < 4) {
        const bf16_t* WG = (const bf16_t*)(p.ws + O_WT_GA) + (size_t)(g * 256 + ql) * 128 + 8 * hf;
        f32x16 ar, ai;
#pragma unroll
        for (int i = 0; i < 16; ++i) { ar[i] = 0.f; ai[i] = 0.f; }
#pragma unroll
        for (int ks = 0; ks < 8; ++ks) {
            const bf16x8 af = *(LAS bf16x8*)(lds + ql * 272 + (16 * ks + 8 * hf) * 2);
            const bf16x8 br = *(const bf16x8*)(WG + (size_t)(32 * n) * 128 + 16 * ks), bi = *(const bf16x8*)(WG + (size_t)(32 * (n + 4)) * 128 + 16 * ks);
            ar = MFMA32(af, br, ar); ai = MFMA32(af, bi, ai);
        }
        const int o = 32 * n + ql, col = g * 128 + o;
        const float ba = p.in[I_RBA][col], bx = p.in[I_RBX][col], lam = p.in[I_RLAM][col];
        const float sp8 = 8.f * 1.4426950408889634f * log1pf(__expf(-lam));
        bf16_t* Y = (bf16_t*)(p.ws + O_AO);
#pragma unroll
        for (int i = 0; i < 16; ++i) {
            const int rt = crow(i, hf);
            const float r = fsigmoid(ar[i] + ba), ig = fsigmoid(ai[i] + bx);
            const float la2 = -(r * sp8), a = fexp2(la2), y = la2 * (2.f * 0.6931471805599453f);
            const float em = y > -0.1f ? -y * (1.f + y * (0.5f + y * (0.16666667f + y * (0.041666668f + y * 0.0083333333f)))) : 1.f - a * a;
            const float xcv = bf2f(*(LAS bf16_t*)(lds + rt * 272 + o * 2));
            const float bv = __builtin_amdgcn_sqrtf(em) * (ig * xcv);
            const float h = a * p.in[I_SRH][(size_t)rt * 1024 + col] + bv;
            p.out[OUT_RH_S + (size_t)rt * 1024 + col] = h;
            Y[(size_t)(MP + rt) * DM + col] = f2bf(bf2f(ZO[(size_t)(MP + rt) * 2048 + col]) * h);
        }
    }
    __syncthreads();
}

DI void scan_apply(const Params& p, ldsp lds) {
    if (blockIdx.x < 8) rglru_sample_item(p, (int)blockIdx.x, lds);
    const unsigned* HP = (const unsigned*)(p.ws + O_AA); const float* AGP = (const float*)(p.ws + O_BB); const float* AGH = AGP + 512 * 1024;
    const bf16_t* ZO = (const bf16_t*)(p.ws + O_ZO); bf16_t* Y = (bf16_t*)(p.ws + O_AO);
    for (size_t u = (size_t)blockIdx.x * 512 + threadIdx.x; u < (size_t)4 * 3 * 1024; u += (size_t)gridDim.x * 512) {
        const int bi = (int)(u >> 10), c = (int)(u & 1023), b = bi / 3, i = bi - 3 * b;
        p.out[OUT_RC_P + u] = bf2f(ZO[(size_t)(b * SEQ + 4093 + i) * 2048 + 1024 + c]);
    }
    const float* TP = AGP + 2 * 512 * 1024; const float* TH = TP + 64 * 1024;
    for (int chunk = blockIdx.x; chunk < 512; chunk += gridDim.x) {
        const int b = chunk >> 7, mt = chunk >> 3, c4 = (threadIdx.x & 255) * 4, rh = threadIdx.x >> 8;
        f32x4 T = {0.f, 0.f, 0.f, 0.f};
#pragma unroll 4
        for (int j = b * 16; j < mt; ++j) T = *(const f32x4*)(TP + (size_t)j * 1024 + c4) * T + *(const f32x4*)(TH + (size_t)j * 1024 + c4);
        const f32x4 h0 = *(const f32x4*)(AGH + (size_t)chunk * 1024 + c4) + *(const f32x4*)(AGP + (size_t)chunk * 1024 + c4) * T;
        const size_t row0 = (size_t)chunk * 32 + rh * 16;
        u32x4 wv[16]; u32x2 gt[16];
#pragma unroll
        for (int t = 0; t < 16; ++t) { wv[t] = *(const u32x4*)(HP + (row0 + t) * DM + c4); gt[t] = *(const u32x2*)(ZO + (row0 + t) * 2048 + c4); }
#pragma unroll
        for (int t = 0; t < 16; ++t) {
            const float y0 = __uint_as_float(gt[t].x << 16) * (__uint_as_float(wv[t].x << 16) + __uint_as_float(wv[t].x & 0xffff0000u) * h0.x);
            const float y1 = __uint_as_float(gt[t].x & 0xffff0000u) * (__uint_as_float(wv[t].y << 16) + __uint_as_float(wv[t].y & 0xffff0000u) * h0.y);
            const float y2 = __uint_as_float(gt[t].y << 16) * (__uint_as_float(wv[t].z << 16) + __uint_as_float(wv[t].z & 0xffff0000u) * h0.z);
            const float y3 = __uint_as_float(gt[t].y & 0xffff0000u) * (__uint_as_float(wv[t].w << 16) + __uint_as_float(wv[t].w & 0xffff0000u) * h0.w);
            u32x2 o; o.x = pk2(y0, y1); o.y = pk2(y2, y3);
            *(u32x2*)(Y + (row0 + t) * DM + c4) = o;
        }
        if ((chunk & 127) == 127 && rh == 0) *(f32x4*)(p.out + OUT_RH_P + (size_t)b * 1024 + c4) = *(const f32x4*)(TP + (size_t)mt * 1024 + c4) * T + *(const f32x4*)(TH + (size_t)mt * 1024 + c4);
    }
}

DI void run_phase(const Params& p, int ph, ldsp lds, int rep = 0) {
    unsigned char* ws = p.ws;
    float* MOD = (float*)(ws + O_MOD); bf16_t* X = (bf16_t*)(ws + O_X); bf16_t* H = (bf16_t*)(ws + O_H); bf16_t* AO = (bf16_t*)(ws + O_AO);
    float* SLOT = (float*)(ws + O_SLOT); unsigned* CNT = (unsigned*)(ws + O_BAR) + CNT_WORD;
    const float* MOD1 = MOD + 36 * 6144; const bf16_t* Xs = X + (size_t)MP * DM;
    if (gridDim.x != 256) return;
    switch (ph) {
    case 0: phase0(p, lds, rep); break;
    case 1: norm_phase(p.in[I_XP], p.in[I_XS], MOD, 0, 1024, H); break;
    case 2: { QInE q{(bf16_t*)(ws + O_Z), p.out + OUT_WK_P, p.out + OUT_WV_P, p.out + OUT_WK_S, p.out + OUT_WV_S};
              gemm_all_p(lds, H, (const bf16_t*)(ws + O_WT_IN_E), NIE, 1024, q); copy_share(p, 0, 600); } break;
    case 3: phase3(p, lds); break;
    case 4: phase4(p); break;
    case 5: { EpiResFused e{p.in[I_XP], p.in[I_XS], X, MOD + 2048, 0, MOD + 4096, MOD + 3072, H, nullptr, nullptr, SLOT, CNT};
              gemm_res_fused(lds, AO, (const bf16_t*)(ws + O_WT_OUT_E), 1024, e); } break;
    case 7: { EpiUpGate e{(bf16_t*)(ws + O_ACT), (bf16_t*)(ws + O_UP), p.in[I_FCW], p.in[I_FCB]}; QUpS qs{(bf16_t*)(ws + O_UP)};
              gemm_upgate(lds, H, (const bf16_t*)(ws + O_WT_UP), e, qs, Xs, MOD, 3072, 4096); copy_share(p, 600, 1324); } break;
    case 8: convgate_phase(p, 0); break;
    case 9: { EpiResFused e{nullptr, nullptr, X, MOD + 5120, 0, MOD1 + 1024, MOD1 + 0, H, nullptr, nullptr, SLOT + (size_t)4 * MP, CNT + 64};
              gemm_res_fused(lds, (const bf16_t*)(ws + O_ACT), (const bf16_t*)(ws + O_WT_DN), DFF, e); } break;
    case 11: { QInO q{(bf16_t*)(ws + O_ZO)}; gemm_all_p_sn(lds, H, (const bf16_t*)(ws + O_WT_IN_O), 2048, q, Xs, MOD1, 0, 1024); } break;
    case 12: for (int it = blockIdx.x; it < 64 * 8; it += gridDim.x) rglru_gate_item(p, it, lds); break;
    case 13: scan_apply(p, lds); break;
    case 15: { EpiResFused e{nullptr, nullptr, X, MOD1 + 2048, 0, MOD1 + 4096, MOD1 + 3072, H, nullptr, nullptr, SLOT + (size_t)8 * MP, CNT + 128};
               gemm_res_fused(lds, AO, (const bf16_t*)(ws + O_WT_OUT_O), 1024, e); } break;
    case 17: { EpiUpGate e{(bf16_t*)(ws + O_ACT), (bf16_t*)(ws + O_UP), p.in[I_FCW] + (size_t)3 * F2, p.in[I_FCB] + F2}; QUpS qs{(bf16_t*)(ws + O_UP)};
               gemm_upgate(lds, H, (const bf16_t*)(ws + O_WT_UP + SZ_WT_UP), e, qs, Xs, MOD1, 3072, 4096); copy_share(p, 1324, COPY_ITEMS); } break;
    case 18: convgate_phase(p, 1); break;
    case 19: { EpiResFused e{nullptr, nullptr, X, MOD1 + 5120, 1, nullptr, nullptr, nullptr, p.in[I_FING], p.out + OUT_Y_P, SLOT + (size_t)12 * MP, CNT + 192};
               gemm_res_fused(lds, (const bf16_t*)(ws + O_ACT), (const bf16_t*)(ws + O_WT_DN + SZ_WT_DN), DFF, e); } break;
    case 20: final_norm_samples(X, p.in[I_FING], p.out + OUT_Y_S); break;
    default: break;
    }
}

__global__ void __launch_bounds__(512, 2) fwd_mega(Params p, int ph_lo, int ph_hi) {
    extern __shared__ __attribute__((aligned(16))) unsigned char shm[];
    ldsp lds = (ldsp)shm;
    cg::grid_group grid = cg::this_grid();
    const bool fused = (ph_hi - ph_lo) > 1;
    volatile LAS unsigned* st = (volatile LAS unsigned*)(lds + 131072);
    if (threadIdx.x == 0) { st[0] = 0u; st[1] = 0u; st[2] = 0u; st[3] = 0u; }
    __syncthreads();
    XcdBarrier xb; xb.bar = (unsigned*)(p.ws + O_BAR); xb.x = 0; xb.st = st;
    if (fused) xb = xcd_barrier_post((unsigned*)(p.ws + O_BAR), st);
    if (ph_hi > 1000) grid.sync();
#define SEAM() xcd_barrier(xb)
#define PHASE(k) if (ph_lo <= (k) && (k) < ph_hi) { run_phase(p, (k), lds); if ((DOUBLE_MASK >> (k)) & 1) { SEAM(); run_phase(p, (k), lds, 1); } if ((k) + 1 < ph_hi) SEAM(); }
    PHASE(0) PHASE(1) PHASE(2) PHASE(3) PHASE(4) PHASE(5) PHASE(7) PHASE(8) PHASE(9)
    PHASE(11) PHASE(12) PHASE(13) PHASE(15) PHASE(17) PHASE(18) PHASE(19) PHASE(20)
#undef SEAM
#undef PHASE
}

extern "C" void kernel_launch(void* const* d_in, const int* in_sizes, int n_in, void* d_out, int out_size, void* d_ws, size_t ws_size, hipStream_t stream) {
    static int grid = 0;
    if (grid == 0) {
        if (n_in != N_IN || (size_t)out_size != OUT_TOTAL || ws_size < WS_NEED) { fprintf(stderr, "kernel_launch: unexpected shapes: n_in %d out %d ws %zu (need %zu)\n", n_in, out_size, ws_size, (size_t)WS_NEED); grid = -1; return; }
        int dev = 0, cus = 0, per_cu = 0;
        hipGetDevice(&dev); hipDeviceGetAttribute(&cus, hipDeviceAttributeMultiprocessorCount, dev);
        if (hipFuncSetAttribute((const void*)fwd_mega, hipFuncAttributeMaxDynamicSharedMemorySize, LDS_BYTES) != hipSuccess) { fprintf(stderr, "kernel_launch: hipFuncSetAttribute failed\n"); grid = -1; return; }
        if (hipOccupancyMaxActiveBlocksPerMultiprocessor(&per_cu, (const void*)fwd_mega, 512, LDS_BYTES) != hipSuccess || per_cu < 1) { fprintf(stderr, "kernel_launch: occupancy query says %d\n", per_cu); per_cu = 1; }
        (void)hipGetLastError();
        grid = cus;
        if (grid > 256) grid = 256;
    }
    if (grid < 0) return;
    Params p{};
    for (int i = 0; i < N_IN; ++i) p.in[i] = (const float*)d_in[i];
    p.out = (float*)d_out; p.ws = (unsigned char*)d_ws;
    if (hipMemsetAsync((unsigned char*)d_ws + O_BAR, 0, BAR_BYTES, stream) != hipSuccess) { fprintf(stderr, "kernel_launch: memset of barrier words failed\n"); return; }
#if MULTI_LAUNCH
    for (int ph = 0; ph < NPH; ++ph) { int lo = ph, hi = ph + 1; hipLaunchKernelGGL(fwd_mega, dim3(grid), dim3(512), LDS_BYTES, stream, p, lo, hi); }
#else
    int lo = 0, hi = NPH;
    void* args[] = {&p, &lo, &hi};
    hipError_t e = hipLaunchCooperativeKernel((const void*)fwd_mega, dim3(grid), dim3(512), args, LDS_BYTES, stream);
    if (e != hipSuccess) fprintf(stderr, "kernel_launch: cooperative launch failed: %s (grid %d)\n", hipGetErrorString(e), grid);
#endif
}
```
